# Optimizing an MI355X kernel written in HIP

```python
import math
import jax, jax.numpy as jnp
from jax import lax
import numpy as np

D_MODEL = 1024
BATCH = 8
SEQ = 2048
DEPTH = 2
DEC_BATCH = 128
DEC_SEQ = 8
PAST_LEN = 16384
PAGE_SIZE = 128

N_MIXERS = 2
N_MLSTM = (DEPTH + 1) // 2
N_CONV = DEPTH // 2
MLSTM_HEADS = 4
MLSTM_DK = D_MODEL // MLSTM_HEADS
MLSTM_DV = D_MODEL // MLSTM_HEADS
MLSTM_QK = MLSTM_HEADS * MLSTM_DK
MLSTM_V = MLSTM_HEADS * MLSTM_DV
MLSTM_CHUNK = 128
CONV_W = 3
D_FF = -(-8 * D_MODEL // (3 * 256)) * 256
EPS = 1e-6

kernel_name = "mlstm_shortconv_hybrid_step"


def rmsnorm(x, g):
    x32 = x.astype(jnp.float32)
    y = x32 * lax.rsqrt(jnp.mean(x32 * x32, axis=-1, keepdims=True) + EPS) * g.astype(jnp.float32)
    return y.astype(x.dtype)


def swiglu(xn, w_gu, w_down):
    gu = jnp.einsum('bsd,df->bsf', xn, w_gu)
    g, u = jnp.split(gu, 2, axis=-1)
    return jnp.einsum('bsf,fd->bsd', jax.nn.silu(g) * u, w_down)


def mlstm_scan(q, k, v, li, lf, C0, n0, m0):
    B, S, H, DK = q.shape
    DV = v.shape[-1]
    L = math.gcd(S, MLSTM_CHUNK)
    NC = S // L

    def blocks(a):
        a = a.reshape((B, NC, L) + a.shape[2:])
        return jnp.swapaxes(jnp.moveaxis(a, 1, 0), 2, 3)

    causal = jnp.tril(jnp.ones((L, L), dtype=bool))

    def step(carry, xs):
        C, n, m = carry
        qc, kc, vc, lic, lfc = xs
        b = jnp.cumsum(lfc, axis=-1)
        Dm = jnp.where(causal, b[..., :, None] - b[..., None, :] + lic[..., None, :], -jnp.inf)
        inter = b + m[..., None]
        m_eff = jnp.maximum(inter, jnp.max(Dm, axis=-1))
        w_inter = jnp.exp(inter - m_eff)
        s = jnp.einsum('bhld,bhsd->bhls', qc, kc) * jnp.exp(Dm - m_eff[..., None])
        num = w_inter[..., None] * jnp.einsum('bhvd,bhld->bhlv', C, qc) + jnp.einsum('bhls,bhsv->bhlv', s, vc)
        den = w_inter * jnp.einsum('bhd,bhld->bhl', n, qc) + jnp.sum(s, axis=-1)
        h = num / jnp.maximum(jnp.abs(den), jnp.exp(-m_eff))[..., None]
        bL = b[..., -1]
        g = bL[..., None] - b + lic
        m_new = jnp.maximum(bL + m, jnp.max(g, axis=-1))
        a = jnp.exp(bL + m - m_new)
        wg = jnp.exp(g - m_new[..., None])
        C_new = a[..., None, None] * C + jnp.einsum('bhl,bhlv,bhld->bhvd', wg, vc, kc)
        n_new = a[..., None] * n + jnp.einsum('bhl,bhld->bhd', wg, kc)
        return (C_new, n_new, m_new), h

    (C, n, m), h = lax.scan(step, (C0, n0, m0), (blocks(q), blocks(k), blocks(v), blocks(li), blocks(lf)))
    h = jnp.moveaxis(jnp.swapaxes(h, 2, 3), 0, 1).reshape(B, S, H, DV)
    return h, C, n, m


def mlstm_mixer(xn, w_in, b_gate, g_head, w_out, C0, n0, m0):
    B, S, _ = xn.shape
    f32 = jnp.float32
    proj = jnp.einsum('bsd,de->bse', xn, w_in).astype(f32)
    q = proj[..., :MLSTM_QK].reshape(B, S, MLSTM_HEADS, MLSTM_DK) * (MLSTM_DK ** -0.5)
    k = proj[..., MLSTM_QK:2 * MLSTM_QK].reshape(B, S, MLSTM_HEADS, MLSTM_DK)
    v = proj[..., 2 * MLSTM_QK:2 * MLSTM_QK + MLSTM_V].reshape(B, S, MLSTM_HEADS, MLSTM_DV)
    o = proj[..., 2 * MLSTM_QK + MLSTM_V:2 * MLSTM_QK + 2 * MLSTM_V]
    gates = proj[..., 2 * MLSTM_QK + 2 * MLSTM_V:] + b_gate.astype(f32)
    li = gates[..., :MLSTM_HEADS]
    lf = jax.nn.log_sigmoid(gates[..., MLSTM_HEADS:])
    h, C, n, m = mlstm_scan(q, k, v, li, lf, C0.astype(f32), n0.astype(f32), m0.astype(f32))
    h = h * lax.rsqrt(jnp.mean(h * h, axis=-1, keepdims=True) + EPS)
    h = h.reshape(B, S, MLSTM_V) * g_head.astype(f32) * jax.nn.sigmoid(o)
    y = jnp.einsum('bse,ed->bsd', h.astype(xn.dtype), w_out)
    return y, C, n, m


def conv_mixer(xn, w_in, w_taps, w_out, buf):
    S = xn.shape[1]
    proj = jnp.einsum('bsd,de->bse', xn, w_in)
    bg, cg, u = jnp.split(proj, 3, axis=-1)
    u = cg * u
    u_pad = jnp.concatenate([buf.astype(u.dtype), u], axis=1)
    conv = w_taps[0] * u_pad[:, 0:S]
    for j in range(1, CONV_W):
        conv = conv + w_taps[j] * u_pad[:, j:j + S]
    y = jnp.einsum('bsd,de->bse', bg * conv, w_out)
    return y, u_pad[:, -(CONV_W - 1):]


def trunk(x, st_C, st_n, st_m, st_conv, norm_mix, norm_ffn, norm_final, w_mlstm_in, b_mlstm_gate,
          mlstm_head_norm, w_mlstm_out, w_conv_in, w_conv_taps, w_conv_out, w_ffn_gate_up, w_ffn_down):
    Cs, ns, ms, bufs = [], [], [], []
    for layer in range(DEPTH):
        j = layer // N_MIXERS
        xn = rmsnorm(x, norm_mix[layer])
        if layer % N_MIXERS == 0:
            y, C, n, m = mlstm_mixer(xn, w_mlstm_in[j], b_mlstm_gate[j], mlstm_head_norm[j], w_mlstm_out[j],
                                     st_C[j], st_n[j], st_m[j])
            Cs.append(C); ns.append(n); ms.append(m)
        else:
            y, b = conv_mixer(xn, w_conv_in[j], w_conv_taps[j], w_conv_out[j], st_conv[j])
            bufs.append(b)
        x = x + y
        x = x + swiglu(rmsnorm(x, norm_ffn[layer]), w_ffn_gate_up[layer], w_ffn_down[layer])
    return rmsnorm(x, norm_final), jnp.stack(Cs), jnp.stack(ns), jnp.stack(ms), jnp.stack(bufs)


def setup_inputs(seed: int = 0) -> dict:
    key = jax.random.key(seed)
    ks = jax.random.split(key, 20)
    nrm = jax.random.normal
    H = MLSTM_HEADS
    d_in = 2 * MLSTM_QK + 2 * MLSTM_V + 2 * H
    b_gate = jnp.concatenate([
        -1.0 + 0.1 * nrm(ks[10], (N_MLSTM, H)),
        3.0 + 3.0 * jax.random.uniform(ks[11], (N_MLSTM, H))], axis=-1)
    return {
        "x_prompt": nrm(ks[0], (BATCH, SEQ, D_MODEL)),
        "x_sample": nrm(ks[1], (DEC_BATCH, DEC_SEQ, D_MODEL)),
        "state_mlstm_C": 0.1 * nrm(ks[2], (N_MLSTM, DEC_BATCH, H, MLSTM_DV, MLSTM_DK)),
        "state_mlstm_n": nrm(ks[3], (N_MLSTM, DEC_BATCH, H, MLSTM_DK)),
        "state_mlstm_m": nrm(ks[4], (N_MLSTM, DEC_BATCH, H)),
        "state_conv": nrm(ks[5], (N_CONV, DEC_BATCH, CONV_W - 1, D_MODEL)),
        "norm_mix": 1.0 + 0.05 * nrm(ks[6], (DEPTH, D_MODEL)),
        "norm_ffn": 1.0 + 0.05 * nrm(ks[7], (DEPTH, D_MODEL)),
        "norm_final": 1.0 + 0.05 * nrm(ks[8], (D_MODEL,)),
        "w_mlstm_in": nrm(ks[9], (N_MLSTM, D_MODEL, d_in)) * D_MODEL ** -0.5,
        "b_mlstm_gate": b_gate,
        "mlstm_head_norm": 1.0 + 0.05 * nrm(ks[12], (N_MLSTM, MLSTM_V)),
        "w_mlstm_out": nrm(ks[13], (N_MLSTM, MLSTM_V, D_MODEL)) * MLSTM_V ** -0.5,
        "w_conv_in": nrm(ks[14], (N_CONV, D_MODEL, 3 * D_MODEL)) * D_MODEL ** -0.5,
        "w_conv_taps": nrm(ks[15], (N_CONV, CONV_W, D_MODEL)) * CONV_W ** -0.5,
        "w_conv_out": nrm(ks[16], (N_CONV, D_MODEL, D_MODEL)) * D_MODEL ** -0.5,
        "w_ffn_gate_up": nrm(ks[17], (DEPTH, D_MODEL, 2 * D_FF)) * D_MODEL ** -0.5,
        "w_ffn_down": nrm(ks[18], (DEPTH, D_FF, D_MODEL)) * D_FF ** -0.5,
    }


def reference(x_prompt, x_sample, state_mlstm_C, state_mlstm_n, state_mlstm_m, state_conv,
              norm_mix, norm_ffn, norm_final, w_mlstm_in, b_mlstm_gate, mlstm_head_norm, w_mlstm_out,
              w_conv_in, w_conv_taps, w_conv_out, w_ffn_gate_up, w_ffn_down):
    Bp = x_prompt.shape[0]
    f32 = jnp.float32
    zC = jnp.zeros((N_MLSTM, Bp, MLSTM_HEADS, MLSTM_DV, MLSTM_DK), f32)
    zn = jnp.zeros((N_MLSTM, Bp, MLSTM_HEADS, MLSTM_DK), f32)
    zm = jnp.zeros((N_MLSTM, Bp, MLSTM_HEADS), f32)
    zconv = jnp.zeros((N_CONV, Bp, CONV_W - 1, D_MODEL), x_prompt.dtype)
    y_prompt, C_p, n_p, m_p, conv_p = trunk(
        x_prompt, zC, zn, zm, zconv, norm_mix, norm_ffn, norm_final, w_mlstm_in, b_mlstm_gate,
        mlstm_head_norm, w_mlstm_out, w_conv_in, w_conv_taps, w_conv_out, w_ffn_gate_up, w_ffn_down)
    y_sample, C_s, n_s, m_s, conv_s = trunk(
        x_sample, state_mlstm_C, state_mlstm_n, state_mlstm_m, state_conv, norm_mix, norm_ffn, norm_final,
        w_mlstm_in, b_mlstm_gate, mlstm_head_norm, w_mlstm_out, w_conv_in, w_conv_taps, w_conv_out,
        w_ffn_gate_up, w_ffn_down)
    return (y_prompt, y_sample, C_p, n_p, m_p, conv_p, C_s, n_s, m_s, conv_s)
```

```cpp
#include <hip/hip_runtime.h>
#include <cstdio>
#include <cstdint>
#include <cmath>
#define USE_SLOW_GEMM 0
#define MK_N_LAUNCHES 1
namespace pg8 {
#define PG8_LAS __attribute__((address_space(3)))
typedef unsigned short bf16_t;
typedef short bf16x8 __attribute__((ext_vector_type(8)));
typedef float f32x4 __attribute__((ext_vector_type(4)));
typedef unsigned u32x4 __attribute__((ext_vector_type(4)));
constexpr int BM = 256, BK = 64, HALF = 128, HTB = HALF * BK * 2  , STAGE_BYTES = 8 * HTB, NXCD = 8, WGM = 8;

__host__ __device__ __forceinline__ int lds_byte(int r, int c) { const int st = (r >> 4) * 2 + (c >> 5), rr = r & 15, cc = c & 31, ob = rr * 64 + cc * 2; return st * 1024 + (ob ^ (((ob >> 9) & 1) << 5)); }
__host__ __device__ __forceinline__ void stage_rc(int b, int& R, int& C) { const int st = b / 1024, sb = b % 1024, swz = sb ^ (((sb >> 9) & 1) << 5); R = (st >> 1) * 16 + swz / 64; C = (st & 1) * 32 + (swz % 64) / 2; }
__host__ __device__ __forceinline__ int perm32(int rho) { const int n = rho >> 4, i = rho & 15; return 8 * (i >> 2) + 4 * n + (i & 3); }

struct Unit { int pm, pn; };
struct Gemm { const bf16_t* A; const bf16_t* Bt; int M, N, K; };

struct StaticOrder {
    int nM, nN, nwg, G, c;
    __host__ __device__ void init(int M, int N, int G_, int c_) { nM = M / BM; nN = N / BM; nwg = nM * nN; G = G_; c = c_; }
    __host__ __device__ bool next(int i, Unit& u) const {
        const long L = (long)i * G + c; if (L >= nwg) return false;
        int wgid = (int)L; { const int q = nwg / NXCD, r = nwg % NXCD, xcd = wgid % NXCD, off = wgid / NXCD; wgid = (xcd < r ? xcd * (q + 1) : r * (q + 1) + (xcd - r) * q) + off; }
        const int nig = WGM * nN, gid = wgid / nig, fm = gid * WGM, gsz = (nM - fm) < WGM ? (nM - fm) : WGM;
        u.pm = fm + ((wgid % nig) % gsz); u.pn = (wgid % nig) / gsz; return true;
    }
    __device__ __forceinline__ void a_ready(const Unit&) const {}
    __device__ __forceinline__ void done(const Unit&) const {}
};

__device__ __forceinline__ unsigned cvt_pk_bf16(float lo, float hi) { unsigned r; asm volatile("v_cvt_pk_bf16_f32 %0, %1, %2" : "=v"(r) : "v"(lo), "v"(hi)); return r; }
template <class Epi, class Sched, bool ALIGN_EPI = false, bool SP2 = false>
__device__ __forceinline__ void gemm_phase(PG8_LAS unsigned char* lds, const Gemm g, const Sched& S, const Epi& E) {
    const int tid = threadIdx.x, wid = __builtin_amdgcn_readfirstlane(tid >> 6), lane = tid & 63, wr = wid >> 2, wc = wid & 3, fr = lane & 15, fq = lane >> 4;
    const int K = g.K, nt = K / BK;
    unsigned voffA[2], voffB[2];
#pragma unroll
    for (int i = 0; i < 2; ++i) { int R, C; stage_rc(tid * 16 + i * 8192, R, C); const int Rb = Epi::PERM ? ((R & ~31) + perm32(R & 31)) : R;
        voffA[i] = (unsigned)(R * K + C) * 2u; voffB[i] = (unsigned)(Rb * K + C) * 2u; }
    const size_t kstep = (size_t)(BK * 2);
    const size_t hstep = (size_t)HALF * K * 2;
    const size_t tstep = 2 * hstep;
    const unsigned ldsw = (unsigned)wid * 1024u;
    const int aoff = lds_byte(wr * 64 + fr, fq * 8), boff = lds_byte(wc * 32 + fr, fq * 8);
#define PG8_SA(b, h) (((b) * 2 + (h)) * HTB)
#define PG8_SB(b, h) ((4 + (b) * 2 + (h)) * HTB)
#define PG8_STAGE(bufoff, gbase, voff) do { _Pragma("unroll") for (int _i = 0; _i < 2; ++_i) \
        __builtin_amdgcn_global_load_lds((const unsigned*)((const char*)(gbase) + (voff)[_i]), (PG8_LAS unsigned*)(lds + (bufoff) + ldsw + _i * 8192), 16, 0, 0); } while (0)
#define PG8_LDA(dst, b, h) do { _Pragma("unroll") for (int m = 0; m < 4; ++m) _Pragma("unroll") for (int k = 0; k < 2; ++k) dst[m][k] = *(const PG8_LAS bf16x8*)(lds + PG8_SA(b, h) + aoff + m * 2048 + k * 1024); } while (0)
#define PG8_LDB(dst, b, h) do { _Pragma("unroll") for (int n = 0; n < 2; ++n) _Pragma("unroll") for (int k = 0; k < 2; ++k) dst[n][k] = *(const PG8_LAS bf16x8*)(lds + PG8_SB(b, h) + boff + n * 2048 + k * 1024); } while (0)
#define PG8_MMA(ai, bj, At, Bt) do { __builtin_amdgcn_s_setprio(1); _Pragma("unroll") for (int m = 0; m < 4; ++m) _Pragma("unroll") for (int n = 0; n < 2; ++n) _Pragma("unroll") for (int k = 0; k < 2; ++k) \
        acc[ai][bj][m][n] = __builtin_amdgcn_mfma_f32_16x16x32_bf16(Bt[n][k], At[m][k], acc[ai][bj][m][n], 0, 0, 0); __builtin_amdgcn_s_setprio(0); } while (0)
#define PG8_WAIT_V(n) asm volatile("s_waitcnt vmcnt(" #n ")" ::: "memory")
#define PG8_WAIT_L(n) asm volatile("s_waitcnt lgkmcnt(" #n ")" ::: "memory")
#define PG8_BAR __builtin_amdgcn_s_barrier()
#define PG8_SCHED __builtin_amdgcn_sched_barrier(0)
    Unit cur, nxt; int ui = 0;
    if (!S.next(0, cur)) return;
    f32x4 acc[2][2][4][2];
#pragma unroll
    for (int a = 0; a < 2; ++a)
#pragma unroll
        for (int b = 0; b < 2; ++b)
#pragma unroll
            for (int m = 0; m < 4; ++m)
#pragma unroll
                for (int n = 0; n < 2; ++n) acc[a][b][m][n] = (f32x4){0.f, 0.f, 0.f, 0.f};
    bf16x8 At[4][2], B0[2][2], B1[2][2];
    const char* cA = (const char*)g.A + (size_t)cur.pm * tstep; const char* cB = (const char*)g.Bt + (size_t)cur.pn * tstep;
    S.a_ready(cur);
    if constexpr (SP2) {
        PG8_STAGE(PG8_SB(0, 0), cB, voffB); PG8_STAGE(PG8_SB(0, 1), cB + hstep, voffB); PG8_STAGE(PG8_SA(0, 0), cA, voffA); PG8_STAGE(PG8_SA(0, 1), cA + hstep, voffA);
        if (wr == 1) PG8_BAR;
        PG8_WAIT_V(2); PG8_BAR;
        PG8_STAGE(PG8_SB(1, 0), cB + kstep, voffB); PG8_STAGE(PG8_SA(1, 0), cA + kstep, voffA); PG8_STAGE(PG8_SB(1, 1), cB + hstep + kstep, voffB);
        PG8_WAIT_V(6); PG8_BAR;
    } else {
        PG8_STAGE(PG8_SB(0, 0), cB, voffB); PG8_STAGE(PG8_SA(0, 0), cA, voffA); PG8_STAGE(PG8_SB(0, 1), cB + hstep, voffB); PG8_STAGE(PG8_SA(0, 1), cA + hstep, voffA);
        if (wr == 1) PG8_BAR;
        PG8_WAIT_V(4); PG8_BAR;
        PG8_STAGE(PG8_SB(1, 0), cB + kstep, voffB); PG8_STAGE(PG8_SA(1, 0), cA + kstep, voffA); PG8_STAGE(PG8_SB(1, 1), cB + hstep + kstep, voffB);
        PG8_WAIT_V(6); PG8_BAR;
    }
    for (;;) {
        const bool has_next = S.next(ui + 1, nxt);
        const char* nA = has_next ? (const char*)g.A + (size_t)nxt.pm * tstep : cA; const char* nB = has_next ? (const char*)g.Bt + (size_t)nxt.pn * tstep : cB;
        for (int t = 0; t < nt; t += 2) {
            const bool last = (t == nt - 2);
            const char* a1 = cA + (size_t)(t + 1) * kstep;
            const char* a2 = last ? nA : cA + (size_t)(t + 2) * kstep; const char* b2 = last ? nB : cB + (size_t)(t + 2) * kstep;
            const char* a3 = a2 + kstep; const char* b3 = b2 + kstep;
            if (last && has_next) S.a_ready(nxt);
            if constexpr (SP2) {
            PG8_LDB(B0, 0, 0); PG8_LDB(B1, 0, 1); PG8_SCHED; PG8_LDA(At, 0, 0); PG8_STAGE(PG8_SA(1, 1), a1 + hstep, voffA);
            PG8_WAIT_V(8); PG8_WAIT_L(0); PG8_BAR; PG8_MMA(0, 0, At, B0); PG8_MMA(0, 1, At, B1); PG8_BAR; PG8_SCHED;
            PG8_LDA(At, 0, 1); PG8_STAGE(PG8_SB(0, 0), b2, voffB); PG8_STAGE(PG8_SB(0, 1), b2 + hstep, voffB); PG8_STAGE(PG8_SA(0, 0), a2, voffA);
            PG8_WAIT_V(8); PG8_WAIT_L(0); PG8_BAR; PG8_MMA(1, 0, At, B0); PG8_MMA(1, 1, At, B1); PG8_BAR; PG8_SCHED;
            PG8_LDB(B0, 1, 0); PG8_LDB(B1, 1, 1); PG8_SCHED; PG8_LDA(At, 1, 0); PG8_STAGE(PG8_SA(0, 1), a2 + hstep, voffA);
            PG8_WAIT_V(8); PG8_WAIT_L(0); PG8_BAR; PG8_MMA(0, 0, At, B0); PG8_MMA(0, 1, At, B1); PG8_BAR; PG8_SCHED;
            PG8_LDA(At, 1, 1); PG8_STAGE(PG8_SB(1, 0), b3, voffB); PG8_STAGE(PG8_SB(1, 1), b3 + hstep, voffB); PG8_STAGE(PG8_SA(1, 0), a3, voffA);
            PG8_WAIT_V(8); PG8_WAIT_L(0); PG8_BAR; PG8_MMA(1, 0, At, B0); PG8_MMA(1, 1, At, B1); PG8_BAR; PG8_SCHED;
            } else {
            PG8_LDB(B0, 0, 0); PG8_SCHED; PG8_LDA(At, 0, 0); PG8_STAGE(PG8_SA(1, 1), a1 + hstep, voffA);
            PG8_WAIT_L(8); PG8_BAR; PG8_WAIT_L(0); PG8_MMA(0, 0, At, B0); PG8_BAR; PG8_SCHED;
            PG8_LDB(B1, 0, 1); PG8_STAGE(PG8_SB(0, 0), b2, voffB);
            PG8_BAR; PG8_WAIT_L(0); PG8_MMA(0, 1, At, B1); PG8_BAR;
            PG8_LDA(At, 0, 1); PG8_STAGE(PG8_SA(0, 0), a2, voffA);
            PG8_BAR; PG8_WAIT_L(0); PG8_MMA(1, 0, At, B0); PG8_BAR; PG8_SCHED;
            PG8_STAGE(PG8_SB(0, 1), b2 + hstep, voffB);
            PG8_WAIT_V(6); PG8_BAR; PG8_MMA(1, 1, At, B1); PG8_BAR;
            PG8_LDB(B0, 1, 0); PG8_SCHED; PG8_LDA(At, 1, 0); PG8_STAGE(PG8_SA(0, 1), a2 + hstep, voffA);
            PG8_WAIT_L(8); PG8_BAR; PG8_WAIT_L(0); PG8_MMA(0, 0, At, B0); PG8_BAR; PG8_SCHED;
            PG8_LDB(B1, 1, 1); PG8_STAGE(PG8_SB(1, 0), b3, voffB);
            PG8_BAR; PG8_WAIT_L(0); PG8_MMA(0, 1, At, B1); PG8_BAR;
            PG8_LDA(At, 1, 1); PG8_STAGE(PG8_SA(1, 0), a3, voffA);
            PG8_BAR; PG8_WAIT_L(0); PG8_MMA(1, 0, At, B0); PG8_BAR; PG8_SCHED;
            PG8_STAGE(PG8_SB(1, 1), b3 + hstep, voffB);
            PG8_WAIT_V(6); PG8_BAR; PG8_MMA(1, 1, At, B1); PG8_BAR;
            }
        }
        if constexpr (ALIGN_EPI) { if (wr == 0) PG8_BAR; }
        if constexpr (!Epi::AFTER_DRAIN) { E(acc, cur, wr, wc, fr, fq); S.done(cur); }
        if (!has_next) break;
#pragma unroll
        for (int a = 0; a < 2; ++a)
#pragma unroll
            for (int b = 0; b < 2; ++b)
#pragma unroll
                for (int m = 0; m < 4; ++m)
#pragma unroll
                    for (int n = 0; n < 2; ++n) acc[a][b][m][n] = (f32x4){0.f, 0.f, 0.f, 0.f};
        cur = nxt; cA = nA; cB = nB; ++ui;
        if constexpr (ALIGN_EPI) { if (wr == 1) PG8_BAR; }
    }
    PG8_WAIT_V(0);
    if constexpr (!ALIGN_EPI) { if (wr == 0) PG8_BAR; }
    PG8_BAR;
    if constexpr (Epi::AFTER_DRAIN) { E.fused(acc, cur, wr, wc, fr, fq, lds, wid, lane); S.done(cur); }
#undef PG8_SA
#undef PG8_SB
#undef PG8_STAGE
#undef PG8_LDA
#undef PG8_LDB
#undef PG8_MMA
#undef PG8_WAIT_V
#undef PG8_WAIT_L
#undef PG8_BAR
#undef PG8_SCHED
}
}
constexpr int DM = 1024;
constexpr int NB_P = 8, S_P = 2048, NB_S = 128, S_S = 8;
constexpr int MP = NB_P * S_P, MS = NB_S * S_S, MT = MP + MS;
constexpr int NH = 4, DK = 256, DV = 256;
constexpr int NIN = 4096, NIN_SRC = 4104;
constexpr int DFF = 2816, NGU = 2 * DFF, NCIN = 3 * DM;
constexpr float EPS = 1e-6f;
constexpr int NWAVES = 8;

constexpr size_t O_Y = 0;
constexpr size_t O_CP = (size_t)MT * DM;
constexpr size_t O_NP = O_CP + (size_t)NB_P * NH * DV * DK;
constexpr size_t O_MP = O_NP + (size_t)NB_P * NH * DK;
constexpr size_t O_CVP = O_MP + (size_t)NB_P * NH;
constexpr size_t O_CS = O_CVP + (size_t)NB_P * 2 * DM;
constexpr size_t O_NS = O_CS + (size_t)NB_S * NH * DV * DK;
constexpr size_t O_MS = O_NS + (size_t)NB_S * NH * DK;
constexpr size_t O_CVS = O_MS + (size_t)NB_S * NH;
constexpr size_t O_END = O_CVS + (size_t)NB_S * 2 * DM;

constexpr size_t MiB = 1u << 20;
constexpr size_t WS_CTL = 0, CTL_ZERO_BYTES = 1 * MiB;
constexpr size_t WS_W_IN = 2 * MiB, WS_W_OUT = 10 * MiB, WS_W_GU0 = 12 * MiB, WS_W_DN0 = 23 * MiB, WS_W_CIN = 29 * MiB, WS_W_COUT = 35 * MiB, WS_W_GU1 = 37 * MiB, WS_W_DN1 = 48 * MiB;
constexpr size_t SSQ_BYTES = (size_t)MT * 16 * 4;
constexpr size_t WS_SSQ = 54 * MiB;
constexpr size_t WS_GATES = 59 * MiB;
constexpr size_t WS_XB = 60 * MiB;
constexpr size_t WS_A2 = 94 * MiB;
constexpr size_t WS_QKVO = 128 * MiB;
constexpr size_t WS_HFF = 128 * MiB;
constexpr size_t WS_BG = 128 * MiB, WS_U = 162 * MiB;
constexpr size_t WS_HBUF = 264 * MiB;
constexpr size_t WS_END = 332 * MiB;
static_assert(WS_SSQ + 4 * SSQ_BYTES <= WS_GATES && WS_GATES + (size_t)MT * 8 * 4 <= WS_XB && WS_XB + (size_t)MT * DM * 2 <= WS_A2 && WS_A2 + (size_t)MT * DM * 2 <= WS_QKVO, "ws map");
static_assert(WS_QKVO + (size_t)MT * NIN * 2 <= WS_HBUF && WS_HFF + (size_t)MT * DFF * 2 <= WS_HBUF && WS_U + (size_t)MT * DM * 2 <= WS_HBUF && WS_HBUF + (size_t)MT * DM * 4 <= WS_END, "ws map 2");
static_assert(WS_W_DN1 + (size_t)DM * DFF * 2 <= WS_SSQ, "ws map 3");
constexpr int CW_BAR = 4096;

constexpr int RING_OFF = 0, RING_BYTES = 131072;
constexpr int LDSCTL_OFF = RING_BYTES, MISC_OFF = LDSCTL_OFF + 320;
constexpr int LDS_BYTES = 147456;

#define GAS __attribute__((address_space(1)))
#define LAS __attribute__((address_space(3)))
typedef unsigned short bf16;
typedef unsigned v4u __attribute__((ext_vector_type(4)));
typedef unsigned v2u __attribute__((ext_vector_type(2)));
typedef float f32x4 __attribute__((ext_vector_type(4)));
typedef short bf16x8 __attribute__((ext_vector_type(8)));
typedef GAS unsigned gu32;
typedef GAS unsigned long long gu64;
#define RLX_AGENT __ATOMIC_RELAXED, __HIP_MEMORY_SCOPE_AGENT
#define LDS_WAIT() asm volatile("s_waitcnt lgkmcnt(0)" ::: "memory")
#define VM_WAIT() asm volatile("s_waitcnt vmcnt(0)" ::: "memory")
__device__ __forceinline__ unsigned f2bf(float f) { unsigned u = __builtin_bit_cast(unsigned, f); return (u + 0x7fffu + ((u >> 16) & 1u)) >> 16; }
__device__ __forceinline__ unsigned pk2(float lo, float hi) { return f2bf(lo) | (f2bf(hi) << 16); }
__device__ __forceinline__ float bf2f(unsigned short s) { return __builtin_bit_cast(float, (unsigned)s << 16); }
__device__ __forceinline__ float bflo(unsigned w) { return __builtin_bit_cast(float, w << 16); }
__device__ __forceinline__ float bfhi(unsigned w) { return __builtin_bit_cast(float, w & 0xffff0000u); }
__device__ __forceinline__ float wave_sum(float v) {
#pragma unroll
    for (int o = 1; o < 64; o <<= 1) v += __shfl_xor(v, o);
    return v;
}
__device__ __forceinline__ float sigmoidf_(float x) { return 1.f / (1.f + __expf(-x)); }
__device__ __forceinline__ float logsigmoidf_(float x) { return fminf(x, 0.f) - log1pf(expf(-fabsf(x))); }
#define XB_TMO      128
#define XB_XCNT(j)  (256  + 64 * (j))
#define XB_XSUB(j)  (1280 + 64 * (j))
#define XB_XGEN(j)  (2304 + 64 * (j))
#define XB_TOP      3328
#define XB_TOPGEN   3392
#define XCD_BAR_WORDS 3456
#define XB_SPIN_CAP (1u << 18)

__device__ __forceinline__ unsigned xb_ld(unsigned* p)              { return __hip_atomic_load(p, __ATOMIC_RELAXED, __HIP_MEMORY_SCOPE_AGENT); }
__device__ __forceinline__ unsigned xb_add(unsigned* p, unsigned v) { return __hip_atomic_fetch_add(p, v, __ATOMIC_RELAXED, __HIP_MEMORY_SCOPE_AGENT); }
__device__ __forceinline__ unsigned xb_xcc_id() { return (unsigned)__builtin_amdgcn_s_getreg((3 << 11) | 20) & 0xFu; }
#define XB_SPIN(cond, bar) do { unsigned _sp = 0; while (cond) { __builtin_amdgcn_s_sleep(1); \
    if ((++_sp & 255u) == 0u) { if (xb_ld(&(bar)[XB_TMO])) break; if (_sp > XB_SPIN_CAP) { atomicAdd(&(bar)[XB_TMO], 1u); break; } } } } while (0)

struct XcdBarrier {
    unsigned* bar; unsigned x;
    volatile LAS unsigned* st;
};

__device__ __forceinline__ XcdBarrier xcd_barrier_post(unsigned* bar, volatile LAS unsigned* st) {
    XcdBarrier b; b.bar = bar; b.x = xb_xcc_id(); b.st = st;
    if (threadIdx.x == 0) (void)xb_add(&bar[XB_XCNT(b.x)], 1u);
    return b;
}
__device__ __forceinline__ void xcd_barrier_complete(unsigned* bar, unsigned x, unsigned& nloc, unsigned& nx) {
    const unsigned G = gridDim.x * gridDim.y * gridDim.z;
    unsigned sum, cnt, mine, sp = 0u;
    for (;;) {
        sum = 0u; cnt = 0u; mine = 0u;
#pragma unroll
        for (unsigned j = 0; j < 16; ++j) { const unsigned c = xb_ld(&bar[XB_XCNT(j)]); sum += c; cnt += (c > 0u) ? 1u : 0u; mine = (j == x) ? c : mine; }
        if (sum == G) break;
        __builtin_amdgcn_s_sleep(1);
        if ((++sp & 255u) == 0u) { if (xb_ld(&bar[XB_TMO])) break; if (sp > XB_SPIN_CAP) { atomicAdd(&bar[XB_TMO], 1u); break; } }
    }
    nloc = mine > 0u ? mine : 1u; nx = cnt > 0u ? cnt : 1u;
}

__device__ __forceinline__ void xcd_barrier(const XcdBarrier& b) {
    asm volatile("s_waitcnt vmcnt(0)" ::: "memory");
    __syncthreads();
    if (threadIdx.x == 0) {
        unsigned* bar = b.bar;
        __builtin_amdgcn_s_waitcnt(0);
        unsigned nloc = b.st[0], nx = b.st[1];
        if (nloc == 0u) { xcd_barrier_complete(bar, b.x, nloc, nx); b.st[0] = nloc; b.st[1] = nx; }
        const unsigned old = xb_add(&bar[XB_XSUB(b.x)], 1u);
        const unsigned gen = old / nloc;
        if (old + 1u == (gen + 1u) * nloc) {
            __builtin_amdgcn_fence(__ATOMIC_RELEASE, "agent");
            asm volatile("s_waitcnt vmcnt(0)" ::: "memory");
            const unsigned og = xb_add(&bar[XB_TOP], 1u);
            const unsigned tg = og / nx;
            if (og + 1u == (tg + 1u) * nx) xb_add(&bar[XB_TOPGEN], 1u);
            else XB_SPIN(xb_ld(&bar[XB_TOPGEN]) == tg, bar);
            __builtin_amdgcn_fence(__ATOMIC_ACQUIRE, "agent");
            xb_add(&bar[XB_XGEN(b.x)], 1u);
            asm volatile("s_waitcnt vmcnt(0)" ::: "memory");
        } else {
            XB_SPIN(xb_ld(&bar[XB_XGEN(b.x)]) == gen, bar);
            __builtin_amdgcn_fence(__ATOMIC_ACQUIRE, "agent");
            asm volatile("s_waitcnt vmcnt(0)" ::: "memory");
        }
    }
    __syncthreads();
}
struct Frame {
    LAS unsigned char* lds;
    volatile LAS unsigned* MISC;
    gu32* ctl;
    int tid, lane, wave, vcu, G;
    const float *xp, *xs, *stC, *stN, *stM, *stConv, *norm_mix, *norm_ffn, *norm_final, *w_in, *b_gate, *head_norm, *w_out, *w_cin, *w_taps, *w_cout, *w_gu, *w_dn;
    float* out; unsigned char* ws;
};
#define WSP(T, off) ((T*)(F.ws + (off)))

namespace ep {
using pg8::Unit; using pg8::bf16_t; using pg8::cvt_pk_bf16; using pg8::BM; using pg8::HALF; using pg8::u32x4;
__device__ __forceinline__ float row_rs(const float* slab, int row) {
    const f32x4* p = (const f32x4*)(slab + (size_t)row * 16);
    const f32x4 a = p[0], b = p[1], c = p[2], d = p[3];
    const float s = (((a.x + a.y) + (a.z + a.w)) + ((b.x + b.y) + (b.z + b.w))) + (((c.x + c.y) + (c.z + c.w)) + ((d.x + d.y) + (d.z + d.w)));
    return rsqrtf(s * (1.f / 1024.f) + EPS);
}
__device__ __forceinline__ u32x4 pack8(const f32x4 v0, const f32x4 v1) { u32x4 w; w.x = cvt_pk_bf16(v0[0], v0[1]); w.y = cvt_pk_bf16(v0[2], v0[3]); w.z = cvt_pk_bf16(v1[0], v1[1]); w.w = cvt_pk_bf16(v1[2], v1[3]); return w; }

struct EpiScale {
    static constexpr bool PERM = true, AFTER_DRAIN = false;
    bf16_t* O; int ldc; const float* ssq;
    __device__ __forceinline__ void operator()(const f32x4 (&acc)[2][2][4][2], const Unit& u, int wr, int wc, int fr, int fq) const {
        const int row0 = u.pm * BM + wr * 64 + fr, col0 = u.pn * BM + wc * 32 + 8 * fq;
#pragma unroll
        for (int ai = 0; ai < 2; ++ai)
#pragma unroll
            for (int m = 0; m < 4; ++m) { const int row = row0 + ai * HALF + m * 16; const float r = row_rs(ssq, row); bf16_t* rowp = O + (size_t)row * ldc + col0;
#pragma unroll
                for (int bj = 0; bj < 2; ++bj) *(u32x4*)(rowp + bj * HALF) = pack8(acc[ai][bj][m][0] * r, acc[ai][bj][m][1] * r); }
    }
};
__device__ __forceinline__ float silu_mul(float g, float u) { return g / (1.f + __expf(-g)) * u; }
struct EpiSwiGLU {
    static constexpr bool PERM = true, AFTER_DRAIN = false;
    bf16_t* O; const float* ssq;
    __device__ __forceinline__ void operator()(const f32x4 (&acc)[2][2][4][2], const Unit& u, int wr, int wc, int fr, int fq) const {
        const int row0 = u.pm * BM + wr * 64 + fr, col0 = u.pn * HALF + wc * 32 + 8 * fq;
#pragma unroll
        for (int ai = 0; ai < 2; ++ai)
#pragma unroll
            for (int m = 0; m < 4; ++m) { const int row = row0 + ai * HALF + m * 16; const float r = row_rs(ssq, row);
                const f32x4 g0 = acc[ai][0][m][0] * r, g1 = acc[ai][0][m][1] * r, u0 = acc[ai][1][m][0] * r, u1 = acc[ai][1][m][1] * r;
                f32x4 h0, h1;
#pragma unroll
                for (int j = 0; j < 4; ++j) { h0[j] = silu_mul(g0[j], u0[j]); h1[j] = silu_mul(g1[j], u1[j]); }
                *(u32x4*)(O + (size_t)row * DFF + col0) = pack8(h0, h1); }
    }
};
template <bool WB> struct EpiResid {
    static constexpr bool PERM = true, AFTER_DRAIN = false;
    const float* baseP; const float* baseS; float* out; bf16_t* XB; float* ssq;
    __device__ __forceinline__ void operator()(const f32x4 (&acc)[2][2][4][2], const Unit& u, int wr, int wc, int fr, int fq) const {
        const int row0 = u.pm * BM + wr * 64 + fr, col0 = u.pn * BM + wc * 32 + 8 * fq;
#pragma unroll
        for (int ai = 0; ai < 2; ++ai)
#pragma unroll
            for (int m = 0; m < 4; ++m) { const int row = row0 + ai * HALF + m * 16;
                const float* bp = (row < MP ? baseP + (size_t)row * DM : baseS + (size_t)(row - MP) * DM) + col0; float* op = out + (size_t)row * DM + col0;
                float ss = 0.f;
#pragma unroll
                for (int bj = 0; bj < 2; ++bj) { const f32x4 x0 = *(const f32x4*)(bp + bj * HALF) + acc[ai][bj][m][0], x1 = *(const f32x4*)(bp + bj * HALF + 4) + acc[ai][bj][m][1];
                    *(f32x4*)(op + bj * HALF) = x0; *(f32x4*)(op + bj * HALF + 4) = x1;
                    if (WB) { *(u32x4*)(XB + (size_t)row * DM + col0 + bj * HALF) = pack8(x0, x1);
                        ss += ((x0[0] * x0[0] + x0[1] * x0[1]) + (x0[2] * x0[2] + x0[3] * x0[3])) + ((x1[0] * x1[0] + x1[1] * x1[1]) + (x1[2] * x1[2] + x1[3] * x1[3])); } }
                if (WB) { ss += __shfl_xor(ss, 16); ss += __shfl_xor(ss, 32); if (fq == 0) ssq[(size_t)row * 16 + u.pn * 4 + wc] = ss; } }
    }
};
struct EpiConvIn {
    static constexpr bool PERM = true, AFTER_DRAIN = false;
    bf16_t* BG; bf16_t* U; const float* ssq; float* cvP; float* cvS;
    __device__ __forceinline__ void operator()(const f32x4 (&acc)[2][2][4][2], const Unit& u, int wr, int wc, int fr, int fq) const {
        const int row0 = u.pm * BM + wr * 64 + fr;
        if (u.pn < 4) {
            const int col0 = u.pn * BM + wc * 32 + 8 * fq;
#pragma unroll
            for (int ai = 0; ai < 2; ++ai)
#pragma unroll
                for (int m = 0; m < 4; ++m) { const int row = row0 + ai * HALF + m * 16; const float r = row_rs(ssq, row); bf16_t* rowp = BG + (size_t)row * DM + col0;
#pragma unroll
                    for (int bj = 0; bj < 2; ++bj) *(u32x4*)(rowp + bj * HALF) = pack8(acc[ai][bj][m][0] * r, acc[ai][bj][m][1] * r); }
        } else {
            const int col0 = (u.pn - 4) * HALF + wc * 32 + 8 * fq;
#pragma unroll
            for (int ai = 0; ai < 2; ++ai)
#pragma unroll
                for (int m = 0; m < 4; ++m) { const int row = row0 + ai * HALF + m * 16; const float r = row_rs(ssq, row);
                    const f32x4 p0 = (acc[ai][0][m][0] * r) * (acc[ai][1][m][0] * r), p1 = (acc[ai][0][m][1] * r) * (acc[ai][1][m][1] * r);
                    *(u32x4*)(U + (size_t)row * DM + col0) = pack8(p0, p1);
                    float* sp = nullptr;
                    if (row < MP) { const int t = row & (S_P - 1), b = row >> 11; if (t >= S_P - 2) sp = cvP + (size_t)(b * 2 + (t - (S_P - 2))) * DM + col0; }
                    else { const int rs = row - MP, t = rs & (S_S - 1), b = rs >> 3; if (t >= S_S - 2) sp = cvS + (size_t)(b * 2 + (t - (S_S - 2))) * DM + col0; }
                    if (sp) { *(f32x4*)sp = p0; *(f32x4*)(sp + 4) = p1; } }
        }
    }
};
}

template <class Epi, class Sched>
__device__ __forceinline__ void gemm_phase_slow(const pg8::Gemm g, const Sched& S, const Epi& E) {
    const int tid = threadIdx.x, wid = __builtin_amdgcn_readfirstlane(tid >> 6), lane = tid & 63, wr = wid >> 2, wc = wid & 3, fr = lane & 15, fq = lane >> 4;
    const int K = g.K;
    pg8::Unit u;
    for (int i = 0; S.next(i, u); ++i) {
        f32x4 acc[2][2][4][2];
#pragma unroll
        for (int a = 0; a < 2; ++a)
#pragma unroll
            for (int b = 0; b < 2; ++b)
#pragma unroll
                for (int m = 0; m < 4; ++m)
#pragma unroll
                    for (int n = 0; n < 2; ++n) acc[a][b][m][n] = (f32x4){0.f, 0.f, 0.f, 0.f};
        const unsigned offA = (unsigned)(wr * 64 + fr) * (unsigned)K * 2u, offB = (unsigned)(wc * 32 + (Epi::PERM ? 8 * fq : 4 * fq)) * (unsigned)K * 2u;
        const char* Au = (const char*)g.A + (size_t)u.pm * 256 * K * 2; const char* Bu = (const char*)g.Bt + (size_t)u.pn * 256 * K * 2;
#pragma unroll
        for (int ai = 0; ai < 2; ++ai) {
#pragma unroll 1
        for (int k0 = 0; k0 < K; k0 += 2) {
            float af[4][2];
#pragma unroll
            for (int m = 0; m < 4; ++m) { const unsigned w = *(const unsigned*)(Au + ((size_t)(ai * 128 + m * 16) * K + k0) * 2 + offA); af[m][0] = bflo(w); af[m][1] = bfhi(w); }
#pragma unroll
            for (int bj = 0; bj < 2; ++bj)
#pragma unroll
                for (int n = 0; n < 2; ++n)
#pragma unroll
                    for (int j = 0; j < 4; ++j) { const unsigned w = *(const unsigned*)(Bu + ((size_t)(bj * 128 + (Epi::PERM ? 4 * n : 16 * n) + j) * K + k0) * 2 + offB);
                        const float b0 = bflo(w), b1 = bfhi(w);
#pragma unroll
                        for (int m = 0; m < 4; ++m) acc[ai][bj][m][n][j] += af[m][0] * b0 + af[m][1] * b1; }
        }
        }
        E(acc, u, wr, wc, fr, fq);
    }
}
#ifndef USE_SLOW_GEMM
#define USE_SLOW_GEMM 0
#endif
template <class Epi, bool ALIGN, bool SP2>
__device__ __forceinline__ void run_gemm(Frame& F, const pg8::Gemm g, const Epi& E) {
    pg8::StaticOrder S; S.init(g.M, g.N, F.G, (int)blockIdx.x);
#if USE_SLOW_GEMM
    gemm_phase_slow<Epi, pg8::StaticOrder>(g, S, E);
#else
    pg8::gemm_phase<Epi, pg8::StaticOrder, ALIGN, SP2>(F.lds + RING_OFF, g, S, E);
#endif
}

__device__ __forceinline__ int map_row(int kind, int n0) {
    if (kind == 2) { if (n0 < DFF) return 256 * (n0 >> 7) + (n0 & 127); const int j = n0 - DFF; return 256 * (j >> 7) + 128 + (j & 127); }
    if (kind == 3) { if (n0 < DM) return n0; if (n0 < 2 * DM) { const int j = n0 - DM; return DM + 256 * (j >> 7) + (j & 127); } const int j = n0 - 2 * DM; return DM + 256 * (j >> 7) + 128 + (j & 127); }
    return n0;
}
__device__ __forceinline__ void p0_transpose_item(const float* W, int K, int N, int ldw, bf16* WT, int kind, const float* kscale, LAS float* scr, int item, int lane) {
    const int nblk = N / 32, kb = item / nblk, nb = item % nblk, k0 = 64 * kb, n0 = 32 * nb;
    const float ns = (kind == 1 && n0 < 1024) ? 0.0625f : 1.f;
#pragma unroll 8
    for (int i = 0; i < 32; ++i) { const int kk = 2 * i + (lane >> 5); const float ks = kscale ? kscale[k0 + kk] * ns : ns;
        scr[kk * 33 + (lane & 31)] = W[(size_t)(k0 + kk) * ldw + n0 + (lane & 31)] * ks; }
    LDS_WAIT(); asm volatile("" ::: "memory");
    const int c = lane & 7, r0 = map_row(kind, n0);
#pragma unroll
    for (int j = 0; j < 4; ++j) { const int n = (lane >> 3) + 8 * j; const LAS float* s = scr + (8 * c) * 33 + n;
        v4u o; o.x = pk2(s[0 * 33], s[1 * 33]); o.y = pk2(s[2 * 33], s[3 * 33]); o.z = pk2(s[4 * 33], s[5 * 33]); o.w = pk2(s[6 * 33], s[7 * 33]);
        *(GAS v4u*)(WT + (size_t)(r0 + n) * K + k0 + 8 * c) = o; }
    LDS_WAIT(); asm volatile("" ::: "memory");
}
__device__ __forceinline__ void p0_prologue(Frame& F) {
    LAS float* scr = (LAS float*)(F.lds + RING_OFF + F.wave * 16384);
    const int gw = F.vcu * NWAVES + F.wave, NGW = F.G * NWAVES;
    constexpr int I0 = 16 * 128, I1 = 16 * 32, I2 = 16 * 176, I3 = 44 * 32, I4 = 16 * 96, I5 = 16 * 32, I6 = I2, I7 = I3;
    constexpr int NITEMS = I0 + I1 + I2 + I3 + I4 + I5 + I6 + I7;
    for (int it = gw; it < NITEMS; it += NGW) {
        int r = it;
        if (r < I0) { p0_transpose_item(F.w_in, DM, NIN, NIN_SRC, WSP(bf16, WS_W_IN), 1, F.norm_mix, scr, r, F.lane); continue; } r -= I0;
        if (r < I1) { p0_transpose_item(F.w_out, DM, DM, DM, WSP(bf16, WS_W_OUT), 0, nullptr, scr, r, F.lane); continue; } r -= I1;
        if (r < I2) { p0_transpose_item(F.w_gu, DM, NGU, NGU, WSP(bf16, WS_W_GU0), 2, F.norm_ffn, scr, r, F.lane); continue; } r -= I2;
        if (r < I3) { p0_transpose_item(F.w_dn, DFF, DM, DM, WSP(bf16, WS_W_DN0), 0, nullptr, scr, r, F.lane); continue; } r -= I3;
        if (r < I4) { p0_transpose_item(F.w_cin, DM, NCIN, NCIN, WSP(bf16, WS_W_CIN), 3, F.norm_mix + DM, scr, r, F.lane); continue; } r -= I4;
        if (r < I5) { p0_transpose_item(F.w_cout, DM, DM, DM, WSP(bf16, WS_W_COUT), 0, nullptr, scr, r, F.lane); continue; } r -= I5;
        if (r < I6) { p0_transpose_item(F.w_gu + (size_t)DM * NGU, DM, NGU, NGU, WSP(bf16, WS_W_GU1), 2, F.norm_ffn + DM, scr, r, F.lane); continue; } r -= I6;
        p0_transpose_item(F.w_dn + (size_t)DFF * DM, DFF, DM, DM, WSP(bf16, WS_W_DN1), 0, nullptr, scr, r, F.lane);
    }
    __syncthreads();
    LAS float* WG = (LAS float*)(F.lds + RING_OFF);
    for (int idx = F.tid; idx < DM * 8; idx += NWAVES * 64) { const int k = idx >> 3, j = idx & 7; WG[idx] = F.w_in[(size_t)k * NIN_SRC + NIN + j] * F.norm_mix[k]; }
    __syncthreads();
    bf16* XB = WSP(bf16, WS_XB); float* SSQ0 = WSP(float, WS_SSQ); float* GATES = WSP(float, WS_GATES);
    for (int row = gw; row < MT; row += NGW) {
        const float* xrow = row < MP ? F.xp + (size_t)row * DM : F.xs + (size_t)(row - MP) * DM;
        const GAS f32x4* xr = (const GAS f32x4*)xrow + F.lane;
        f32x4 v[4]; float s = 0.f;
#pragma unroll
        for (int j = 0; j < 4; ++j) { v[j] = xr[64 * j]; s += (v[j].x * v[j].x + v[j].y * v[j].y) + (v[j].z * v[j].z + v[j].w * v[j].w); }
        const float ssq = wave_sum(s), r = rsqrtf(ssq * (1.f / 1024.f) + EPS);
        GAS unsigned long long* o8 = (GAS unsigned long long*)(XB + (size_t)row * DM) + F.lane;
#pragma unroll
        for (int j = 0; j < 4; ++j) o8[64 * j] = (unsigned long long)pk2(v[j].x, v[j].y) | ((unsigned long long)pk2(v[j].z, v[j].w) << 32);
        if (F.lane < 16) SSQ0[(size_t)row * 16 + F.lane] = F.lane == 0 ? ssq : 0.f;
        f32x4 ga = (f32x4){0.f, 0.f, 0.f, 0.f}, gb = ga;
#pragma unroll
        for (int j = 0; j < 4; ++j)
#pragma unroll
            for (int e = 0; e < 4; ++e) { const int k = 4 * F.lane + 256 * j + e; const f32x4 w0 = *(const LAS f32x4*)(WG + k * 8), w1 = *(const LAS f32x4*)(WG + k * 8 + 4); ga += w0 * v[j][e]; gb += w1 * v[j][e]; }
        float outv = 0.f;
#pragma unroll
        for (int e = 0; e < 4; ++e) { const float gi = wave_sum(ga[e]) * r + F.b_gate[e]; const float gf = wave_sum(gb[e]) * r + F.b_gate[4 + e];
            if (F.lane == e) outv = gi; if (F.lane == 4 + e) outv = logsigmoidf_(gf); }
        if (F.lane < 8) GATES[(size_t)row * 8 + F.lane] = outv;
    }
}

__device__ __forceinline__ void scan_oracle(Frame& F) {
    const bf16* QKVO = WSP(bf16, WS_QKVO); const float* GATES = WSP(float, WS_GATES); float* HBUF = WSP(float, WS_HBUF);
    constexpr int NU_P = NB_P * NH * 32, NU_S = NB_S * NH * 32;
    for (int un = F.vcu; un < NU_P + NU_S; un += F.G) {
        const bool smp = un >= NU_P; const int uu = smp ? un - NU_P : un; const int vg = uu & 31, h = (uu >> 5) & 3, b = uu >> 7;
        const int S = smp ? S_S : S_P, rowbase = smp ? MP + b * S_S : b * S_P;
        const int v = 8 * vg + F.wave, d0 = 4 * F.lane;
        f32x4 C = (f32x4){0.f, 0.f, 0.f, 0.f}, n = C; float m = 0.f;
        if (smp) { C = *(const f32x4*)(F.stC + ((size_t)(b * NH + h) * DV + v) * DK + d0); n = *(const f32x4*)(F.stN + (size_t)(b * NH + h) * DK + d0); m = F.stM[b * NH + h]; }
        for (int t0 = 0; t0 < S; t0 += 8) {
            v2u qw[8], kw[8]; unsigned short vw[8]; float li[8], lf[8];
#pragma unroll
            for (int i = 0; i < 8; ++i) { const size_t row = (size_t)(rowbase + t0 + i); const bf16* bp = QKVO + row * NIN + 256 * h;
                qw[i] = *(const v2u*)(bp + d0); kw[i] = *(const v2u*)(bp + 1024 + d0); vw[i] = bp[2048 + v]; li[i] = GATES[row * 8 + h]; lf[i] = GATES[row * 8 + 4 + h]; }
#pragma unroll
            for (int i = 0; i < 8; ++i) {
                const float mn = fmaxf(lf[i] + m, li[i]), a = expf(lf[i] + m - mn), wi = expf(li[i] - mn), vf = bf2f(vw[i]) * wi;
                const f32x4 kf = (f32x4){bflo(kw[i].x), bfhi(kw[i].x), bflo(kw[i].y), bfhi(kw[i].y)}, qf = (f32x4){bflo(qw[i].x), bfhi(qw[i].x), bflo(qw[i].y), bfhi(qw[i].y)};
                C = C * a + kf * vf; n = n * a + kf * wi;
                float num = (C.x * qf.x + C.y * qf.y) + (C.z * qf.z + C.w * qf.w), den = (n.x * qf.x + n.y * qf.y) + (n.z * qf.z + n.w * qf.w);
                num = wave_sum(num); den = wave_sum(den);
                const float hv = num / fmaxf(fabsf(den), expf(-mn));
                if (F.lane == 0) HBUF[(size_t)(rowbase + t0 + i) * DM + 256 * h + v] = hv;
                m = mn;
            }
        }
        float* Co = F.out + (smp ? O_CS : O_CP) + ((size_t)(b * NH + h) * DV + v) * DK + d0; *(f32x4*)Co = C;
        if (vg == 0 && F.wave == 0) { *(f32x4*)(F.out + (smp ? O_NS : O_NP) + (size_t)(b * NH + h) * DK + d0) = n; if (F.lane == 0) F.out[(smp ? O_MS : O_MP) + b * NH + h] = m; }
    }
}
__device__ __forceinline__ void gate_pass(Frame& F) {
    const bf16* QKVO = WSP(bf16, WS_QKVO); const float* HBUF = WSP(float, WS_HBUF); bf16* A2 = WSP(bf16, WS_A2);
    const int gw = F.vcu * NWAVES + F.wave, NGW = F.G * NWAVES;
    for (int row = gw; row < MT; row += NGW) {
        const f32x4* hr = (const f32x4*)(HBUF + (size_t)row * DM) + F.lane; const v2u* orow = (const v2u*)(QKVO + (size_t)row * NIN + 3072) + F.lane; const f32x4* gr = (const f32x4*)F.head_norm + F.lane;
        v2u* o8 = (v2u*)(A2 + (size_t)row * DM) + F.lane;
#pragma unroll
        for (int j = 0; j < 4; ++j) { const f32x4 hv = hr[64 * j], g = gr[64 * j]; const v2u ow = orow[64 * j];
            const float ss = wave_sum((hv.x * hv.x + hv.y * hv.y) + (hv.z * hv.z + hv.w * hv.w)), rn = rsqrtf(ss * (1.f / 256.f) + EPS);
            v2u w; w.x = pk2(hv.x * rn * g.x * sigmoidf_(bflo(ow.x)), hv.y * rn * g.y * sigmoidf_(bfhi(ow.x))); w.y = pk2(hv.z * rn * g.z * sigmoidf_(bflo(ow.y)), hv.w * rn * g.w * sigmoidf_(bfhi(ow.y)));
            o8[64 * j] = w; }
    }
}
__device__ __forceinline__ void conv_pass(Frame& F) {
    const bf16* BG = WSP(bf16, WS_BG); const bf16* U = WSP(bf16, WS_U); bf16* A2 = WSP(bf16, WS_A2);
    const int gw = F.vcu * NWAVES + F.wave, NGW = F.G * NWAVES;
    for (int row = gw; row < MT; row += NGW) {
        const bool smp = row >= MP; const int t = smp ? (row - MP) & (S_S - 1) : row & (S_P - 1), b = smp ? (row - MP) >> 3 : row >> 11;
        const v2u* u0 = (const v2u*)(U + (size_t)row * DM) + F.lane; const v2u* bgr = (const v2u*)(BG + (size_t)row * DM) + F.lane; v2u* o8 = (v2u*)(A2 + (size_t)row * DM) + F.lane;
        const f32x4* sb = (const f32x4*)(F.stConv + (size_t)b * 2 * DM) + F.lane;
#pragma unroll
        for (int j = 0; j < 4; ++j) {
            const v2u uc = u0[64 * j], bw = bgr[64 * j];
            const f32x4 w0 = ((const f32x4*)F.w_taps + F.lane)[64 * j], w1 = ((const f32x4*)(F.w_taps + DM) + F.lane)[64 * j], w2 = ((const f32x4*)(F.w_taps + 2 * DM) + F.lane)[64 * j];
            f32x4 a = (f32x4){0.f, 0.f, 0.f, 0.f}, c = a;
            if (t >= 2) { const v2u w = (u0 - 2 * (DM / 4))[64 * j]; a = (f32x4){bflo(w.x), bfhi(w.x), bflo(w.y), bfhi(w.y)}; } else if (smp) a = sb[(t == 0 ? 0 : 256) + 64 * j];
            if (t >= 1) { const v2u w = (u0 - (DM / 4))[64 * j]; c = (f32x4){bflo(w.x), bfhi(w.x), bflo(w.y), bfhi(w.y)}; } else if (smp) c = sb[256 + 64 * j];
            const f32x4 cur = (f32x4){bflo(uc.x), bfhi(uc.x), bflo(uc.y), bfhi(uc.y)}, bg = (f32x4){bflo(bw.x), bfhi(bw.x), bflo(bw.y), bfhi(bw.y)};
            const f32x4 y = bg * (w0 * a + w1 * c + w2 * cur);
            v2u w; w.x = pk2(y.x, y.y); w.y = pk2(y.z, y.w); o8[64 * j] = w;
        }
    }
}
__device__ __forceinline__ void final_norm(Frame& F) {
    const int gw = F.vcu * NWAVES + F.wave, NGW = F.G * NWAVES;
    for (int row = gw; row < MT; row += NGW) {
        GAS f32x4* xr = (GAS f32x4*)(F.out + O_Y + (size_t)row * DM) + F.lane; const f32x4* gr = (const f32x4*)F.norm_final + F.lane;
        f32x4 v[4]; float s = 0.f;
#pragma unroll
        for (int j = 0; j < 4; ++j) { v[j] = xr[64 * j]; s += (v[j].x * v[j].x + v[j].y * v[j].y) + (v[j].z * v[j].z + v[j].w * v[j].w); }
        const float r = rsqrtf(wave_sum(s) * (1.f / 1024.f) + EPS);
#pragma unroll
        for (int j = 0; j < 4; ++j) xr[64 * j] = v[j] * r * gr[64 * j];
    }
}

#ifndef MK_N_LAUNCHES
#define MK_N_LAUNCHES 1
#endif
constexpr int N_PHASES = 13;
struct Args { const float* in[18]; float* out; unsigned char* ws; int ph_lo, ph_hi; };
__global__ void __launch_bounds__(NWAVES * 64, 2) fwd_kernel(Args args) {
    extern __shared__ __attribute__((aligned(16))) unsigned char lds[];
    Frame F;
    F.lds = (LAS unsigned char*)lds; F.MISC = (volatile LAS unsigned*)(F.lds + MISC_OFF);
    F.tid = threadIdx.x; F.lane = F.tid & 63; F.wave = __builtin_amdgcn_readfirstlane(F.tid >> 6);
    F.G = gridDim.x; { const int bx = blockIdx.x; F.vcu = (F.G % 8 == 0) ? (bx % 8) * (F.G / 8) + bx / 8 : bx; }
    F.ws = args.ws; F.out = args.out; F.ctl = (gu32*)(args.ws + WS_CTL);
    F.xp = args.in[0]; F.xs = args.in[1]; F.stC = args.in[2]; F.stN = args.in[3]; F.stM = args.in[4]; F.stConv = args.in[5]; F.norm_mix = args.in[6]; F.norm_ffn = args.in[7]; F.norm_final = args.in[8];
    F.w_in = args.in[9]; F.b_gate = args.in[10]; F.head_norm = args.in[11]; F.w_out = args.in[12]; F.w_cin = args.in[13]; F.w_taps = args.in[14]; F.w_cout = args.in[15]; F.w_gu = args.in[16]; F.w_dn = args.in[17];
    for (int u = F.tid; u < (LDS_BYTES - LDSCTL_OFF) / 4; u += NWAVES * 64) ((LAS unsigned*)(F.lds + LDSCTL_OFF))[u] = 0u;
    __syncthreads();
    XcdBarrier bar; bar.bar = (unsigned*)(F.ctl + CW_BAR); bar.x = 0; bar.st = nullptr;
    const int lo = args.ph_lo, hi = args.ph_hi;
    if (hi - lo > 1) bar = xcd_barrier_post((unsigned*)(F.ctl + CW_BAR), F.MISC + 8);
#define IN(k) (lo <= (k) && (k) < hi)
#define SEAM(k) do { if (IN(k) && IN((k) + 1)) xcd_barrier(bar); } while (0)
    bf16* XB = WSP(bf16, WS_XB); bf16* A2 = WSP(bf16, WS_A2); float* Y = F.out + O_Y;
    float* SSQ0 = WSP(float, WS_SSQ); float* SSQ1 = SSQ0 + (size_t)MT * 16; float* SSQ2 = SSQ1 + (size_t)MT * 16; float* SSQ3 = SSQ2 + (size_t)MT * 16;

    if (IN(0)) { p0_prologue(F); } SEAM(0);
    if (IN(1)) { pg8::Gemm g{XB, WSP(bf16, WS_W_IN), MT, NIN, DM}; ep::EpiScale E{WSP(bf16, WS_QKVO), NIN, SSQ0}; run_gemm<ep::EpiScale, true, true>(F, g, E); } SEAM(1);
    if (IN(2)) { scan_oracle(F); } SEAM(2);
    if (IN(3)) { gate_pass(F); } SEAM(3);
    if (IN(4)) { pg8::Gemm g{A2, WSP(bf16, WS_W_OUT), MT, DM, DM}; ep::EpiResid<true> E{F.xp, F.xs, Y, XB, SSQ1}; run_gemm<ep::EpiResid<true>, true, true>(F, g, E); } SEAM(4);
    if (IN(5)) { pg8::Gemm g{XB, WSP(bf16, WS_W_GU0), MT, NGU, DM}; ep::EpiSwiGLU E{WSP(bf16, WS_HFF), SSQ1}; run_gemm<ep::EpiSwiGLU, true, true>(F, g, E); } SEAM(5);
    if (IN(6)) { pg8::Gemm g{WSP(bf16, WS_HFF), WSP(bf16, WS_W_DN0), MT, DM, DFF}; ep::EpiResid<true> E{Y, Y + (size_t)MP * DM, Y, XB, SSQ2}; run_gemm<ep::EpiResid<true>, true, true>(F, g, E); } SEAM(6);
    if (IN(7)) { pg8::Gemm g{XB, WSP(bf16, WS_W_CIN), MT, NCIN, DM}; ep::EpiConvIn E{WSP(bf16, WS_BG), WSP(bf16, WS_U), SSQ2, F.out + O_CVP, F.out + O_CVS}; run_gemm<ep::EpiConvIn, true, true>(F, g, E); } SEAM(7);
    if (IN(8)) { conv_pass(F); } SEAM(8);
    if (IN(9)) { pg8::Gemm g{A2, WSP(bf16, WS_W_COUT), MT, DM, DM}; ep::EpiResid<true> E{Y, Y + (size_t)MP * DM, Y, XB, SSQ3}; run_gemm<ep::EpiResid<true>, true, true>(F, g, E); } SEAM(9);
    if (IN(10)) { pg8::Gemm g{XB, WSP(bf16, WS_W_GU1), MT, NGU, DM}; ep::EpiSwiGLU E{WSP(bf16, WS_HFF), SSQ3}; run_gemm<ep::EpiSwiGLU, true, true>(F, g, E); } SEAM(10);
    if (IN(11)) { pg8::Gemm g{WSP(bf16, WS_HFF), WSP(bf16, WS_W_DN1), MT, DM, DFF}; ep::EpiResid<false> E{Y, Y + (size_t)MP * DM, Y, nullptr, nullptr}; run_gemm<ep::EpiResid<false>, true, true>(F, g, E); } SEAM(11);
    if (IN(12)) { final_norm(F); }
#undef IN
#undef SEAM
}

extern "C" void kernel_launch(void* const* d_in, const int* in_sizes, int n_in, void* d_out, int out_size, void* d_ws, size_t ws_size, hipStream_t stream) {
    static int grid = 0;
    if (grid == 0) {
        if (n_in != 18 || in_sizes[0] != MP * DM || (size_t)out_size != O_END || ws_size < WS_END) { fprintf(stderr, "kernel_launch: unexpected shapes: n_in %d in0 %d out %d ws %zu (need out %zu ws %zu)\n", n_in, n_in > 0 ? in_sizes[0] : -1, out_size, ws_size, (size_t)O_END, (size_t)WS_END); grid = -1; return; }
        int dev = 0, cus = 0;
        if (hipGetDevice(&dev) != hipSuccess || hipDeviceGetAttribute(&cus, hipDeviceAttributeMultiprocessorCount, dev) != hipSuccess) { grid = -1; return; }
        if (hipFuncSetAttribute((const void*)fwd_kernel, hipFuncAttributeMaxDynamicSharedMemorySize, LDS_BYTES) != hipSuccess) { fprintf(stderr, "kernel_launch: hipFuncSetAttribute failed\n"); grid = -1; return; }
        (void)hipGetLastError();
        grid = cus;
    }
    if (grid < 0) return;
    (void)hipMemsetAsync((char*)d_ws + WS_CTL, 0, CTL_ZERO_BYTES, stream);
    Args a{};
    for (int i = 0; i < 18; ++i) a.in[i] = (const float*)d_in[i];
    a.out = (float*)d_out; a.ws = (unsigned char*)d_ws;
#if MK_N_LAUNCHES == 1
    a.ph_lo = 0; a.ph_hi = N_PHASES;
    hipLaunchKernelGGL(fwd_kernel, dim3(grid), dim3(NWAVES * 64), LDS_BYTES, stream, a);
#else
    for (int p = 0; p < N_PHASES; ++p) { a.ph_lo = p; a.ph_hi = p + 1; hipLaunchKernelGGL(fwd_kernel, dim3(grid), dim3(NWAVES * 64), LDS_BYTES, stream, a); }
#endif
}
```

```cpp
#include <hip/hip_runtime.h>
#include <cstdio>
#include <cstdint>
#include <cmath>
#define USE_SLOW_GEMM 0
#define MK_N_LAUNCHES 1
#define SCAN_MODE 3
namespace pg8 {
#define PG8_LAS __attribute__((address_space(3)))
typedef unsigned short bf16_t;
typedef short bf16x8 __attribute__((ext_vector_type(8)));
typedef float f32x4 __attribute__((ext_vector_type(4)));
typedef unsigned u32x4 __attribute__((ext_vector_type(4)));
constexpr int BM = 256, BK = 64, HALF = 128, HTB = HALF * BK * 2  , STAGE_BYTES = 8 * HTB, NXCD = 8, WGM = 8;

__host__ __device__ __forceinline__ int lds_byte(int r, int c) { const int st = (r >> 4) * 2 + (c >> 5), rr = r & 15, cc = c & 31, ob = rr * 64 + cc * 2; return st * 1024 + (ob ^ (((ob >> 9) & 1) << 5)); }
__host__ __device__ __forceinline__ void stage_rc(int b, int& R, int& C) { const int st = b / 1024, sb = b % 1024, swz = sb ^ (((sb >> 9) & 1) << 5); R = (st >> 1) * 16 + swz / 64; C = (st & 1) * 32 + (swz % 64) / 2; }
__host__ __device__ __forceinline__ int perm32(int rho) { const int n = rho >> 4, i = rho & 15; return 8 * (i >> 2) + 4 * n + (i & 3); }

struct Unit { int pm, pn; };
struct Gemm { const bf16_t* A; const bf16_t* Bt; int M, N, K; };

struct StaticOrder {
    int nM, nN, nwg, G, c;
    __host__ __device__ void init(int M, int N, int G_, int c_) { nM = M / BM; nN = N / BM; nwg = nM * nN; G = G_; c = c_; }
    __host__ __device__ bool next(int i, Unit& u) const {
        const long L = (long)i * G + c; if (L >= nwg) return false;
        int wgid = (int)L; { const int q = nwg / NXCD, r = nwg % NXCD, xcd = wgid % NXCD, off = wgid / NXCD; wgid = (xcd < r ? xcd * (q + 1) : r * (q + 1) + (xcd - r) * q) + off; }
        const int nig = WGM * nN, gid = wgid / nig, fm = gid * WGM, gsz = (nM - fm) < WGM ? (nM - fm) : WGM;
        u.pm = fm + ((wgid % nig) % gsz); u.pn = (wgid % nig) / gsz; return true;
    }
    __device__ __forceinline__ void a_ready(const Unit&) const {}
    __device__ __forceinline__ void done(const Unit&) const {}
};

__device__ __forceinline__ unsigned cvt_pk_bf16(float lo, float hi) { unsigned r; asm volatile("v_cvt_pk_bf16_f32 %0, %1, %2" : "=v"(r) : "v"(lo), "v"(hi)); return r; }
template <class Epi, class Sched, bool ALIGN_EPI = false, bool SP2 = false>
__device__ __forceinline__ void gemm_phase(PG8_LAS unsigned char* lds, const Gemm g, const Sched& S, const Epi& E) {
    const int tid = threadIdx.x, wid = __builtin_amdgcn_readfirstlane(tid >> 6), lane = tid & 63, wr = wid >> 2, wc = wid & 3, fr = lane & 15, fq = lane >> 4;
    const int K = g.K, nt = K / BK;
    unsigned voffA[2], voffB[2];
#pragma unroll
    for (int i = 0; i < 2; ++i) { int R, C; stage_rc(tid * 16 + i * 8192, R, C); const int Rb = Epi::PERM ? ((R & ~31) + perm32(R & 31)) : R;
        voffA[i] = (unsigned)(R * K + C) * 2u; voffB[i] = (unsigned)(Rb * K + C) * 2u; }
    const size_t kstep = (size_t)(BK * 2);
    const size_t hstep = (size_t)HALF * K * 2;
    const size_t tstep = 2 * hstep;
    const unsigned ldsw = (unsigned)wid * 1024u;
    const int aoff = lds_byte(wr * 64 + fr, fq * 8), boff = lds_byte(wc * 32 + fr, fq * 8);
#define PG8_SA(b, h) (((b) * 2 + (h)) * HTB)
#define PG8_SB(b, h) ((4 + (b) * 2 + (h)) * HTB)
#define PG8_STAGE(bufoff, gbase, voff) do { _Pragma("unroll") for (int _i = 0; _i < 2; ++_i) \
        __builtin_amdgcn_global_load_lds((const unsigned*)((const char*)(gbase) + (voff)[_i]), (PG8_LAS unsigned*)(lds + (bufoff) + ldsw + _i * 8192), 16, 0, 0); } while (0)
#define PG8_LDA(dst, b, h) do { _Pragma("unroll") for (int m = 0; m < 4; ++m) _Pragma("unroll") for (int k = 0; k < 2; ++k) dst[m][k] = *(const PG8_LAS bf16x8*)(lds + PG8_SA(b, h) + aoff + m * 2048 + k * 1024); } while (0)
#define PG8_LDB(dst, b, h) do { _Pragma("unroll") for (int n = 0; n < 2; ++n) _Pragma("unroll") for (int k = 0; k < 2; ++k) dst[n][k] = *(const PG8_LAS bf16x8*)(lds + PG8_SB(b, h) + boff + n * 2048 + k * 1024); } while (0)
#define PG8_MMA(ai, bj, At, Bt) do { __builtin_amdgcn_s_setprio(1); _Pragma("unroll") for (int m = 0; m < 4; ++m) _Pragma("unroll") for (int n = 0; n < 2; ++n) _Pragma("unroll") for (int k = 0; k < 2; ++k) \
        acc[ai][bj][m][n] = __builtin_amdgcn_mfma_f32_16x16x32_bf16(Bt[n][k], At[m][k], acc[ai][bj][m][n], 0, 0, 0); __builtin_amdgcn_s_setprio(0); } while (0)
#define PG8_WAIT_V(n) asm volatile("s_waitcnt vmcnt(" #n ")" ::: "memory")
#define PG8_WAIT_L(n) asm volatile("s_waitcnt lgkmcnt(" #n ")" ::: "memory")
#define PG8_BAR __builtin_amdgcn_s_barrier()
#define PG8_SCHED __builtin_amdgcn_sched_barrier(0)
    Unit cur, nxt; int ui = 0;
    if (!S.next(0, cur)) return;
    f32x4 acc[2][2][4][2];
#pragma unroll
    for (int a = 0; a < 2; ++a)
#pragma unroll
        for (int b = 0; b < 2; ++b)
#pragma unroll
            for (int m = 0; m < 4; ++m)
#pragma unroll
                for (int n = 0; n < 2; ++n) acc[a][b][m][n] = (f32x4){0.f, 0.f, 0.f, 0.f};
    bf16x8 At[4][2], B0[2][2], B1[2][2];
    const char* cA = (const char*)g.A + (size_t)cur.pm * tstep; const char* cB = (const char*)g.Bt + (size_t)cur.pn * tstep;
    S.a_ready(cur);
    if constexpr (SP2) {
        PG8_STAGE(PG8_SB(0, 0), cB, voffB); PG8_STAGE(PG8_SB(0, 1), cB + hstep, voffB); PG8_STAGE(PG8_SA(0, 0), cA, voffA); PG8_STAGE(PG8_SA(0, 1), cA + hstep, voffA);
        if (wr == 1) PG8_BAR;
        PG8_WAIT_V(2); PG8_BAR;
        PG8_STAGE(PG8_SB(1, 0), cB + kstep, voffB); PG8_STAGE(PG8_SA(1, 0), cA + kstep, voffA); PG8_STAGE(PG8_SB(1, 1), cB + hstep + kstep, voffB);
        PG8_WAIT_V(6); PG8_BAR;
    } else {
        PG8_STAGE(PG8_SB(0, 0), cB, voffB); PG8_STAGE(PG8_SA(0, 0), cA, voffA); PG8_STAGE(PG8_SB(0, 1), cB + hstep, voffB); PG8_STAGE(PG8_SA(0, 1), cA + hstep, voffA);
        if (wr == 1) PG8_BAR;
        PG8_WAIT_V(4); PG8_BAR;
        PG8_STAGE(PG8_SB(1, 0), cB + kstep, voffB); PG8_STAGE(PG8_SA(1, 0), cA + kstep, voffA); PG8_STAGE(PG8_SB(1, 1), cB + hstep + kstep, voffB);
        PG8_WAIT_V(6); PG8_BAR;
    }
    for (;;) {
        const bool has_next = S.next(ui + 1, nxt);
        const char* nA = has_next ? (const char*)g.A + (size_t)nxt.pm * tstep : cA; const char* nB = has_next ? (const char*)g.Bt + (size_t)nxt.pn * tstep : cB;
        for (int t = 0; t < nt; t += 2) {
            const bool last = (t == nt - 2);
            const char* a1 = cA + (size_t)(t + 1) * kstep;
            const char* a2 = last ? nA : cA + (size_t)(t + 2) * kstep; const char* b2 = last ? nB : cB + (size_t)(t + 2) * kstep;
            const char* a3 = a2 + kstep; const char* b3 = b2 + kstep;
            if (last && has_next) S.a_ready(nxt);
            if constexpr (SP2) {
            PG8_LDB(B0, 0, 0); PG8_LDB(B1, 0, 1); PG8_SCHED; PG8_LDA(At, 0, 0); PG8_STAGE(PG8_SA(1, 1), a1 + hstep, voffA);
            PG8_WAIT_V(8); PG8_WAIT_L(0); PG8_BAR; PG8_MMA(0, 0, At, B0); PG8_MMA(0, 1, At, B1); PG8_BAR; PG8_SCHED;
            PG8_LDA(At, 0, 1); PG8_STAGE(PG8_SB(0, 0), b2, voffB); PG8_STAGE(PG8_SB(0, 1), b2 + hstep, voffB); PG8_STAGE(PG8_SA(0, 0), a2, voffA);
            PG8_WAIT_V(8); PG8_WAIT_L(0); PG8_BAR; PG8_MMA(1, 0, At, B0); PG8_MMA(1, 1, At, B1); PG8_BAR; PG8_SCHED;
            PG8_LDB(B0, 1, 0); PG8_LDB(B1, 1, 1); PG8_SCHED; PG8_LDA(At, 1, 0); PG8_STAGE(PG8_SA(0, 1), a2 + hstep, voffA);
            PG8_WAIT_V(8); PG8_WAIT_L(0); PG8_BAR; PG8_MMA(0, 0, At, B0); PG8_MMA(0, 1, At, B1); PG8_BAR; PG8_SCHED;
            PG8_LDA(At, 1, 1); PG8_STAGE(PG8_SB(1, 0), b3, voffB); PG8_STAGE(PG8_SB(1, 1), b3 + hstep, voffB); PG8_STAGE(PG8_SA(1, 0), a3, voffA);
            PG8_WAIT_V(8); PG8_WAIT_L(0); PG8_BAR; PG8_MMA(1, 0, At, B0); PG8_MMA(1, 1, At, B1); PG8_BAR; PG8_SCHED;
            } else {
            PG8_LDB(B0, 0, 0); PG8_SCHED; PG8_LDA(At, 0, 0); PG8_STAGE(PG8_SA(1, 1), a1 + hstep, voffA);
            PG8_WAIT_L(8); PG8_BAR; PG8_WAIT_L(0); PG8_MMA(0, 0, At, B0); PG8_BAR; PG8_SCHED;
            PG8_LDB(B1, 0, 1); PG8_STAGE(PG8_SB(0, 0), b2, voffB);
            PG8_BAR; PG8_WAIT_L(0); PG8_MMA(0, 1, At, B1); PG8_BAR;
            PG8_LDA(At, 0, 1); PG8_STAGE(PG8_SA(0, 0), a2, voffA);
            PG8_BAR; PG8_WAIT_L(0); PG8_MMA(1, 0, At, B0); PG8_BAR; PG8_SCHED;
            PG8_STAGE(PG8_SB(0, 1), b2 + hstep, voffB);
            PG8_WAIT_V(6); PG8_BAR; PG8_MMA(1, 1, At, B1); PG8_BAR;
            PG8_LDB(B0, 1, 0); PG8_SCHED; PG8_LDA(At, 1, 0); PG8_STAGE(PG8_SA(0, 1), a2 + hstep, voffA);
            PG8_WAIT_L(8); PG8_BAR; PG8_WAIT_L(0); PG8_MMA(0, 0, At, B0); PG8_BAR; PG8_SCHED;
            PG8_LDB(B1, 1, 1); PG8_STAGE(PG8_SB(1, 0), b3, voffB);
            PG8_BAR; PG8_WAIT_L(0); PG8_MMA(0, 1, At, B1); PG8_BAR;
            PG8_LDA(At, 1, 1); PG8_STAGE(PG8_SA(1, 0), a3, voffA);
            PG8_BAR; PG8_WAIT_L(0); PG8_MMA(1, 0, At, B0); PG8_BAR; PG8_SCHED;
            PG8_STAGE(PG8_SB(1, 1), b3 + hstep, voffB);
            PG8_WAIT_V(6); PG8_BAR; PG8_MMA(1, 1, At, B1); PG8_BAR;
            }
        }
        if constexpr (ALIGN_EPI) { if (wr == 0) PG8_BAR; }
        if constexpr (!Epi::AFTER_DRAIN) { E(acc, cur, wr, wc, fr, fq); S.done(cur); }
        if (!has_next) break;
#pragma unroll
        for (int a = 0; a < 2; ++a)
#pragma unroll
            for (int b = 0; b < 2; ++b)
#pragma unroll
                for (int m = 0; m < 4; ++m)
#pragma unroll
                    for (int n = 0; n < 2; ++n) acc[a][b][m][n] = (f32x4){0.f, 0.f, 0.f, 0.f};
        cur = nxt; cA = nA; cB = nB; ++ui;
        if constexpr (ALIGN_EPI) { if (wr == 1) PG8_BAR; }
    }
    PG8_WAIT_V(0);
    if constexpr (!ALIGN_EPI) { if (wr == 0) PG8_BAR; }
    PG8_BAR;
    if constexpr (Epi::AFTER_DRAIN) { E.fused(acc, cur, wr, wc, fr, fq, lds, wid, lane); S.done(cur); }
#undef PG8_SA
#undef PG8_SB
#undef PG8_STAGE
#undef PG8_LDA
#undef PG8_LDB
#undef PG8_MMA
#undef PG8_WAIT_V
#undef PG8_WAIT_L
#undef PG8_BAR
#undef PG8_SCHED
}
}
constexpr int DM = 1024;
constexpr int NB_P = 8, S_P = 2048, NB_S = 128, S_S = 8;
constexpr int MP = NB_P * S_P, MS = NB_S * S_S, MT = MP + MS;
constexpr int NH = 4, DK = 256, DV = 256;
constexpr int NIN = 4096, NIN_SRC = 4104;
constexpr int DFF = 2816, NGU = 2 * DFF, NCIN = 3 * DM;
constexpr float EPS = 1e-6f;
constexpr int NWAVES = 8;

constexpr size_t O_Y = 0;
constexpr size_t O_CP = (size_t)MT * DM;
constexpr size_t O_NP = O_CP + (size_t)NB_P * NH * DV * DK;
constexpr size_t O_MP = O_NP + (size_t)NB_P * NH * DK;
constexpr size_t O_CVP = O_MP + (size_t)NB_P * NH;
constexpr size_t O_CS = O_CVP + (size_t)NB_P * 2 * DM;
constexpr size_t O_NS = O_CS + (size_t)NB_S * NH * DV * DK;
constexpr size_t O_MS = O_NS + (size_t)NB_S * NH * DK;
constexpr size_t O_CVS = O_MS + (size_t)NB_S * NH;
constexpr size_t O_END = O_CVS + (size_t)NB_S * 2 * DM;

constexpr size_t MiB = 1u << 20;
constexpr size_t WS_CTL = 0, CTL_ZERO_BYTES = 1 * MiB;
constexpr size_t WS_W_IN = 2 * MiB, WS_W_OUT = 10 * MiB, WS_W_GU0 = 12 * MiB, WS_W_DN0 = 23 * MiB, WS_W_CIN = 29 * MiB, WS_W_COUT = 35 * MiB, WS_W_GU1 = 37 * MiB, WS_W_DN1 = 48 * MiB;
constexpr size_t SSQ_BYTES = (size_t)MT * 16 * 4;
constexpr size_t WS_SSQ = 54 * MiB;
constexpr size_t WS_GATES = 59 * MiB;
constexpr size_t WS_XB = 60 * MiB;
constexpr size_t WS_A2 = 94 * MiB;
constexpr size_t WS_QKVO = 128 * MiB;
constexpr size_t WS_HFF = 128 * MiB;
constexpr size_t WS_BG = 128 * MiB, WS_U = 162 * MiB;
constexpr size_t WS_HBUF = 264 * MiB;
constexpr size_t WS_CST = 332 * MiB;
constexpr size_t WS_NST = 396 * MiB;
constexpr size_t WS_MST = WS_NST + (size_t)32 * 16 * 256 * 4;
constexpr size_t WS_END = 398 * MiB;
static_assert(WS_SSQ + 4 * SSQ_BYTES <= WS_GATES && WS_GATES + (size_t)MT * 8 * 4 <= WS_XB && WS_XB + (size_t)MT * DM * 2 <= WS_A2 && WS_A2 + (size_t)MT * DM * 2 <= WS_QKVO, "ws map");
static_assert(WS_QKVO + (size_t)MT * NIN * 2 <= WS_HBUF && WS_HFF + (size_t)MT * DFF * 2 <= WS_HBUF && WS_U + (size_t)MT * DM * 2 <= WS_HBUF && WS_HBUF + (size_t)MT * DM * 4 <= WS_END, "ws map 2");
static_assert(WS_W_DN1 + (size_t)DM * DFF * 2 <= WS_SSQ, "ws map 3");
constexpr int CW_BAR = 4096;

constexpr int RING_OFF = 0, RING_BYTES = 131072;
constexpr int LDSCTL_OFF = RING_BYTES, MISC_OFF = LDSCTL_OFF + 320;
constexpr int SCR_OFF = 132096;
constexpr int LDS_BYTES = 163840;

#define GAS __attribute__((address_space(1)))
#define LAS __attribute__((address_space(3)))
typedef unsigned short bf16;
typedef unsigned v4u __attribute__((ext_vector_type(4)));
typedef unsigned v2u __attribute__((ext_vector_type(2)));
typedef float f32x4 __attribute__((ext_vector_type(4)));
typedef short bf16x8 __attribute__((ext_vector_type(8)));
typedef GAS unsigned gu32;
typedef GAS unsigned long long gu64;
#define RLX_AGENT __ATOMIC_RELAXED, __HIP_MEMORY_SCOPE_AGENT
#define LDS_WAIT() asm volatile("s_waitcnt lgkmcnt(0)" ::: "memory")
#define VM_WAIT() asm volatile("s_waitcnt vmcnt(0)" ::: "memory")
__device__ __forceinline__ unsigned f2bf(float f) { unsigned u = __builtin_bit_cast(unsigned, f); return (u + 0x7fffu + ((u >> 16) & 1u)) >> 16; }
__device__ __forceinline__ unsigned pk2(float lo, float hi) { return f2bf(lo) | (f2bf(hi) << 16); }
__device__ __forceinline__ float bf2f(unsigned short s) { return __builtin_bit_cast(float, (unsigned)s << 16); }
__device__ __forceinline__ float bflo(unsigned w) { return __builtin_bit_cast(float, w << 16); }
__device__ __forceinline__ float bfhi(unsigned w) { return __builtin_bit_cast(float, w & 0xffff0000u); }
__device__ __forceinline__ float wave_sum(float v) {
#pragma unroll
    for (int o = 1; o < 64; o <<= 1) v += __shfl_xor(v, o);
    return v;
}
__device__ __forceinline__ float sigmoidf_(float x) { return 1.f / (1.f + __expf(-x)); }
__device__ __forceinline__ float logsigmoidf_(float x) { return fminf(x, 0.f) - log1pf(expf(-fabsf(x))); }
#define XB_TMO      128
#define XB_XCNT(j)  (256  + 64 * (j))
#define XB_XSUB(j)  (1280 + 64 * (j))
#define XB_XGEN(j)  (2304 + 64 * (j))
#define XB_TOP      3328
#define XB_TOPGEN   3392
#define XCD_BAR_WORDS 3456
#define XB_SPIN_CAP (1u << 18)

__device__ __forceinline__ unsigned xb_ld(unsigned* p)              { return __hip_atomic_load(p, __ATOMIC_RELAXED, __HIP_MEMORY_SCOPE_AGENT); }
__device__ __forceinline__ unsigned xb_add(unsigned* p, unsigned v) { return __hip_atomic_fetch_add(p, v, __ATOMIC_RELAXED, __HIP_MEMORY_SCOPE_AGENT); }
__device__ __forceinline__ unsigned xb_xcc_id() { return (unsigned)__builtin_amdgcn_s_getreg((3 << 11) | 20) & 0xFu; }
#define XB_SPIN(cond, bar) do { unsigned _sp = 0; while (cond) { __builtin_amdgcn_s_sleep(1); \
    if ((++_sp & 255u) == 0u) { if (xb_ld(&(bar)[XB_TMO])) break; if (_sp > XB_SPIN_CAP) { atomicAdd(&(bar)[XB_TMO], 1u); break; } } } } while (0)

struct XcdBarrier {
    unsigned* bar; unsigned x;
    volatile LAS unsigned* st;
};

__device__ __forceinline__ XcdBarrier xcd_barrier_post(unsigned* bar, volatile LAS unsigned* st) {
    XcdBarrier b; b.bar = bar; b.x = xb_xcc_id(); b.st = st;
    if (threadIdx.x == 0) (void)xb_add(&bar[XB_XCNT(b.x)], 1u);
    return b;
}
__device__ __forceinline__ void xcd_barrier_complete(unsigned* bar, unsigned x, unsigned& nloc, unsigned& nx) {
    const unsigned G = gridDim.x * gridDim.y * gridDim.z;
    unsigned sum, cnt, mine, sp = 0u;
    for (;;) {
        sum = 0u; cnt = 0u; mine = 0u;
#pragma unroll
        for (unsigned j = 0; j < 16; ++j) { const unsigned c = xb_ld(&bar[XB_XCNT(j)]); sum += c; cnt += (c > 0u) ? 1u : 0u; mine = (j == x) ? c : mine; }
        if (sum == G) break;
        __builtin_amdgcn_s_sleep(1);
        if ((++sp & 255u) == 0u) { if (xb_ld(&bar[XB_TMO])) break; if (sp > XB_SPIN_CAP) { atomicAdd(&bar[XB_TMO], 1u); break; } }
    }
    nloc = mine > 0u ? mine : 1u; nx = cnt > 0u ? cnt : 1u;
}

__device__ __forceinline__ void xcd_barrier(const XcdBarrier& b) {
    asm volatile("s_waitcnt vmcnt(0)" ::: "memory");
    __syncthreads();
    if (threadIdx.x == 0) {
        unsigned* bar = b.bar;
        __builtin_amdgcn_s_waitcnt(0);
        unsigned nloc = b.st[0], nx = b.st[1];
        if (nloc == 0u) { xcd_barrier_complete(bar, b.x, nloc, nx); b.st[0] = nloc; b.st[1] = nx; }
        const unsigned old = xb_add(&bar[XB_XSUB(b.x)], 1u);
        const unsigned gen = old / nloc;
        if (old + 1u == (gen + 1u) * nloc) {
            __builtin_amdgcn_fence(__ATOMIC_RELEASE, "agent");
            asm volatile("s_waitcnt vmcnt(0)" ::: "memory");
            const unsigned og = xb_add(&bar[XB_TOP], 1u);
            const unsigned tg = og / nx;
            if (og + 1u == (tg + 1u) * nx) xb_add(&bar[XB_TOPGEN], 1u);
            else XB_SPIN(xb_ld(&bar[XB_TOPGEN]) == tg, bar);
            __builtin_amdgcn_fence(__ATOMIC_ACQUIRE, "agent");
            xb_add(&bar[XB_XGEN(b.x)], 1u);
            asm volatile("s_waitcnt vmcnt(0)" ::: "memory");
        } else {
            XB_SPIN(xb_ld(&bar[XB_XGEN(b.x)]) == gen, bar);
            __builtin_amdgcn_fence(__ATOMIC_ACQUIRE, "agent");
            asm volatile("s_waitcnt vmcnt(0)" ::: "memory");
        }
    }
    __syncthreads();
}
struct Frame {
    LAS unsigned char* lds;
    volatile LAS unsigned* MISC;
    gu32* ctl;
    int tid, lane, wave, vcu, G;
    const float *xp, *xs, *stC, *stN, *stM, *stConv, *norm_mix, *norm_ffn, *norm_final, *w_in, *b_gate, *head_norm, *w_out, *w_cin, *w_taps, *w_cout, *w_gu, *w_dn;
    float* out; unsigned char* ws;
};
#define WSP(T, off) ((T*)(F.ws + (off)))

namespace ep {
using pg8::Unit; using pg8::bf16_t; using pg8::cvt_pk_bf16; using pg8::BM; using pg8::HALF; using pg8::u32x4;
__device__ __forceinline__ float row_rs(const float* slab, int row) {
    const f32x4* p = (const f32x4*)(slab + (size_t)row * 16);
    const f32x4 a = p[0], b = p[1], c = p[2], d = p[3];
    const float s = (((a.x + a.y) + (a.z + a.w)) + ((b.x + b.y) + (b.z + b.w))) + (((c.x + c.y) + (c.z + c.w)) + ((d.x + d.y) + (d.z + d.w)));
    return rsqrtf(s * (1.f / 1024.f) + EPS);
}
__device__ __forceinline__ u32x4 pack8(const f32x4 v0, const f32x4 v1) { u32x4 w; w.x = cvt_pk_bf16(v0[0], v0[1]); w.y = cvt_pk_bf16(v0[2], v0[3]); w.z = cvt_pk_bf16(v1[0], v1[1]); w.w = cvt_pk_bf16(v1[2], v1[3]); return w; }

struct EpiScale {
    static constexpr bool PERM = true, AFTER_DRAIN = false;
    bf16_t* O; int ldc; const float* ssq;
    __device__ __forceinline__ void operator()(const f32x4 (&acc)[2][2][4][2], const Unit& u, int wr, int wc, int fr, int fq) const {
        const int row0 = u.pm * BM + wr * 64 + fr, col0 = u.pn * BM + wc * 32 + 8 * fq;
#pragma unroll
        for (int ai = 0; ai < 2; ++ai)
#pragma unroll
            for (int m = 0; m < 4; ++m) { const int row = row0 + ai * HALF + m * 16; const float r = row_rs(ssq, row); bf16_t* rowp = O + (size_t)row * ldc + col0;
#pragma unroll
                for (int bj = 0; bj < 2; ++bj) *(u32x4*)(rowp + bj * HALF) = pack8(acc[ai][bj][m][0] * r, acc[ai][bj][m][1] * r); }
    }
};
__device__ __forceinline__ float silu_mul(float g, float u) { return g / (1.f + __expf(-g)) * u; }
struct EpiSwiGLU {
    static constexpr bool PERM = true, AFTER_DRAIN = false;
    bf16_t* O; const float* ssq;
    __device__ __forceinline__ void operator()(const f32x4 (&acc)[2][2][4][2], const Unit& u, int wr, int wc, int fr, int fq) const {
        const int row0 = u.pm * BM + wr * 64 + fr, col0 = u.pn * HALF + wc * 32 + 8 * fq;
#pragma unroll
        for (int ai = 0; ai < 2; ++ai)
#pragma unroll
            for (int m = 0; m < 4; ++m) { const int row = row0 + ai * HALF + m * 16; const float r = row_rs(ssq, row);
                const f32x4 g0 = acc[ai][0][m][0] * r, g1 = acc[ai][0][m][1] * r, u0 = acc[ai][1][m][0] * r, u1 = acc[ai][1][m][1] * r;
                f32x4 h0, h1;
#pragma unroll
                for (int j = 0; j < 4; ++j) { h0[j] = silu_mul(g0[j], u0[j]); h1[j] = silu_mul(g1[j], u1[j]); }
                *(u32x4*)(O + (size_t)row * DFF + col0) = pack8(h0, h1); }
    }
};
template <bool WB> struct EpiResid {
    static constexpr bool PERM = true, AFTER_DRAIN = false;
    const float* baseP; const float* baseS; float* out; bf16_t* XB; float* ssq;
    __device__ __forceinline__ void operator()(const f32x4 (&acc)[2][2][4][2], const Unit& u, int wr, int wc, int fr, int fq) const {
        const int row0 = u.pm * BM + wr * 64 + fr, col0 = u.pn * BM + wc * 32 + 8 * fq;
#pragma unroll
        for (int ai = 0; ai < 2; ++ai)
#pragma unroll
            for (int m = 0; m < 4; ++m) { const int row = row0 + ai * HALF + m * 16;
                const float* bp = (row < MP ? baseP + (size_t)row * DM : baseS + (size_t)(row - MP) * DM) + col0; float* op = out + (size_t)row * DM + col0;
                float ss = 0.f;
#pragma unroll
                for (int bj = 0; bj < 2; ++bj) { const f32x4 x0 = *(const f32x4*)(bp + bj * HALF) + acc[ai][bj][m][0], x1 = *(const f32x4*)(bp + bj * HALF + 4) + acc[ai][bj][m][1];
                    *(f32x4*)(op + bj * HALF) = x0; *(f32x4*)(op + bj * HALF + 4) = x1;
                    if (WB) { *(u32x4*)(XB + (size_t)row * DM + col0 + bj * HALF) = pack8(x0, x1);
                        ss += ((x0[0] * x0[0] + x0[1] * x0[1]) + (x0[2] * x0[2] + x0[3] * x0[3])) + ((x1[0] * x1[0] + x1[1] * x1[1]) + (x1[2] * x1[2] + x1[3] * x1[3])); } }
                if (WB) { ss += __shfl_xor(ss, 16); ss += __shfl_xor(ss, 32); if (fq == 0) ssq[(size_t)row * 16 + u.pn * 4 + wc] = ss; } }
    }
};
struct EpiConvIn {
    static constexpr bool PERM = true, AFTER_DRAIN = false;
    bf16_t* BG; bf16_t* U; const float* ssq; float* cvP; float* cvS;
    __device__ __forceinline__ void operator()(const f32x4 (&acc)[2][2][4][2], const Unit& u, int wr, int wc, int fr, int fq) const {
        const int row0 = u.pm * BM + wr * 64 + fr;
        if (u.pn < 4) {
            const int col0 = u.pn * BM + wc * 32 + 8 * fq;
#pragma unroll
            for (int ai = 0; ai < 2; ++ai)
#pragma unroll
                for (int m = 0; m < 4; ++m) { const int row = row0 + ai * HALF + m * 16; const float r = row_rs(ssq, row); bf16_t* rowp = BG + (size_t)row * DM + col0;
#pragma unroll
                    for (int bj = 0; bj < 2; ++bj) *(u32x4*)(rowp + bj * HALF) = pack8(acc[ai][bj][m][0] * r, acc[ai][bj][m][1] * r); }
        } else {
            const int col0 = (u.pn - 4) * HALF + wc * 32 + 8 * fq;
#pragma unroll
            for (int ai = 0; ai < 2; ++ai)
#pragma unroll
                for (int m = 0; m < 4; ++m) { const int row = row0 + ai * HALF + m * 16; const float r = row_rs(ssq, row);
                    const f32x4 p0 = (acc[ai][0][m][0] * r) * (acc[ai][1][m][0] * r), p1 = (acc[ai][0][m][1] * r) * (acc[ai][1][m][1] * r);
                    *(u32x4*)(U + (size_t)row * DM + col0) = pack8(p0, p1);
                    float* sp = nullptr;
                    if (row < MP) { const int t = row & (S_P - 1), b = row >> 11; if (t >= S_P - 2) sp = cvP + (size_t)(b * 2 + (t - (S_P - 2))) * DM + col0; }
                    else { const int rs = row - MP, t = rs & (S_S - 1), b = rs >> 3; if (t >= S_S - 2) sp = cvS + (size_t)(b * 2 + (t - (S_S - 2))) * DM + col0; }
                    if (sp) { *(f32x4*)sp = p0; *(f32x4*)(sp + 4) = p1; } }
        }
    }
};
}

template <class Epi, class Sched>
__device__ __forceinline__ void gemm_phase_slow(const pg8::Gemm g, const Sched& S, const Epi& E) {
    const int tid = threadIdx.x, wid = __builtin_amdgcn_readfirstlane(tid >> 6), lane = tid & 63, wr = wid >> 2, wc = wid & 3, fr = lane & 15, fq = lane >> 4;
    const int K = g.K;
    pg8::Unit u;
    for (int i = 0; S.next(i, u); ++i) {
        f32x4 acc[2][2][4][2];
#pragma unroll
        for (int a = 0; a < 2; ++a)
#pragma unroll
            for (int b = 0; b < 2; ++b)
#pragma unroll
                for (int m = 0; m < 4; ++m)
#pragma unroll
                    for (int n = 0; n < 2; ++n) acc[a][b][m][n] = (f32x4){0.f, 0.f, 0.f, 0.f};
        const unsigned offA = (unsigned)(wr * 64 + fr) * (unsigned)K * 2u, offB = (unsigned)(wc * 32 + (Epi::PERM ? 8 * fq : 4 * fq)) * (unsigned)K * 2u;
        const char* Au = (const char*)g.A + (size_t)u.pm * 256 * K * 2; const char* Bu = (const char*)g.Bt + (size_t)u.pn * 256 * K * 2;
#pragma unroll
        for (int ai = 0; ai < 2; ++ai) {
#pragma unroll 1
        for (int k0 = 0; k0 < K; k0 += 2) {
            float af[4][2];
#pragma unroll
            for (int m = 0; m < 4; ++m) { const unsigned w = *(const unsigned*)(Au + ((size_t)(ai * 128 + m * 16) * K + k0) * 2 + offA); af[m][0] = bflo(w); af[m][1] = bfhi(w); }
#pragma unroll
            for (int bj = 0; bj < 2; ++bj)
#pragma unroll
                for (int n = 0; n < 2; ++n)
#pragma unroll
                    for (int j = 0; j < 4; ++j) { const unsigned w = *(const unsigned*)(Bu + ((size_t)(bj * 128 + (Epi::PERM ? 4 * n : 16 * n) + j) * K + k0) * 2 + offB);
                        const float b0 = bflo(w), b1 = bfhi(w);
#pragma unroll
                        for (int m = 0; m < 4; ++m) acc[ai][bj][m][n][j] += af[m][0] * b0 + af[m][1] * b1; }
        }
        }
        E(acc, u, wr, wc, fr, fq);
    }
}
#ifndef USE_SLOW_GEMM
#define USE_SLOW_GEMM 0
#endif
template <class Epi, bool ALIGN, bool SP2>
__device__ __forceinline__ void run_gemm(Frame& F, const pg8::Gemm g, const Epi& E) {
    pg8::StaticOrder S; S.init(g.M, g.N, F.G, (int)blockIdx.x);
#if USE_SLOW_GEMM
    gemm_phase_slow<Epi, pg8::StaticOrder>(g, S, E);
#else
    pg8::gemm_phase<Epi, pg8::StaticOrder, ALIGN, SP2>(F.lds + RING_OFF, g, S, E);
#endif
}

__device__ __forceinline__ int map_row(int kind, int n0) {
    if (kind == 2) { if (n0 < DFF) return 256 * (n0 >> 7) + (n0 & 127); const int j = n0 - DFF; return 256 * (j >> 7) + 128 + (j & 127); }
    if (kind == 3) { if (n0 < DM) return n0; if (n0 < 2 * DM) { const int j = n0 - DM; return DM + 256 * (j >> 7) + (j & 127); } const int j = n0 - 2 * DM; return DM + 256 * (j >> 7) + 128 + (j & 127); }
    return n0;
}
__device__ __forceinline__ void p0_transpose_item(const float* W, int K, int N, int ldw, bf16* WT, int kind, const float* kscale, LAS float* scr, int item, int lane) {
    const int nblk = N / 32, kb = item / nblk, nb = item % nblk, k0 = 64 * kb, n0 = 32 * nb;
    const float ns = (kind == 1 && n0 < 1024) ? 0.0625f : 1.f;
#pragma unroll 8
    for (int i = 0; i < 32; ++i) { const int kk = 2 * i + (lane >> 5); const float ks = kscale ? kscale[k0 + kk] * ns : ns;
        scr[kk * 33 + (lane & 31)] = W[(size_t)(k0 + kk) * ldw + n0 + (lane & 31)] * ks; }
    LDS_WAIT(); asm volatile("" ::: "memory");
    const int c = lane & 7, r0 = map_row(kind, n0);
#pragma unroll
    for (int j = 0; j < 4; ++j) { const int n = (lane >> 3) + 8 * j; const LAS float* s = scr + (8 * c) * 33 + n;
        v4u o; o.x = pk2(s[0 * 33], s[1 * 33]); o.y = pk2(s[2 * 33], s[3 * 33]); o.z = pk2(s[4 * 33], s[5 * 33]); o.w = pk2(s[6 * 33], s[7 * 33]);
        *(GAS v4u*)(WT + (size_t)(r0 + n) * K + k0 + 8 * c) = o; }
    LDS_WAIT(); asm volatile("" ::: "memory");
}
__device__ __forceinline__ void p0_prologue(Frame& F) {
    LAS float* scr = (LAS float*)(F.lds + RING_OFF + F.wave * 16384);
    const int gw = F.vcu * NWAVES + F.wave, NGW = F.G * NWAVES;
    constexpr int I0 = 16 * 128, I1 = 16 * 32, I2 = 16 * 176, I3 = 44 * 32, I4 = 16 * 96, I5 = 16 * 32, I6 = I2, I7 = I3;
    constexpr int NITEMS = I0 + I1 + I2 + I3 + I4 + I5 + I6 + I7;
    for (int it = gw; it < NITEMS; it += NGW) {
        int r = it;
        if (r < I0) { p0_transpose_item(F.w_in, DM, NIN, NIN_SRC, WSP(bf16, WS_W_IN), 1, F.norm_mix, scr, r, F.lane); continue; } r -= I0;
        if (r < I1) { p0_transpose_item(F.w_out, DM, DM, DM, WSP(bf16, WS_W_OUT), 0, nullptr, scr, r, F.lane); continue; } r -= I1;
        if (r < I2) { p0_transpose_item(F.w_gu, DM, NGU, NGU, WSP(bf16, WS_W_GU0), 2, F.norm_ffn, scr, r, F.lane); continue; } r -= I2;
        if (r < I3) { p0_transpose_item(F.w_dn, DFF, DM, DM, WSP(bf16, WS_W_DN0), 0, nullptr, scr, r, F.lane); continue; } r -= I3;
        if (r < I4) { p0_transpose_item(F.w_cin, DM, NCIN, NCIN, WSP(bf16, WS_W_CIN), 3, F.norm_mix + DM, scr, r, F.lane); continue; } r -= I4;
        if (r < I5) { p0_transpose_item(F.w_cout, DM, DM, DM, WSP(bf16, WS_W_COUT), 0, nullptr, scr, r, F.lane); continue; } r -= I5;
        if (r < I6) { p0_transpose_item(F.w_gu + (size_t)DM * NGU, DM, NGU, NGU, WSP(bf16, WS_W_GU1), 2, F.norm_ffn + DM, scr, r, F.lane); continue; } r -= I6;
        p0_transpose_item(F.w_dn + (size_t)DFF * DM, DFF, DM, DM, WSP(bf16, WS_W_DN1), 0, nullptr, scr, r, F.lane);
    }
    __syncthreads();
    LAS float* WG = (LAS float*)(F.lds + RING_OFF);
    for (int idx = F.tid; idx < DM * 8; idx += NWAVES * 64) { const int k = idx >> 3, j = idx & 7; WG[idx] = F.w_in[(size_t)k * NIN_SRC + NIN + j] * F.norm_mix[k]; }
    __syncthreads();
    bf16* XB = WSP(bf16, WS_XB); float* SSQ0 = WSP(float, WS_SSQ); float* GATES = WSP(float, WS_GATES);
    for (int row = gw; row < MT; row += NGW) {
        const float* xrow = row < MP ? F.xp + (size_t)row * DM : F.xs + (size_t)(row - MP) * DM;
        const GAS f32x4* xr = (const GAS f32x4*)xrow + F.lane;
        f32x4 v[4]; float s = 0.f;
#pragma unroll
        for (int j = 0; j < 4; ++j) { v[j] = xr[64 * j]; s += (v[j].x * v[j].x + v[j].y * v[j].y) + (v[j].z * v[j].z + v[j].w * v[j].w); }
        const float ssq = wave_sum(s), r = rsqrtf(ssq * (1.f / 1024.f) + EPS);
        GAS unsigned long long* o8 = (GAS unsigned long long*)(XB + (size_t)row * DM) + F.lane;
#pragma unroll
        for (int j = 0; j < 4; ++j) o8[64 * j] = (unsigned long long)pk2(v[j].x, v[j].y) | ((unsigned long long)pk2(v[j].z, v[j].w) << 32);
        if (F.lane < 16) SSQ0[(size_t)row * 16 + F.lane] = F.lane == 0 ? ssq : 0.f;
        f32x4 ga = (f32x4){0.f, 0.f, 0.f, 0.f}, gb = ga;
#pragma unroll
        for (int j = 0; j < 4; ++j)
#pragma unroll
            for (int e = 0; e < 4; ++e) { const int k = 4 * F.lane + 256 * j + e; const f32x4 w0 = *(const LAS f32x4*)(WG + k * 8), w1 = *(const LAS f32x4*)(WG + k * 8 + 4); ga += w0 * v[j][e]; gb += w1 * v[j][e]; }
        float outv = 0.f;
#pragma unroll
        for (int e = 0; e < 4; ++e) { const float gi = wave_sum(ga[e]) * r + F.b_gate[e]; const float gf = wave_sum(gb[e]) * r + F.b_gate[4 + e];
            if (F.lane == e) outv = gi; if (F.lane == 4 + e) outv = logsigmoidf_(gf); }
        if (F.lane < 8) GATES[(size_t)row * 8 + F.lane] = outv;
    }
}

__device__ __forceinline__ void scan_oracle(Frame& F, const bool do_p, const bool do_s, const bool wr_p) {
    const bf16* QKVO = WSP(bf16, WS_QKVO); const float* GATES = WSP(float, WS_GATES); float* HBUF = WSP(float, WS_HBUF);
    constexpr int NU_P = NB_P * NH * 32, NU_S = NB_S * NH * 32;
    for (int un = F.vcu + (do_p ? 0 : NU_P); un < (do_s ? NU_P + NU_S : NU_P); un += F.G) {
        const bool smp = un >= NU_P; const int uu = smp ? un - NU_P : un; const int vg = uu & 31, h = (uu >> 5) & 3, b = uu >> 7;
        const int S = smp ? S_S : S_P, rowbase = smp ? MP + b * S_S : b * S_P;
        const int v = 8 * vg + F.wave, d0 = 4 * F.lane;
        f32x4 C = (f32x4){0.f, 0.f, 0.f, 0.f}, n = C; float m = 0.f;
        if (smp) { C = *(const f32x4*)(F.stC + ((size_t)(b * NH + h) * DV + v) * DK + d0); n = *(const f32x4*)(F.stN + (size_t)(b * NH + h) * DK + d0); m = F.stM[b * NH + h]; }
        for (int t0 = 0; t0 < S; t0 += 8) {
            v2u qw[8], kw[8]; unsigned short vw[8]; float li[8], lf[8];
#pragma unroll
            for (int i = 0; i < 8; ++i) { const size_t row = (size_t)(rowbase + t0 + i); const bf16* bp = QKVO + row * NIN + 256 * h;
                qw[i] = *(const v2u*)(bp + d0); kw[i] = *(const v2u*)(bp + 1024 + d0); vw[i] = bp[2048 + v]; li[i] = GATES[row * 8 + h]; lf[i] = GATES[row * 8 + 4 + h]; }
#pragma unroll
            for (int i = 0; i < 8; ++i) {
                const float mn = fmaxf(lf[i] + m, li[i]), a = expf(lf[i] + m - mn), wi = expf(li[i] - mn), vf = bf2f(vw[i]) * wi;
                const f32x4 kf = (f32x4){bflo(kw[i].x), bfhi(kw[i].x), bflo(kw[i].y), bfhi(kw[i].y)}, qf = (f32x4){bflo(qw[i].x), bfhi(qw[i].x), bflo(qw[i].y), bfhi(qw[i].y)};
                C = C * a + kf * vf; n = n * a + kf * wi;
                float num = (C.x * qf.x + C.y * qf.y) + (C.z * qf.z + C.w * qf.w), den = (n.x * qf.x + n.y * qf.y) + (n.z * qf.z + n.w * qf.w);
                num = wave_sum(num); den = wave_sum(den);
                const float hv = num / fmaxf(fabsf(den), expf(-mn));
                if (F.lane == 0) HBUF[(size_t)(rowbase + t0 + i) * DM + 256 * h + v] = hv;
                m = mn;
            }
        }
        if (!smp && !wr_p) continue;
        float* Co = F.out + (smp ? O_CS : O_CP) + ((size_t)(b * NH + h) * DV + v) * DK + d0; *(f32x4*)Co = C;
        if (vg == 0 && F.wave == 0) { *(f32x4*)(F.out + (smp ? O_NS : O_NP) + (size_t)(b * NH + h) * DK + d0) = n; if (F.lane == 0) F.out[(smp ? O_MS : O_MP) + b * NH + h] = m; }
    }
}
__device__ __forceinline__ void gate_pass(Frame& F, const int row_lo, const int row_hi) {
    const bf16* QKVO = WSP(bf16, WS_QKVO); const float* HBUF = WSP(float, WS_HBUF); bf16* A2 = WSP(bf16, WS_A2);
    const int gw = F.vcu * NWAVES + F.wave, NGW = F.G * NWAVES;
    for (int row = row_lo + gw; row < row_hi; row += NGW) {
        const f32x4* hr = (const f32x4*)(HBUF + (size_t)row * DM) + F.lane; const v2u* orow = (const v2u*)(QKVO + (size_t)row * NIN + 3072) + F.lane; const f32x4* gr = (const f32x4*)F.head_norm + F.lane;
        v2u* o8 = (v2u*)(A2 + (size_t)row * DM) + F.lane;
#pragma unroll
        for (int j = 0; j < 4; ++j) { const f32x4 hv = hr[64 * j], g = gr[64 * j]; const v2u ow = orow[64 * j];
            const float ss = wave_sum((hv.x * hv.x + hv.y * hv.y) + (hv.z * hv.z + hv.w * hv.w)), rn = rsqrtf(ss * (1.f / 256.f) + EPS);
            v2u w; w.x = pk2(hv.x * rn * g.x * sigmoidf_(bflo(ow.x)), hv.y * rn * g.y * sigmoidf_(bfhi(ow.x))); w.y = pk2(hv.z * rn * g.z * sigmoidf_(bflo(ow.y)), hv.w * rn * g.w * sigmoidf_(bfhi(ow.y)));
            o8[64 * j] = w; }
    }
}
__device__ __forceinline__ void conv_pass(Frame& F) {
    const bf16* BG = WSP(bf16, WS_BG); const bf16* U = WSP(bf16, WS_U); bf16* A2 = WSP(bf16, WS_A2);
    const int gw = F.vcu * NWAVES + F.wave, NGW = F.G * NWAVES;
    for (int row = gw; row < MT; row += NGW) {
        const bool smp = row >= MP; const int t = smp ? (row - MP) & (S_S - 1) : row & (S_P - 1), b = smp ? (row - MP) >> 3 : row >> 11;
        const v2u* u0 = (const v2u*)(U + (size_t)row * DM) + F.lane; const v2u* bgr = (const v2u*)(BG + (size_t)row * DM) + F.lane; v2u* o8 = (v2u*)(A2 + (size_t)row * DM) + F.lane;
        const f32x4* sb = (const f32x4*)(F.stConv + (size_t)b * 2 * DM) + F.lane;
#pragma unroll
        for (int j = 0; j < 4; ++j) {
            const v2u uc = u0[64 * j], bw = bgr[64 * j];
            const f32x4 w0 = ((const f32x4*)F.w_taps + F.lane)[64 * j], w1 = ((const f32x4*)(F.w_taps + DM) + F.lane)[64 * j], w2 = ((const f32x4*)(F.w_taps + 2 * DM) + F.lane)[64 * j];
            f32x4 a = (f32x4){0.f, 0.f, 0.f, 0.f}, c = a;
            if (t >= 2) { const v2u w = (u0 - 2 * (DM / 4))[64 * j]; a = (f32x4){bflo(w.x), bfhi(w.x), bflo(w.y), bfhi(w.y)}; } else if (smp) a = sb[(t == 0 ? 0 : 256) + 64 * j];
            if (t >= 1) { const v2u w = (u0 - (DM / 4))[64 * j]; c = (f32x4){bflo(w.x), bfhi(w.x), bflo(w.y), bfhi(w.y)}; } else if (smp) c = sb[256 + 64 * j];
            const f32x4 cur = (f32x4){bflo(uc.x), bfhi(uc.x), bflo(uc.y), bfhi(uc.y)}, bg = (f32x4){bflo(bw.x), bfhi(bw.x), bflo(bw.y), bfhi(bw.y)};
            const f32x4 y = bg * (w0 * a + w1 * c + w2 * cur);
            v2u w; w.x = pk2(y.x, y.y); w.y = pk2(y.z, y.w); o8[64 * j] = w;
        }
    }
}
__device__ __forceinline__ void final_norm(Frame& F) {
    const int gw = F.vcu * NWAVES + F.wave, NGW = F.G * NWAVES;
    for (int row = gw; row < MT; row += NGW) {
        GAS f32x4* xr = (GAS f32x4*)(F.out + O_Y + (size_t)row * DM) + F.lane; const f32x4* gr = (const f32x4*)F.norm_final + F.lane;
        f32x4 v[4]; float s = 0.f;
#pragma unroll
        for (int j = 0; j < 4; ++j) { v[j] = xr[64 * j]; s += (v[j].x * v[j].x + v[j].y * v[j].y) + (v[j].z * v[j].z + v[j].w * v[j].w); }
        const float r = rsqrtf(wave_sum(s) * (1.f / 1024.f) + EPS);
#pragma unroll
        for (int j = 0; j < 4; ++j) xr[64 * j] = v[j] * r * gr[64 * j];
    }
}

typedef float f32x4v __attribute__((ext_vector_type(4)));
#define MFMA16(a, b, c) __builtin_amdgcn_mfma_f32_16x16x32_bf16((a), (b), (c), 0, 0, 0)
__device__ __forceinline__ float scan_sum(float v, int lane) {
#pragma unroll
    for (int o = 1; o < 64; o <<= 1) { const float t = __shfl_up(v, o); if (lane >= o) v += t; }
    return v;
}
__device__ __forceinline__ float scan_max(float v, int lane) {
#pragma unroll
    for (int o = 1; o < 64; o <<= 1) { const float t = __shfl_up(v, o); if (lane >= o) v = fmaxf(v, t); }
    return v;
}
__device__ __forceinline__ float wave_max(float v) {
#pragma unroll
    for (int o = 1; o < 64; o <<= 1) v = fmaxf(v, __shfl_xor(v, o));
    return v;
}
__device__ __forceinline__ unsigned img_off(unsigned row, unsigned ch) { return row * 512u + ((ch ^ (row & 15u)) << 4); }
__device__ __forceinline__ void dma_tile128(LAS unsigned char* buf, const bf16* gsrc, size_t ld, int wave, int lane) {
#pragma unroll
    for (int i = 0; i < 8; ++i) { const int p = wave * 8 + i, row = 2 * p + (lane >> 5), ch = (lane & 31) ^ (row & 15);
        __builtin_amdgcn_global_load_lds((const unsigned*)(gsrc + (size_t)row * ld + ch * 8), (LAS unsigned*)(buf + p * 1024), 16, 0, 0); }
}
__device__ __forceinline__ bf16x8 tr_frag(unsigned a0, unsigned a1) {
    v2u lo, hi;
    asm volatile("ds_read_b64_tr_b16 %0, %2\n\tds_read_b64_tr_b16 %1, %3\n\ts_waitcnt lgkmcnt(0)" : "=&v"(lo), "=&v"(hi) : "v"(a0), "v"(a1) : "memory");
    v4u r; r.x = lo.x; r.y = lo.y; r.z = hi.x; r.w = hi.y; return __builtin_bit_cast(bf16x8, r);
}
__device__ __forceinline__ bf16x8 pack_f8(const f32x4 a, const f32x4 b) { v4u r; r.x = pk2(a.x, a.y); r.y = pk2(a.z, a.w); r.z = pk2(b.x, b.y); r.w = pk2(b.z, b.w); return __builtin_bit_cast(bf16x8, r); }
__device__ __forceinline__ f32x4 bf4_to_f(const v2u w) { return (f32x4){bflo(w.x), bfhi(w.x), bflo(w.y), bfhi(w.y)}; }

__device__ __forceinline__ void s1_state_pass(Frame& F) {
    const bf16* QKVO = WSP(bf16, WS_QKVO); const float* GATES = WSP(float, WS_GATES);
    bf16* CST = WSP(bf16, WS_CST); float* NST = WSP(float, WS_NST); float* MST = WSP(float, WS_MST);
    LAS unsigned char* VP = F.lds + SCR_OFF;
    LAS float* WGS = (LAS float*)(F.lds + SCR_OFF + 8192);
    LAS float* SC = (LAS float*)(F.lds + SCR_OFF + 8192 + 1024);
    const int lane = F.lane, wave = F.wave, g = lane >> 4, q = (lane & 15) >> 2, p = lane & 3;
    const unsigned ldsK = (unsigned)(size_t)F.lds, ldsV = (unsigned)(size_t)VP;
    for (int un = F.vcu; un < NB_P * NH * 8; un += F.G) {
        const int vs = un & 7, h = (un >> 3) & 3, b = un >> 5, bh = b * NH + h;
        f32x4 acc[2][2], nacc[2];
#pragma unroll
        for (int i = 0; i < 2; ++i) { nacc[i] = (f32x4){0.f, 0.f, 0.f, 0.f};
#pragma unroll
            for (int j = 0; j < 2; ++j) acc[i][j] = (f32x4){0.f, 0.f, 0.f, 0.f}; }
        float m_run = 0.f;
        __syncthreads();
        dma_tile128(F.lds, QKVO + (size_t)(b * S_P) * NIN + 1024 + 256 * h, NIN, wave, lane);
        for (int c = 0; c < 16; ++c) {
            const int r0 = b * S_P + 128 * c, par = c & 1;
            if (wave == 0) {
                const float li0 = GATES[(size_t)(r0 + lane) * 8 + h], li1 = GATES[(size_t)(r0 + 64 + lane) * 8 + h], lf0 = GATES[(size_t)(r0 + lane) * 8 + 4 + h], lf1 = GATES[(size_t)(r0 + 64 + lane) * 8 + 4 + h];
                const float b0 = scan_sum(lf0, lane), b1 = scan_sum(lf1, lane) + __shfl(b0, 63), bL = __shfl(b1, 63);
                const float g0 = bL - b0 + li0, g1 = bL - b1 + li1, mx = wave_max(fmaxf(g0, g1));
                const float m_new = fmaxf(bL + m_run, mx), a = expf(bL + m_run - m_new);
                WGS[par * 128 + lane] = expf(g0 - m_new); WGS[par * 128 + 64 + lane] = expf(g1 - m_new);
                if (lane == 0) { SC[par * 4] = a; SC[par * 4 + 1] = m_new; if (vs == 0) MST[bh * 16 + c] = m_run; }
                m_run = m_new;
            }
            const int vl = F.tid >> 2, vp = F.tid & 3;
            const v4u vraw = *(const v4u*)(QKVO + (size_t)(r0 + vl) * NIN + 2048 + 256 * h + 32 * vs + 8 * vp);
            VM_WAIT(); __syncthreads();
            { const float wg = WGS[par * 128 + vl];
              v4u o; o.x = pk2(bflo(vraw.x) * wg, bfhi(vraw.x) * wg); o.y = pk2(bflo(vraw.y) * wg, bfhi(vraw.y) * wg); o.z = pk2(bflo(vraw.z) * wg, bfhi(vraw.z) * wg); o.w = pk2(bflo(vraw.w) * wg, bfhi(vraw.w) * wg);
              *(LAS v4u*)(VP + vl * 64 + vp * 16) = o; }
            if (c >= 1) {
                bf16* cp = CST + ((size_t)(bh * 16 + c) * DV + 32 * vs + (lane & 15)) * DK + 32 * wave + 4 * g;
#pragma unroll
                for (int dt = 0; dt < 2; ++dt)
#pragma unroll
                    for (int vt = 0; vt < 2; ++vt) { v2u w; w.x = pk2(acc[dt][vt].x, acc[dt][vt].y); w.y = pk2(acc[dt][vt].z, acc[dt][vt].w); *(v2u*)(cp + (size_t)(16 * vt) * DK + 16 * dt) = w; }
                if (vs == 0 && (lane & 15) == 0) {
#pragma unroll
                    for (int dt = 0; dt < 2; ++dt) *(f32x4*)(NST + (size_t)(bh * 16 + c) * DK + 32 * wave + 16 * dt + 4 * g) = nacc[dt]; }
            }
            __syncthreads();
            if (c + 1 < 16) dma_tile128(F.lds + ((c + 1) & 1) * 65536, QKVO + (size_t)(r0 + 128) * NIN + 1024 + 256 * h, NIN, wave, lane);
            const float a = SC[par * 4];
#pragma unroll
            for (int i = 0; i < 2; ++i) { nacc[i] = nacc[i] * a;
#pragma unroll
                for (int j = 0; j < 2; ++j) acc[i][j] = acc[i][j] * a; }
            const unsigned kb = ldsK + par * 65536;
#pragma unroll
            for (int kl = 0; kl < 4; ++kl) {
                const unsigned ra = 32 * kl + 8 * g + q, rb = ra + 4;
                bf16x8 Af[2], Bf[2];
#pragma unroll
                for (int dt = 0; dt < 2; ++dt) Af[dt] = tr_frag(kb + img_off(ra, 4 * wave + 2 * dt + (p >> 1)) + 8 * (p & 1), kb + img_off(rb, 4 * wave + 2 * dt + (p >> 1)) + 8 * (p & 1));
#pragma unroll
                for (int vt = 0; vt < 2; ++vt) Bf[vt] = tr_frag(ldsV + ra * 64 + (16 * vt + 4 * p) * 2, ldsV + rb * 64 + (16 * vt + 4 * p) * 2);
#pragma unroll
                for (int dt = 0; dt < 2; ++dt)
#pragma unroll
                    for (int vt = 0; vt < 2; ++vt) acc[dt][vt] = MFMA16(Af[dt], Bf[vt], acc[dt][vt]);
                if (vs == 0) {
                    const f32x4 w0 = *(const LAS f32x4*)(WGS + par * 128 + 32 * kl + 8 * g), w1 = *(const LAS f32x4*)(WGS + par * 128 + 32 * kl + 8 * g + 4);
                    bf16x8 b2 = pack_f8(w0, w1); if ((lane & 15) != 0) b2 = (bf16x8){0, 0, 0, 0, 0, 0, 0, 0};
#pragma unroll
                    for (int dt = 0; dt < 2; ++dt) nacc[dt] = MFMA16(Af[dt], b2, nacc[dt]);
                }
            }
        }
        float* co = F.out + O_CP + ((size_t)bh * DV + 32 * vs + (lane & 15)) * DK + 32 * wave + 4 * g;
#pragma unroll
        for (int dt = 0; dt < 2; ++dt)
#pragma unroll
            for (int vt = 0; vt < 2; ++vt) *(f32x4*)(co + (size_t)(16 * vt) * DK + 16 * dt) = acc[dt][vt];
        if (vs == 0) {
            if ((lane & 15) == 0) {
#pragma unroll
                for (int dt = 0; dt < 2; ++dt) *(f32x4*)(F.out + O_NP + (size_t)bh * DK + 32 * wave + 16 * dt + 4 * g) = nacc[dt]; }
            if (wave == 0 && lane == 0) F.out[O_MP + bh] = m_run;
        }
    }
}

template <int VT>
__device__ __forceinline__ void s2_h_step(f32x4& acc, const unsigned base, const bf16x8 (&Sf)[4]) {
    constexpr int HI = (VT >> 3) * 256;
    v2u r0, r1, r2, r3, r4, r5, r6, r7;
    asm volatile("ds_read_b64_tr_b16 %0, %8 offset:%9\n\tds_read_b64_tr_b16 %1, %8 offset:%10\n\tds_read_b64_tr_b16 %2, %8 offset:%11\n\tds_read_b64_tr_b16 %3, %8 offset:%12\n\t"
                 "ds_read_b64_tr_b16 %4, %8 offset:%13\n\tds_read_b64_tr_b16 %5, %8 offset:%14\n\tds_read_b64_tr_b16 %6, %8 offset:%15\n\tds_read_b64_tr_b16 %7, %8 offset:%16\n\ts_waitcnt lgkmcnt(0)"
                 : "=&v"(r0), "=&v"(r1), "=&v"(r2), "=&v"(r3), "=&v"(r4), "=&v"(r5), "=&v"(r6), "=&v"(r7)
                 : "v"(base), "i"(HI), "i"(HI + 8192), "i"(HI + 16384), "i"(HI + 24576), "i"(HI + 32768), "i"(HI + 40960), "i"(HI + 49152), "i"(HI + 57344) : "memory");
    v4u f;
    f.x = r0.x; f.y = r0.y; f.z = r1.x; f.w = r1.y; acc = MFMA16(__builtin_bit_cast(bf16x8, f), Sf[0], acc);
    f.x = r2.x; f.y = r2.y; f.z = r3.x; f.w = r3.y; acc = MFMA16(__builtin_bit_cast(bf16x8, f), Sf[1], acc);
    f.x = r4.x; f.y = r4.y; f.z = r5.x; f.w = r5.y; acc = MFMA16(__builtin_bit_cast(bf16x8, f), Sf[2], acc);
    f.x = r6.x; f.y = r6.y; f.z = r7.x; f.w = r7.y; acc = MFMA16(__builtin_bit_cast(bf16x8, f), Sf[3], acc);
}

__device__ __forceinline__ void s2_output_pass(Frame& F) {
    const bf16* QKVO = WSP(bf16, WS_QKVO); const float* GATES = WSP(float, WS_GATES);
    const bf16* CST = WSP(bf16, WS_CST); const float* NST = WSP(float, WS_NST); const float* MST = WSP(float, WS_MST); bf16* A2 = WSP(bf16, WS_A2);
    LAS float* ZS = (LAS float*)(F.lds + SCR_OFF); LAS float* LM = ZS + 128; LAS float* LW = ZS + 256; LAS float* LE = ZS + 384; LAS float* NS = ZS + 512;
    LAS unsigned char* bufA = F.lds; LAS unsigned char* bufB = F.lds + 65536;
    const int lane = F.lane, wave = F.wave, g = lane >> 4, q = (lane & 15) >> 2, p = lane & 3, li_ = lane & 15;
    const unsigned ldsB = (unsigned)(size_t)bufB;
    for (int un = F.vcu; un < NB_P * NH * 16; un += F.G) {
        const int c = un & 15, h = (un >> 4) & 3, b = un >> 6, bh = b * NH + h, r0 = b * S_P + 128 * c;
        const bf16* Kg = QKVO + (size_t)r0 * NIN + 1024 + 256 * h; const bf16* Vg = QKVO + (size_t)r0 * NIN + 2048 + 256 * h;
        __syncthreads();
        if (c) { const bf16* Cg = CST + (size_t)(bh * 16 + c) * DV * DK; dma_tile128(bufA, Cg, DK, wave, lane); dma_tile128(bufB, Cg + (size_t)128 * DK, DK, wave, lane); }
        else { dma_tile128(bufA, Kg, NIN, wave, lane); dma_tile128(bufB, Vg, NIN, wave, lane); }
        if (wave == 0) {
            const float li0 = GATES[(size_t)(r0 + lane) * 8 + h], li1 = GATES[(size_t)(r0 + 64 + lane) * 8 + h], lf0 = GATES[(size_t)(r0 + lane) * 8 + 4 + h], lf1 = GATES[(size_t)(r0 + 64 + lane) * 8 + 4 + h];
            const float m0 = c ? MST[bh * 16 + c] : 0.f;
            const float b0 = scan_sum(lf0, lane), b1 = scan_sum(lf1, lane) + __shfl(b0, 63);
            const float z0 = li0 - b0, z1 = li1 - b1, p0 = scan_max(z0, lane), p1 = fmaxf(scan_max(z1, lane), __shfl(p0, 63));
            const float M0 = fmaxf(m0, p0), M1 = fmaxf(m0, p1);
            ZS[lane] = z0; ZS[64 + lane] = z1; LM[lane] = M0; LM[64 + lane] = M1; LW[lane] = expf(m0 - M0); LW[64 + lane] = expf(m0 - M1); LE[lane] = expf(-(b0 + M0)); LE[64 + lane] = expf(-(b1 + M1));
        }
        if (F.tid < 64) *(LAS f32x4*)(NS + 4 * F.tid) = c ? *(const f32x4*)(NST + (size_t)(bh * 16 + c) * DK + 4 * F.tid) : (f32x4){0.f, 0.f, 0.f, 0.f};
        const int lrow = 16 * wave + li_; const size_t row = (size_t)(r0 + lrow);
        bf16x8 Qf[8];
#pragma unroll
        for (int kd = 0; kd < 8; ++kd) Qf[kd] = *(const bf16x8*)(QKVO + row * NIN + 256 * h + 32 * kd + 8 * g);
        f32x4 acc[16];
#pragma unroll
        for (int vt = 0; vt < 16; ++vt) acc[vt] = (f32x4){0.f, 0.f, 0.f, 0.f};
        VM_WAIT(); __syncthreads();
        if (c) {
#pragma unroll
            for (int vt = 0; vt < 8; ++vt) {
#pragma unroll
                for (int kd = 0; kd < 8; ++kd) acc[vt] = MFMA16(*(const LAS bf16x8*)(bufA + img_off(16 * vt + li_, 4 * kd + g)), Qf[kd], acc[vt]);
                __builtin_amdgcn_sched_barrier(0); }
#pragma unroll
            for (int vt = 0; vt < 8; ++vt) {
#pragma unroll
                for (int kd = 0; kd < 8; ++kd) acc[8 + vt] = MFMA16(*(const LAS bf16x8*)(bufB + img_off(16 * vt + li_, 4 * kd + g)), Qf[kd], acc[8 + vt]);
                __builtin_amdgcn_sched_barrier(0); }
            __syncthreads();
            dma_tile128(bufA, Kg, NIN, wave, lane); dma_tile128(bufB, Vg, NIN, wave, lane);
            const float wl = LW[lrow];
#pragma unroll
            for (int vt = 0; vt < 16; ++vt) acc[vt] = acc[vt] * wl;
            VM_WAIT(); __syncthreads();
        }
        float gn = 0.f;
#pragma unroll
        for (int kd = 0; kd < 8; ++kd) { const v4u qw = __builtin_bit_cast(v4u, Qf[kd]); const f32x4 n0 = *(const LAS f32x4*)(NS + 32 * kd + 8 * g), n1 = *(const LAS f32x4*)(NS + 32 * kd + 8 * g + 4);
            gn += (bflo(qw.x) * n0.x + bfhi(qw.x) * n0.y) + (bflo(qw.y) * n0.z + bfhi(qw.y) * n0.w) + (bflo(qw.z) * n1.x + bfhi(qw.z) * n1.y) + (bflo(qw.w) * n1.z + bfhi(qw.w) * n1.w); }
        gn += __shfl_xor(gn, 16); gn += __shfl_xor(gn, 32);
        f32x4 sacc[8];
#pragma unroll
        for (int ts = 0; ts < 8; ++ts) { sacc[ts] = (f32x4){0.f, 0.f, 0.f, 0.f};
#pragma unroll
            for (int kd = 0; kd < 8; ++kd) sacc[ts] = MFMA16(*(const LAS bf16x8*)(bufA + img_off(16 * ts + li_, 4 * kd + g)), Qf[kd], sacc[ts]);
            __builtin_amdgcn_sched_barrier(0); }
        const float Ml = LM[lrow]; float dsum = 0.f;
#pragma unroll
        for (int ts = 0; ts < 8; ++ts) { const f32x4 z4 = *(const LAS f32x4*)(ZS + 16 * ts + 4 * g);
#pragma unroll
            for (int r = 0; r < 4; ++r) { const int s = 16 * ts + 4 * g + r; const float v = (s <= lrow) ? sacc[ts][r] * __expf(z4[r] - Ml) : 0.f; dsum += v; sacc[ts][r] = v; } }
        dsum += __shfl_xor(dsum, 16); dsum += __shfl_xor(dsum, 32);
        bf16x8 Sf[4];
#pragma unroll
        for (int ks = 0; ks < 4; ++ks) Sf[ks] = pack_f8(sacc[2 * ks], sacc[2 * ks + 1]);
        {
            unsigned hb[8];
#pragma unroll
            for (int j = 0; j < 8; ++j) hb[j] = ldsB + img_off(4 * g + q, 2 * j + (p >> 1)) + 8 * (p & 1);
            s2_h_step<0>(acc[0], hb[0], Sf); s2_h_step<1>(acc[1], hb[1], Sf); s2_h_step<2>(acc[2], hb[2], Sf); s2_h_step<3>(acc[3], hb[3], Sf);
            s2_h_step<4>(acc[4], hb[4], Sf); s2_h_step<5>(acc[5], hb[5], Sf); s2_h_step<6>(acc[6], hb[6], Sf); s2_h_step<7>(acc[7], hb[7], Sf);
            s2_h_step<8>(acc[8], hb[0], Sf); s2_h_step<9>(acc[9], hb[1], Sf); s2_h_step<10>(acc[10], hb[2], Sf); s2_h_step<11>(acc[11], hb[3], Sf);
            s2_h_step<12>(acc[12], hb[4], Sf); s2_h_step<13>(acc[13], hb[5], Sf); s2_h_step<14>(acc[14], hb[6], Sf); s2_h_step<15>(acc[15], hb[7], Sf);
        }
        const float den = LW[lrow] * gn + dsum, inv = 1.f / fmaxf(fabsf(den), LE[lrow]);
        float ssq = 0.f;
#pragma unroll
        for (int vt = 0; vt < 16; ++vt) { acc[vt] = acc[vt] * inv; ssq += (acc[vt].x * acc[vt].x + acc[vt].y * acc[vt].y) + (acc[vt].z * acc[vt].z + acc[vt].w * acc[vt].w); }
        ssq += __shfl_xor(ssq, 16); ssq += __shfl_xor(ssq, 32);
        const float rn = rsqrtf(ssq * (1.f / 256.f) + EPS);
#pragma unroll
        for (int vt = 0; vt < 16; ++vt) { const int v0 = 256 * h + 16 * vt + 4 * g;
            const f32x4 ov = bf4_to_f(*(const v2u*)(QKVO + row * NIN + 3072 + v0)), gh = *(const f32x4*)(F.head_norm + v0);
            v2u w; w.x = pk2(acc[vt].x * rn * gh.x * sigmoidf_(ov.x), acc[vt].y * rn * gh.y * sigmoidf_(ov.y)); w.y = pk2(acc[vt].z * rn * gh.z * sigmoidf_(ov.z), acc[vt].w * rn * gh.w * sigmoidf_(ov.w));
            *(v2u*)(A2 + row * DM + v0) = w; }
    }
}

__device__ __forceinline__ void s3_sample_pass(Frame& F) {
    const bf16* QKVO = WSP(bf16, WS_QKVO); const float* GATES = WSP(float, WS_GATES); bf16* A2 = WSP(bf16, WS_A2);
    LAS float* GP = (LAS float*)F.lds;
    LAS float* VW = (LAS float*)(F.lds + 65536);
    LAS float* SCS = (LAS float*)(F.lds + SCR_OFF);
    const int lane = F.lane, wave = F.wave, g = lane >> 4, li_ = lane & 15;
    for (int un = F.vcu; un < NB_S * NH; un += F.G) {
        const int h = un & 3, b = un >> 2, bh = b * NH + h, r0 = MP + S_S * b;
        __syncthreads();
        if (wave == 0) {
            const bool ok = lane < S_S; const int rr = r0 + (lane & 7);
            const float li = GATES[(size_t)rr * 8 + h], lf = ok ? GATES[(size_t)rr * 8 + 4 + h] : 0.f, m0 = F.stM[bh];
            const float bc = scan_sum(lf, lane), z = ok ? li - bc : -INFINITY, pm = scan_max(z, lane), M = fmaxf(m0, pm), bL = __shfl(bc, S_S - 1);
            const float gq = ok ? bL - bc + li : -INFINITY, mx = wave_max(gq), m_new = fmaxf(bL + m0, mx), a = expf(bL + m0 - m_new);
            if (ok) { SCS[lane] = z; SCS[8 + lane] = M; SCS[16 + lane] = expf(m0 - M); SCS[24 + lane] = expf(-(bc + M)); SCS[32 + lane] = expf(gq - m_new); }
            if (lane == 0) { SCS[40] = a; SCS[41] = m_new; F.out[O_MS + bh] = m_new; }
        }
        __syncthreads();
        { const int l = F.tid >> 6, v0 = 4 * (F.tid & 63); const float wg = SCS[32 + l];
          const f32x4 vv = bf4_to_f(*(const v2u*)(QKVO + (size_t)(r0 + l) * NIN + 2048 + 256 * h + v0)); *(LAS f32x4*)(VW + l * 256 + v0) = vv * wg; }
        float kk[8][8];
#pragma unroll
        for (int l = 0; l < 8; ++l) { const v4u w = *(const v4u*)(QKVO + (size_t)(r0 + l) * NIN + 1024 + 256 * h + 32 * wave + 8 * g);
            kk[l][0] = bflo(w.x); kk[l][1] = bfhi(w.x); kk[l][2] = bflo(w.y); kk[l][3] = bfhi(w.y); kk[l][4] = bflo(w.z); kk[l][5] = bfhi(w.z); kk[l][6] = bflo(w.w); kk[l][7] = bfhi(w.w); }
        bf16x8 Qa = (bf16x8){0, 0, 0, 0, 0, 0, 0, 0};
        if (li_ < 8) Qa = *(const bf16x8*)(QKVO + (size_t)(r0 + li_) * NIN + 256 * h + 32 * wave + 8 * g);
        __syncthreads();
        const float a = SCS[40];
        const float* cin = F.stC + ((size_t)bh * DV + li_) * DK + 32 * wave + 8 * g; float* cout = F.out + O_CS + ((size_t)bh * DV + li_) * DK + 32 * wave + 8 * g;
#pragma unroll 4
        for (int vb = 0; vb < 16; ++vb) {
            const f32x4 c0 = *(const f32x4*)(cin + (size_t)(16 * vb) * DK), c1 = *(const f32x4*)(cin + (size_t)(16 * vb) * DK + 4);
            const f32x4 gp = MFMA16(Qa, pack_f8(c0, c1), ((f32x4){0.f, 0.f, 0.f, 0.f}));
            if (g < 2) {
#pragma unroll
                for (int r = 0; r < 4; ++r) GP[(wave * 8 + 4 * g + r) * 256 + 16 * vb + li_] = gp[r]; }
            f32x4 n0 = c0 * a, n1 = c1 * a;
#pragma unroll
            for (int l = 0; l < 8; ++l) { const float vw = VW[l * 256 + 16 * vb + li_];
                n0.x += vw * kk[l][0]; n0.y += vw * kk[l][1]; n0.z += vw * kk[l][2]; n0.w += vw * kk[l][3]; n1.x += vw * kk[l][4]; n1.y += vw * kk[l][5]; n1.z += vw * kk[l][6]; n1.w += vw * kk[l][7]; }
            *(f32x4*)(cout + (size_t)(16 * vb) * DK) = n0; *(f32x4*)(cout + (size_t)(16 * vb) * DK + 4) = n1;
        }
        __syncthreads();
        {
            const int l = wave; const size_t row = (size_t)(r0 + l);
            f32x4 G = (f32x4){0.f, 0.f, 0.f, 0.f};
#pragma unroll
            for (int w2 = 0; w2 < 8; ++w2) G += *(const LAS f32x4*)(GP + (w2 * 8 + l) * 256 + 4 * lane);
            const f32x4 qv = bf4_to_f(*(const v2u*)(QKVO + row * NIN + 256 * h + 4 * lane));
            const f32x4 n0v = *(const f32x4*)(F.stN + (size_t)bh * DK + 4 * lane);
            const float gn = wave_sum((n0v.x * qv.x + n0v.y * qv.y) + (n0v.z * qv.z + n0v.w * qv.w));
            const float Ml = SCS[8 + l], wl = SCS[16 + l], el = SCS[24 + l];
            f32x4 num = G * wl; float dsum = 0.f;
#pragma unroll
            for (int s = 0; s < 8; ++s) { const f32x4 kv = bf4_to_f(*(const v2u*)(QKVO + (size_t)(r0 + s) * NIN + 1024 + 256 * h + 4 * lane));
                const float qk = wave_sum((kv.x * qv.x + kv.y * qv.y) + (kv.z * qv.z + kv.w * qv.w));
                const float sd = (s <= l) ? qk * __expf(SCS[s] - Ml) : 0.f;
                const f32x4 vv = bf4_to_f(*(const v2u*)(QKVO + (size_t)(r0 + s) * NIN + 2048 + 256 * h + 4 * lane));
                num += vv * sd; dsum += sd; }
            const float den = wl * gn + dsum, inv = 1.f / fmaxf(fabsf(den), el);
            const f32x4 hv = num * inv;
            const float rn = rsqrtf(wave_sum((hv.x * hv.x + hv.y * hv.y) + (hv.z * hv.z + hv.w * hv.w)) * (1.f / 256.f) + EPS);
            const int v0 = 256 * h + 4 * lane;
            const f32x4 ov = bf4_to_f(*(const v2u*)(QKVO + row * NIN + 3072 + v0)), gh = *(const f32x4*)(F.head_norm + v0);
            v2u w; w.x = pk2(hv.x * rn * gh.x * sigmoidf_(ov.x), hv.y * rn * gh.y * sigmoidf_(ov.y)); w.y = pk2(hv.z * rn * gh.z * sigmoidf_(ov.z), hv.w * rn * gh.w * sigmoidf_(ov.w));
            *(v2u*)(A2 + row * DM + v0) = w;
            if (wave == 0) {
                f32x4 nn = n0v * a;
#pragma unroll
                for (int s = 0; s < 8; ++s) { const f32x4 kv = bf4_to_f(*(const v2u*)(QKVO + (size_t)(r0 + s) * NIN + 1024 + 256 * h + 4 * lane)); nn += kv * SCS[32 + s]; }
                *(f32x4*)(F.out + O_NS + (size_t)bh * DK + 4 * lane) = nn;
            }
        }
    }
}
#ifndef SCAN_MODE
#define SCAN_MODE 3
#endif
#ifndef MK_N_LAUNCHES
#define MK_N_LAUNCHES 1
#endif
constexpr int N_PHASES = 13;
struct Args { const float* in[18]; float* out; unsigned char* ws; int ph_lo, ph_hi; };
__global__ void __launch_bounds__(NWAVES * 64, 2) fwd_kernel(Args args) {
    extern __shared__ __attribute__((aligned(16))) unsigned char lds[];
    Frame F;
    F.lds = (LAS unsigned char*)lds; F.MISC = (volatile LAS unsigned*)(F.lds + MISC_OFF);
    F.tid = threadIdx.x; F.lane = F.tid & 63; F.wave = __builtin_amdgcn_readfirstlane(F.tid >> 6);
    F.G = gridDim.x; { const int bx = blockIdx.x; F.vcu = (F.G % 8 == 0) ? (bx % 8) * (F.G / 8) + bx / 8 : bx; }
    F.ws = args.ws; F.out = args.out; F.ctl = (gu32*)(args.ws + WS_CTL);
    F.xp = args.in[0]; F.xs = args.in[1]; F.stC = args.in[2]; F.stN = args.in[3]; F.stM = args.in[4]; F.stConv = args.in[5]; F.norm_mix = args.in[6]; F.norm_ffn = args.in[7]; F.norm_final = args.in[8];
    F.w_in = args.in[9]; F.b_gate = args.in[10]; F.head_norm = args.in[11]; F.w_out = args.in[12]; F.w_cin = args.in[13]; F.w_taps = args.in[14]; F.w_cout = args.in[15]; F.w_gu = args.in[16]; F.w_dn = args.in[17];
    for (int u = F.tid; u < (LDS_BYTES - LDSCTL_OFF) / 4; u += NWAVES * 64) ((LAS unsigned*)(F.lds + LDSCTL_OFF))[u] = 0u;
    __syncthreads();
    XcdBarrier bar; bar.bar = (unsigned*)(F.ctl + CW_BAR); bar.x = 0; bar.st = nullptr;
    const int lo = args.ph_lo, hi = args.ph_hi;
    if (hi - lo > 1) bar = xcd_barrier_post((unsigned*)(F.ctl + CW_BAR), F.MISC + 8);
#define IN(k) (lo <= (k) && (k) < hi)
#define SEAM(k) do { if (IN(k) && IN((k) + 1)) xcd_barrier(bar); } while (0)
    bf16* XB = WSP(bf16, WS_XB); bf16* A2 = WSP(bf16, WS_A2); float* Y = F.out + O_Y;
    float* SSQ0 = WSP(float, WS_SSQ); float* SSQ1 = SSQ0 + (size_t)MT * 16; float* SSQ2 = SSQ1 + (size_t)MT * 16; float* SSQ3 = SSQ2 + (size_t)MT * 16;

    if (IN(0)) { p0_prologue(F); } SEAM(0);
    if (IN(1)) { pg8::Gemm g{XB, WSP(bf16, WS_W_IN), MT, NIN, DM}; ep::EpiScale E{WSP(bf16, WS_QKVO), NIN, SSQ0}; run_gemm<ep::EpiScale, true, true>(F, g, E); } SEAM(1);
#if SCAN_MODE == 0
    if (IN(2)) { scan_oracle(F, true, true, true); } SEAM(2);
    if (IN(3)) { gate_pass(F, 0, MT); } SEAM(3);
#elif SCAN_MODE == 1
    if (IN(2)) { s1_state_pass(F); scan_oracle(F, true, true, false); } SEAM(2);
    if (IN(3)) { gate_pass(F, 0, MT); } SEAM(3);
#elif SCAN_MODE == 2
    if (IN(2)) { s1_state_pass(F); scan_oracle(F, false, true, false); } SEAM(2);
    if (IN(3)) { s2_output_pass(F); gate_pass(F, MP, MT); } SEAM(3);
#else
    if (IN(2)) { s3_sample_pass(F); s1_state_pass(F); } SEAM(2);
    if (IN(3)) { s2_output_pass(F); } SEAM(3);
#endif
    if (IN(4)) { pg8::Gemm g{A2, WSP(bf16, WS_W_OUT), MT, DM, DM}; ep::EpiResid<true> E{F.xp, F.xs, Y, XB, SSQ1}; run_gemm<ep::EpiResid<true>, true, true>(F, g, E); } SEAM(4);
    if (IN(5)) { pg8::Gemm g{XB, WSP(bf16, WS_W_GU0), MT, NGU, DM}; ep::EpiSwiGLU E{WSP(bf16, WS_HFF), SSQ1}; run_gemm<ep::EpiSwiGLU, true, true>(F, g, E); } SEAM(5);
    if (IN(6)) { pg8::Gemm g{WSP(bf16, WS_HFF), WSP(bf16, WS_W_DN0), MT, DM, DFF}; ep::EpiResid<true> E{Y, Y + (size_t)MP * DM, Y, XB, SSQ2}; run_gemm<ep::EpiResid<true>, true, true>(F, g, E); } SEAM(6);
    if (IN(7)) { pg8::Gemm g{XB, WSP(bf16, WS_W_CIN), MT, NCIN, DM}; ep::EpiConvIn E{WSP(bf16, WS_BG), WSP(bf16, WS_U), SSQ2, F.out + O_CVP, F.out + O_CVS}; run_gemm<ep::EpiConvIn, true, true>(F, g, E); } SEAM(7);
    if (IN(8)) { conv_pass(F); } SEAM(8);
    if (IN(9)) { pg8::Gemm g{A2, WSP(bf16, WS_W_COUT), MT, DM, DM}; ep::EpiResid<true> E{Y, Y + (size_t)MP * DM, Y, XB, SSQ3}; run_gemm<ep::EpiResid<true>, true, true>(F, g, E); } SEAM(9);
    if (IN(10)) { pg8::Gemm g{XB, WSP(bf16, WS_W_GU1), MT, NGU, DM}; ep::EpiSwiGLU E{WSP(bf16, WS_HFF), SSQ3}; run_gemm<ep::EpiSwiGLU, true, true>(F, g, E); } SEAM(10);
    if (IN(11)) { pg8::Gemm g{WSP(bf16, WS_HFF), WSP(bf16, WS_W_DN1), MT, DM, DFF}; ep::EpiResid<false> E{Y, Y + (size_t)MP * DM, Y, nullptr, nullptr}; run_gemm<ep::EpiResid<false>, true, true>(F, g, E); } SEAM(11);
    if (IN(12)) { final_norm(F); }
#undef IN
#undef SEAM
}

extern "C" void kernel_launch(void* const* d_in, const int* in_sizes, int n_in, void* d_out, int out_size, void* d_ws, size_t ws_size, hipStream_t stream) {
    static int grid = 0;
    if (grid == 0) {
        if (n_in != 18 || in_sizes[0] != MP * DM || (size_t)out_size != O_END || ws_size < WS_END) { fprintf(stderr, "kernel_launch: unexpected shapes: n_in %d in0 %d out %d ws %zu (need out %zu ws %zu)\n", n_in, n_in > 0 ? in_sizes[0] : -1, out_size, ws_size, (size_t)O_END, (size_t)WS_END); grid = -1; return; }
        int dev = 0, cus = 0;
        if (hipGetDevice(&dev) != hipSuccess || hipDeviceGetAttribute(&cus, hipDeviceAttributeMultiprocessorCount, dev) != hipSuccess) { grid = -1; return; }
        if (hipFuncSetAttribute((const void*)fwd_kernel, hipFuncAttributeMaxDynamicSharedMemorySize, LDS_BYTES) != hipSuccess) { fprintf(stderr, "kernel_launch: hipFuncSetAttribute failed\n"); grid = -1; return; }
        (void)hipGetLastError();
        grid = cus;
    }
    if (grid < 0) return;
    (void)hipMemsetAsync((char*)d_ws + WS_CTL, 0, CTL_ZERO_BYTES, stream);
    Args a{};
    for (int i = 0; i < 18; ++i) a.in[i] = (const float*)d_in[i];
    a.out = (float*)d_out; a.ws = (unsigned char*)d_ws;
#if MK_N_LAUNCHES == 1
    a.ph_lo = 0; a.ph_hi = N_PHASES;
    hipLaunchKernelGGL(fwd_kernel, dim3(grid), dim3(NWAVES * 64), LDS_BYTES, stream, a);
#else
    for (int p = 0; p < N_PHASES; ++p) { a.ph_lo = p; a.ph_hi = p + 1; hipLaunchKernelGGL(fwd_kernel, dim3(grid), dim3(NWAVES * 64), LDS_BYTES, stream, a); }
#endif
}
```

```cpp
#include <hip/hip_runtime.h>
#include <cstdio>
#include <cstdint>
#include <cmath>
#define USE_SLOW_GEMM 0
#define MK_N_LAUNCHES 1
#define SCAN_MODE 3
#define FLOW 0
#ifndef FLOW
#define FLOW 0
#endif
#define PG8_A_AUX ((FLOW) ? 16 : 0)
namespace pg8 {
#define PG8_LAS __attribute__((address_space(3)))
typedef unsigned short bf16_t;
typedef short bf16x8 __attribute__((ext_vector_type(8)));
typedef float f32x4 __attribute__((ext_vector_type(4)));
typedef unsigned u32x4 __attribute__((ext_vector_type(4)));
constexpr int BM = 256, BK = 64, HALF = 128, HTB = HALF * BK * 2  , STAGE_BYTES = 8 * HTB, NXCD = 8, WGM = 4;

__host__ __device__ __forceinline__ int lds_byte(int r, int c) { const int st = (r >> 4) * 2 + (c >> 5), rr = r & 15, cc = c & 31, ob = rr * 64 + cc * 2; return st * 1024 + (ob ^ (((ob >> 9) & 1) << 5)); }
__host__ __device__ __forceinline__ void stage_rc(int b, int& R, int& C) { const int st = b / 1024, sb = b % 1024, swz = sb ^ (((sb >> 9) & 1) << 5); R = (st >> 1) * 16 + swz / 64; C = (st & 1) * 32 + (swz % 64) / 2; }
__host__ __device__ __forceinline__ int perm32(int rho) { const int n = rho >> 4, i = rho & 15; return 8 * (i >> 2) + 4 * n + (i & 3); }

struct Unit { int pm, pn; };
struct Gemm { const bf16_t* A; const bf16_t* Bt; int M, N, K; };

struct StaticOrder {
    int nM, nN, nwg, G, c;
    __host__ __device__ void init(int M, int N, int G_, int c_) { nM = M / BM; nN = N / BM; nwg = nM * nN; G = G_; c = c_; }
    __host__ __device__ bool next(int i, Unit& u) const {
        const long L = (long)i * G + c; if (L >= nwg) return false;
        int wgid = (int)L; { const int q = nwg / NXCD, r = nwg % NXCD, xcd = wgid % NXCD, off = wgid / NXCD; wgid = (xcd < r ? xcd * (q + 1) : r * (q + 1) + (xcd - r) * q) + off; }
        const int nig = WGM * nN, gid = wgid / nig, fm = gid * WGM, gsz = (nM - fm) < WGM ? (nM - fm) : WGM;
        u.pm = fm + ((wgid % nig) % gsz); u.pn = (wgid % nig) / gsz; return true;
    }
    __device__ __forceinline__ void a_ready(const Unit&) const {}
    __device__ __forceinline__ void done(const Unit&) const {}
    __device__ __forceinline__ void flush() const {}
};

__device__ __forceinline__ unsigned cvt_pk_bf16(float lo, float hi) { unsigned r; asm volatile("v_cvt_pk_bf16_f32 %0, %1, %2" : "=v"(r) : "v"(lo), "v"(hi)); return r; }
template <class Epi, class Sched, bool ALIGN_EPI = false, bool SP2 = false>
__device__ __forceinline__ void gemm_phase(PG8_LAS unsigned char* lds, const Gemm g, const Sched& S, const Epi& E) {
    const int tid = threadIdx.x, wid = __builtin_amdgcn_readfirstlane(tid >> 6), lane = tid & 63, wr = wid >> 2, wc = wid & 3, fr = lane & 15, fq = lane >> 4;
    const int K = g.K, nt = K / BK;
    unsigned voffA[2], voffB[2];
#pragma unroll
    for (int i = 0; i < 2; ++i) { int R, C; stage_rc(tid * 16 + i * 8192, R, C); const int Rb = Epi::PERM ? ((R & ~31) + perm32(R & 31)) : R;
        voffA[i] = (unsigned)(R * K + C) * 2u; voffB[i] = (unsigned)(Rb * K + C) * 2u; }
    const size_t kstep = (size_t)(BK * 2);
    const size_t hstep = (size_t)HALF * K * 2;
    const size_t tstep = 2 * hstep;
    const unsigned ldsw = (unsigned)wid * 1024u;
    const int aoff = lds_byte(wr * 64 + fr, fq * 8), boff = lds_byte(wc * 32 + fr, fq * 8);
#define PG8_SA(b, h) (((b) * 2 + (h)) * HTB)
#define PG8_SB(b, h) ((4 + (b) * 2 + (h)) * HTB)
#define PG8_STAGE(bufoff, gbase, voff, aux) do { _Pragma("unroll") for (int _i = 0; _i < 2; ++_i) \
        __builtin_amdgcn_global_load_lds((const unsigned*)((const char*)(gbase) + (voff)[_i]), (PG8_LAS unsigned*)(lds + (bufoff) + ldsw + _i * 8192), 16, 0, aux); } while (0)
#define PG8_LDA(dst, b, h) do { _Pragma("unroll") for (int m = 0; m < 4; ++m) _Pragma("unroll") for (int k = 0; k < 2; ++k) dst[m][k] = *(const PG8_LAS bf16x8*)(lds + PG8_SA(b, h) + aoff + m * 2048 + k * 1024); } while (0)
#define PG8_LDB(dst, b, h) do { _Pragma("unroll") for (int n = 0; n < 2; ++n) _Pragma("unroll") for (int k = 0; k < 2; ++k) dst[n][k] = *(const PG8_LAS bf16x8*)(lds + PG8_SB(b, h) + boff + n * 2048 + k * 1024); } while (0)
#define PG8_MMA(ai, bj, At, Bt) do { __builtin_amdgcn_s_setprio(1); _Pragma("unroll") for (int m = 0; m < 4; ++m) _Pragma("unroll") for (int n = 0; n < 2; ++n) _Pragma("unroll") for (int k = 0; k < 2; ++k) \
        acc[ai][bj][m][n] = __builtin_amdgcn_mfma_f32_16x16x32_bf16(Bt[n][k], At[m][k], acc[ai][bj][m][n], 0, 0, 0); __builtin_amdgcn_s_setprio(0); } while (0)
#define PG8_WAIT_V(n) asm volatile("s_waitcnt vmcnt(" #n ")" ::: "memory")
#define PG8_WAIT_L(n) asm volatile("s_waitcnt lgkmcnt(" #n ")" ::: "memory")
#define PG8_BAR __builtin_amdgcn_s_barrier()
#define PG8_SCHED __builtin_amdgcn_sched_barrier(0)
    Unit cur, nxt; int ui = 0;
    if (!S.next(0, cur)) return;
    f32x4 acc[2][2][4][2];
#pragma unroll
    for (int a = 0; a < 2; ++a)
#pragma unroll
        for (int b = 0; b < 2; ++b)
#pragma unroll
            for (int m = 0; m < 4; ++m)
#pragma unroll
                for (int n = 0; n < 2; ++n) acc[a][b][m][n] = (f32x4){0.f, 0.f, 0.f, 0.f};
    bf16x8 At[4][2], B0[2][2], B1[2][2];
    const char* cA = (const char*)g.A + (size_t)cur.pm * tstep; const char* cB = (const char*)g.Bt + (size_t)cur.pn * tstep;
    S.a_ready(cur);
    if constexpr (SP2) {
        PG8_STAGE(PG8_SB(0, 0), cB, voffB, 0); PG8_STAGE(PG8_SB(0, 1), cB + hstep, voffB, 0); PG8_STAGE(PG8_SA(0, 0), cA, voffA, PG8_A_AUX); PG8_STAGE(PG8_SA(0, 1), cA + hstep, voffA, PG8_A_AUX);
        if (wr == 1) PG8_BAR;
        PG8_WAIT_V(2); PG8_BAR;
        PG8_STAGE(PG8_SB(1, 0), cB + kstep, voffB, 0); PG8_STAGE(PG8_SA(1, 0), cA + kstep, voffA, PG8_A_AUX); PG8_STAGE(PG8_SB(1, 1), cB + hstep + kstep, voffB, 0);
        PG8_WAIT_V(6); PG8_BAR;
    } else {
        PG8_STAGE(PG8_SB(0, 0), cB, voffB, 0); PG8_STAGE(PG8_SA(0, 0), cA, voffA, PG8_A_AUX); PG8_STAGE(PG8_SB(0, 1), cB + hstep, voffB, 0); PG8_STAGE(PG8_SA(0, 1), cA + hstep, voffA, PG8_A_AUX);
        if (wr == 1) PG8_BAR;
        PG8_WAIT_V(4); PG8_BAR;
        PG8_STAGE(PG8_SB(1, 0), cB + kstep, voffB, 0); PG8_STAGE(PG8_SA(1, 0), cA + kstep, voffA, PG8_A_AUX); PG8_STAGE(PG8_SB(1, 1), cB + hstep + kstep, voffB, 0);
        PG8_WAIT_V(6); PG8_BAR;
    }
    for (;;) {
        const bool has_next = S.next(ui + 1, nxt);
        const char* nA = has_next ? (const char*)g.A + (size_t)nxt.pm * tstep : cA; const char* nB = has_next ? (const char*)g.Bt + (size_t)nxt.pn * tstep : cB;
        for (int t = 0; t < nt; t += 2) {
            const bool last = (t == nt - 2);
            const char* a1 = cA + (size_t)(t + 1) * kstep;
            const char* a2 = last ? nA : cA + (size_t)(t + 2) * kstep; const char* b2 = last ? nB : cB + (size_t)(t + 2) * kstep;
            const char* a3 = a2 + kstep; const char* b3 = b2 + kstep;
            if (last && has_next) S.a_ready(nxt);
            if constexpr (SP2) {
            PG8_LDB(B0, 0, 0); PG8_LDB(B1, 0, 1); PG8_SCHED; PG8_LDA(At, 0, 0); PG8_STAGE(PG8_SA(1, 1), a1 + hstep, voffA, PG8_A_AUX);
            PG8_WAIT_V(8); PG8_WAIT_L(0); PG8_BAR; PG8_MMA(0, 0, At, B0); PG8_MMA(0, 1, At, B1); PG8_BAR; PG8_SCHED;
            PG8_LDA(At, 0, 1); PG8_STAGE(PG8_SB(0, 0), b2, voffB, 0); PG8_STAGE(PG8_SB(0, 1), b2 + hstep, voffB, 0); PG8_STAGE(PG8_SA(0, 0), a2, voffA, PG8_A_AUX);
            PG8_WAIT_V(8); PG8_WAIT_L(0); PG8_BAR; PG8_MMA(1, 0, At, B0); PG8_MMA(1, 1, At, B1); PG8_BAR; PG8_SCHED;
            PG8_LDB(B0, 1, 0); PG8_LDB(B1, 1, 1); PG8_SCHED; PG8_LDA(At, 1, 0); PG8_STAGE(PG8_SA(0, 1), a2 + hstep, voffA, PG8_A_AUX);
            PG8_WAIT_V(8); PG8_WAIT_L(0); PG8_BAR; PG8_MMA(0, 0, At, B0); PG8_MMA(0, 1, At, B1); PG8_BAR; PG8_SCHED;
            PG8_LDA(At, 1, 1); PG8_STAGE(PG8_SB(1, 0), b3, voffB, 0); PG8_STAGE(PG8_SB(1, 1), b3 + hstep, voffB, 0); PG8_STAGE(PG8_SA(1, 0), a3, voffA, PG8_A_AUX);
            PG8_WAIT_V(8); PG8_WAIT_L(0); PG8_BAR; PG8_MMA(1, 0, At, B0); PG8_MMA(1, 1, At, B1); PG8_BAR; PG8_SCHED;
            } else {
            PG8_LDB(B0, 0, 0); PG8_SCHED; PG8_LDA(At, 0, 0); PG8_STAGE(PG8_SA(1, 1), a1 + hstep, voffA, PG8_A_AUX);
            PG8_WAIT_L(8); PG8_BAR; PG8_WAIT_L(0); PG8_MMA(0, 0, At, B0); PG8_BAR; PG8_SCHED;
            PG8_LDB(B1, 0, 1); PG8_STAGE(PG8_SB(0, 0), b2, voffB, 0);
            PG8_BAR; PG8_WAIT_L(0); PG8_MMA(0, 1, At, B1); PG8_BAR;
            PG8_LDA(At, 0, 1); PG8_STAGE(PG8_SA(0, 0), a2, voffA, PG8_A_AUX);
            PG8_BAR; PG8_WAIT_L(0); PG8_MMA(1, 0, At, B0); PG8_BAR; PG8_SCHED;
            PG8_STAGE(PG8_SB(0, 1), b2 + hstep, voffB, 0);
            PG8_WAIT_V(6); PG8_BAR; PG8_MMA(1, 1, At, B1); PG8_BAR;
            PG8_LDB(B0, 1, 0); PG8_SCHED; PG8_LDA(At, 1, 0); PG8_STAGE(PG8_SA(0, 1), a2 + hstep, voffA, PG8_A_AUX);
            PG8_WAIT_L(8); PG8_BAR; PG8_WAIT_L(0); PG8_MMA(0, 0, At, B0); PG8_BAR; PG8_SCHED;
            PG8_LDB(B1, 1, 1); PG8_STAGE(PG8_SB(1, 0), b3, voffB, 0);
            PG8_BAR; PG8_WAIT_L(0); PG8_MMA(0, 1, At, B1); PG8_BAR;
            PG8_LDA(At, 1, 1); PG8_STAGE(PG8_SA(1, 0), a3, voffA, PG8_A_AUX);
            PG8_BAR; PG8_WAIT_L(0); PG8_MMA(1, 0, At, B0); PG8_BAR; PG8_SCHED;
            PG8_STAGE(PG8_SB(1, 1), b3 + hstep, voffB, 0);
            PG8_WAIT_V(6); PG8_BAR; PG8_MMA(1, 1, At, B1); PG8_BAR;
            }
            if (t == 0) S.flush();
        }
        if constexpr (ALIGN_EPI) { if (wr == 0) PG8_BAR; }
        if constexpr (!Epi::AFTER_DRAIN) { E(acc, cur, wr, wc, fr, fq); S.done(cur); }
        if (!has_next) break;
#pragma unroll
        for (int a = 0; a < 2; ++a)
#pragma unroll
            for (int b = 0; b < 2; ++b)
#pragma unroll
                for (int m = 0; m < 4; ++m)
#pragma unroll
                    for (int n = 0; n < 2; ++n) acc[a][b][m][n] = (f32x4){0.f, 0.f, 0.f, 0.f};
        cur = nxt; cA = nA; cB = nB; ++ui;
        if constexpr (ALIGN_EPI) { if (wr == 1) PG8_BAR; }
    }
    PG8_WAIT_V(0);
    if constexpr (!ALIGN_EPI) { if (wr == 0) PG8_BAR; }
    PG8_BAR;
    if constexpr (Epi::AFTER_DRAIN) { E.fused(acc, cur, wr, wc, fr, fq, lds, wid, lane); S.done(cur); }
    S.flush();
#undef PG8_SA
#undef PG8_SB
#undef PG8_STAGE
#undef PG8_LDA
#undef PG8_LDB
#undef PG8_MMA
#undef PG8_WAIT_V
#undef PG8_WAIT_L
#undef PG8_BAR
#undef PG8_SCHED
}
}
constexpr int DM = 1024;
constexpr int NB_P = 8, S_P = 2048, NB_S = 128, S_S = 8;
constexpr int MP = NB_P * S_P, MS = NB_S * S_S, MT = MP + MS;
constexpr int NH = 4, DK = 256, DV = 256;
constexpr int NIN = 4096, NIN_SRC = 4104;
constexpr int DFF = 2816, NGU = 2 * DFF, NCIN = 3 * DM;
constexpr float EPS = 1e-6f;
constexpr int NWAVES = 8;

constexpr size_t O_Y = 0;
constexpr size_t O_CP = (size_t)MT * DM;
constexpr size_t O_NP = O_CP + (size_t)NB_P * NH * DV * DK;
constexpr size_t O_MP = O_NP + (size_t)NB_P * NH * DK;
constexpr size_t O_CVP = O_MP + (size_t)NB_P * NH;
constexpr size_t O_CS = O_CVP + (size_t)NB_P * 2 * DM;
constexpr size_t O_NS = O_CS + (size_t)NB_S * NH * DV * DK;
constexpr size_t O_MS = O_NS + (size_t)NB_S * NH * DK;
constexpr size_t O_CVS = O_MS + (size_t)NB_S * NH;
constexpr size_t O_END = O_CVS + (size_t)NB_S * 2 * DM;

constexpr size_t MiB = 1u << 20;
constexpr size_t WS_CTL = 0, CTL_ZERO_BYTES = 32768;
constexpr size_t WS_W_IN = 2 * MiB, WS_W_OUT = 10 * MiB, WS_W_GU0 = 12 * MiB, WS_W_DN0 = 23 * MiB, WS_W_CIN = 29 * MiB, WS_W_COUT = 35 * MiB, WS_W_GU1 = 37 * MiB, WS_W_DN1 = 48 * MiB;
constexpr size_t SSQ_BYTES = (size_t)MT * 16 * 4;
constexpr size_t WS_SSQ = 54 * MiB;
constexpr size_t WS_GATES = 59 * MiB;
constexpr size_t WS_XB = 60 * MiB;
constexpr size_t WS_A2 = 94 * MiB;
constexpr size_t WS_QKVO = 128 * MiB;
constexpr size_t WS_HFF = 128 * MiB;
constexpr size_t WS_BG = 264 * MiB, WS_U = 298 * MiB;
constexpr size_t WS_HBUF = 264 * MiB;
constexpr size_t WS_CST = 332 * MiB;
constexpr size_t WS_NST = 396 * MiB;
constexpr size_t WS_MST = WS_NST + (size_t)32 * 16 * 256 * 4;
constexpr size_t WS_GV = 397 * MiB;
constexpr size_t WS_DRY = 398 * MiB;
constexpr size_t WS_END = 398 * MiB;
static_assert(WS_SSQ + 4 * SSQ_BYTES <= WS_GATES && WS_GATES + (size_t)MT * 8 * 4 <= WS_XB && WS_XB + (size_t)MT * DM * 2 <= WS_A2 && WS_A2 + (size_t)MT * DM * 2 <= WS_QKVO, "ws map");
static_assert(WS_QKVO + (size_t)MT * NIN * 2 <= WS_HBUF && WS_HFF + (size_t)MT * DFF * 2 <= WS_HBUF && WS_BG + (size_t)MT * DM * 2 <= WS_U && WS_U + (size_t)MT * DM * 2 <= WS_CST && WS_HBUF + (size_t)MT * DM * 4 <= WS_CST, "ws map 2");
static_assert(WS_W_DN1 + (size_t)DM * DFF * 2 <= WS_SSQ, "ws map 3");
constexpr int CW_BAR = 4096;

constexpr int RING_OFF = 0, RING_BYTES = 131072;
constexpr int LDSCTL_OFF = RING_BYTES, MISC_OFF = LDSCTL_OFF + 320;
constexpr int SCR_OFF = 132096;
constexpr int LDS_BYTES = 163840;

#define GAS __attribute__((address_space(1)))
#define LAS __attribute__((address_space(3)))
typedef unsigned short bf16;
typedef unsigned v4u __attribute__((ext_vector_type(4)));
typedef unsigned v2u __attribute__((ext_vector_type(2)));
typedef float f32x4 __attribute__((ext_vector_type(4)));
typedef short bf16x8 __attribute__((ext_vector_type(8)));
typedef GAS unsigned gu32;
typedef GAS unsigned long long gu64;
#define RLX_AGENT __ATOMIC_RELAXED, __HIP_MEMORY_SCOPE_AGENT
#define LDS_WAIT() asm volatile("s_waitcnt lgkmcnt(0)" ::: "memory")
#define VM_WAIT() asm volatile("s_waitcnt vmcnt(0)" ::: "memory")
__device__ __forceinline__ unsigned f2bf(float f) { unsigned u = __builtin_bit_cast(unsigned, f); return (u + 0x7fffu + ((u >> 16) & 1u)) >> 16; }
__device__ __forceinline__ unsigned pk2(float lo, float hi) { return f2bf(lo) | (f2bf(hi) << 16); }
__device__ __forceinline__ float bf2f(unsigned short s) { return __builtin_bit_cast(float, (unsigned)s << 16); }
__device__ __forceinline__ float bflo(unsigned w) { return __builtin_bit_cast(float, w << 16); }
__device__ __forceinline__ float bfhi(unsigned w) { return __builtin_bit_cast(float, w & 0xffff0000u); }
__device__ __forceinline__ float wave_sum(float v) {
#pragma unroll
    for (int o = 1; o < 64; o <<= 1) v += __shfl_xor(v, o);
    return v;
}
__device__ __forceinline__ float sigmoidf_(float x) { return 1.f / (1.f + __expf(-x)); }
__device__ __forceinline__ float logsigmoidf_(float x) { return fminf(x, 0.f) - log1pf(expf(-fabsf(x))); }
#define XB_TMO      128
#define XB_XCNT(j)  (256  + 64 * (j))
#define XB_XSUB(j)  (1280 + 64 * (j))
#define XB_XGEN(j)  (2304 + 64 * (j))
#define XB_TOP      3328
#define XB_TOPGEN   3392
#define XCD_BAR_WORDS 3456
#define XB_SPIN_CAP (1u << 18)

__device__ __forceinline__ unsigned xb_ld(unsigned* p)              { return __hip_atomic_load(p, __ATOMIC_RELAXED, __HIP_MEMORY_SCOPE_AGENT); }
__device__ __forceinline__ unsigned xb_add(unsigned* p, unsigned v) { return __hip_atomic_fetch_add(p, v, __ATOMIC_RELAXED, __HIP_MEMORY_SCOPE_AGENT); }
__device__ __forceinline__ unsigned xb_xcc_id() { return (unsigned)__builtin_amdgcn_s_getreg((3 << 11) | 20) & 0xFu; }
#define XB_SPIN(cond, bar) do { unsigned _sp = 0; while (cond) { __builtin_amdgcn_s_sleep(1); \
    if ((++_sp & 255u) == 0u) { if (xb_ld(&(bar)[XB_TMO])) break; if (_sp > XB_SPIN_CAP) { atomicAdd(&(bar)[XB_TMO], 1u); break; } } } } while (0)

struct XcdBarrier {
    unsigned* bar; unsigned x;
    volatile LAS unsigned* st;
};

__device__ __forceinline__ XcdBarrier xcd_barrier_post(unsigned* bar, volatile LAS unsigned* st) {
    XcdBarrier b; b.bar = bar; b.x = xb_xcc_id(); b.st = st;
    if (threadIdx.x == 0) (void)xb_add(&bar[XB_XCNT(b.x)], 1u);
    return b;
}
__device__ __forceinline__ void xcd_barrier_complete(unsigned* bar, unsigned x, unsigned& nloc, unsigned& nx) {
    const unsigned G = gridDim.x * gridDim.y * gridDim.z;
    unsigned sum, cnt, mine, sp = 0u;
    for (;;) {
        sum = 0u; cnt = 0u; mine = 0u;
#pragma unroll
        for (unsigned j = 0; j < 16; ++j) { const unsigned c = xb_ld(&bar[XB_XCNT(j)]); sum += c; cnt += (c > 0u) ? 1u : 0u; mine = (j == x) ? c : mine; }
        if (sum == G) break;
        __builtin_amdgcn_s_sleep(1);
        if ((++sp & 255u) == 0u) { if (xb_ld(&bar[XB_TMO])) break; if (sp > XB_SPIN_CAP) { atomicAdd(&bar[XB_TMO], 1u); break; } }
    }
    nloc = mine > 0u ? mine : 1u; nx = cnt > 0u ? cnt : 1u;
}

__device__ __forceinline__ void xcd_barrier(const XcdBarrier& b) {
    asm volatile("s_waitcnt vmcnt(0)" ::: "memory");
    __syncthreads();
    if (threadIdx.x == 0) {
        unsigned* bar = b.bar;
        __builtin_amdgcn_s_waitcnt(0);
        unsigned nloc = b.st[0], nx = b.st[1];
        if (nloc == 0u) { xcd_barrier_complete(bar, b.x, nloc, nx); b.st[0] = nloc; b.st[1] = nx; }
        const unsigned old = xb_add(&bar[XB_XSUB(b.x)], 1u);
        const unsigned gen = old / nloc;
        if (old + 1u == (gen + 1u) * nloc) {
            __builtin_amdgcn_fence(__ATOMIC_RELEASE, "agent");
            asm volatile("s_waitcnt vmcnt(0)" ::: "memory");
            const unsigned og = xb_add(&bar[XB_TOP], 1u);
            const unsigned tg = og / nx;
            if (og + 1u == (tg + 1u) * nx) xb_add(&bar[XB_TOPGEN], 1u);
            else XB_SPIN(xb_ld(&bar[XB_TOPGEN]) == tg, bar);
            __builtin_amdgcn_fence(__ATOMIC_ACQUIRE, "agent");
            xb_add(&bar[XB_XGEN(b.x)], 1u);
            asm volatile("s_waitcnt vmcnt(0)" ::: "memory");
        } else {
            XB_SPIN(xb_ld(&bar[XB_XGEN(b.x)]) == gen, bar);
            __builtin_amdgcn_fence(__ATOMIC_ACQUIRE, "agent");
            asm volatile("s_waitcnt vmcnt(0)" ::: "memory");
        }
    }
    __syncthreads();
}
struct Frame {
    LAS unsigned char* lds;
    volatile LAS unsigned* MISC;
    gu32* ctl;
    int tid, lane, wave, vcu, G;
    const float *xp, *xs, *stC, *stN, *stM, *stConv, *norm_mix, *norm_ffn, *norm_final, *w_in, *b_gate, *head_norm, *w_out, *w_cin, *w_taps, *w_cout, *w_gu, *w_dn;
    float* out; unsigned char* ws;
};
#define WSP(T, off) ((T*)(F.ws + (off)))

namespace ep {
using pg8::Unit; using pg8::bf16_t; using pg8::cvt_pk_bf16; using pg8::BM; using pg8::HALF; using pg8::u32x4;
__device__ __forceinline__ float row_rs(const float* slab, int row) {
    const f32x4* p = (const f32x4*)(slab + (size_t)row * 16);
    const f32x4 a = p[0], b = p[1], c = p[2], d = p[3];
    const float s = (((a.x + a.y) + (a.z + a.w)) + ((b.x + b.y) + (b.z + b.w))) + (((c.x + c.y) + (c.z + c.w)) + ((d.x + d.y) + (d.z + d.w)));
    return rsqrtf(s * (1.f / 1024.f) + EPS);
}
__device__ __forceinline__ u32x4 pack8(const f32x4 v0, const f32x4 v1) { u32x4 w; w.x = cvt_pk_bf16(v0[0], v0[1]); w.y = cvt_pk_bf16(v0[2], v0[3]); w.z = cvt_pk_bf16(v1[0], v1[1]); w.w = cvt_pk_bf16(v1[2], v1[3]); return w; }

struct EpiScale {
    static constexpr bool PERM = true, AFTER_DRAIN = false;
    bf16_t* O; int ldc; const float* ssq;
    __device__ __forceinline__ void operator()(const f32x4 (&acc)[2][2][4][2], const Unit& u, int wr, int wc, int fr, int fq) const {
        const int row0 = u.pm * BM + wr * 64 + fr, col0 = u.pn * BM + wc * 32 + 8 * fq;
#pragma unroll
        for (int ai = 0; ai < 2; ++ai)
#pragma unroll
            for (int m = 0; m < 4; ++m) { const int row = row0 + ai * HALF + m * 16; const float r = row_rs(ssq, row); bf16_t* rowp = O + (size_t)row * ldc + col0;
#pragma unroll
                for (int bj = 0; bj < 2; ++bj) *(u32x4*)(rowp + bj * HALF) = pack8(acc[ai][bj][m][0] * r, acc[ai][bj][m][1] * r); }
    }
};
__device__ __forceinline__ float silu_mul(float g, float u) { return g / (1.f + __expf(-g)) * u; }
struct EpiSwiGLU {
    static constexpr bool PERM = true, AFTER_DRAIN = false;
    bf16_t* O; const float* ssq;
    __device__ __forceinline__ void operator()(const f32x4 (&acc)[2][2][4][2], const Unit& u, int wr, int wc, int fr, int fq) const {
        const int row0 = u.pm * BM + wr * 64 + fr, col0 = u.pn * HALF + wc * 32 + 8 * fq;
#pragma unroll
        for (int ai = 0; ai < 2; ++ai)
#pragma unroll
            for (int m = 0; m < 4; ++m) { const int row = row0 + ai * HALF + m * 16; const float r = row_rs(ssq, row);
                const f32x4 g0 = acc[ai][0][m][0] * r, g1 = acc[ai][0][m][1] * r, u0 = acc[ai][1][m][0] * r, u1 = acc[ai][1][m][1] * r;
                f32x4 h0, h1;
#pragma unroll
                for (int j = 0; j < 4; ++j) { h0[j] = silu_mul(g0[j], u0[j]); h1[j] = silu_mul(g1[j], u1[j]); }
                *(u32x4*)(O + (size_t)row * DFF + col0) = pack8(h0, h1); }
    }
};
template <bool WB> struct EpiResid {
    static constexpr bool PERM = true, AFTER_DRAIN = false;
    bf16_t* XB; float* ssq;
    __device__ __forceinline__ void operator()(const f32x4 (&acc)[2][2][4][2], const Unit& u, int wr, int wc, int fr, int fq) const {
        const int row0 = u.pm * BM + wr * 64 + fr, col0 = u.pn * BM + wc * 32 + 8 * fq;
#pragma unroll
        for (int ai = 0; ai < 2; ++ai)
#pragma unroll
            for (int m = 0; m < 4; ++m) { const int row = row0 + ai * HALF + m * 16; bf16_t* xp = XB + (size_t)row * DM + col0;
                float ss = 0.f;
#pragma unroll
                for (int bj = 0; bj < 2; ++bj) { const u32x4 bw = *(const u32x4*)(xp + bj * HALF);
                    const f32x4 x0 = (f32x4){bflo(bw.x), bfhi(bw.x), bflo(bw.y), bfhi(bw.y)} + acc[ai][bj][m][0], x1 = (f32x4){bflo(bw.z), bfhi(bw.z), bflo(bw.w), bfhi(bw.w)} + acc[ai][bj][m][1];
                    const u32x4 ow = pack8(x0, x1); *(u32x4*)(xp + bj * HALF) = ow;
                    if (WB) { const float r0 = bflo(ow.x), r1 = bfhi(ow.x), r2 = bflo(ow.y), r3 = bfhi(ow.y), r4 = bflo(ow.z), r5 = bfhi(ow.z), r6 = bflo(ow.w), r7 = bfhi(ow.w);
                        ss += ((r0 * r0 + r1 * r1) + (r2 * r2 + r3 * r3)) + ((r4 * r4 + r5 * r5) + (r6 * r6 + r7 * r7)); } }
                if (WB) { ss += __shfl_xor(ss, 16); ss += __shfl_xor(ss, 32); if (fq == 0) ssq[(size_t)row * 16 + u.pn * 4 + wc] = ss; } }
    }
};
struct EpiConvIn {
    static constexpr bool PERM = true, AFTER_DRAIN = false;
    bf16_t* BG; bf16_t* U; const float* ssq; float* cvP; float* cvS;
    __device__ __forceinline__ void operator()(const f32x4 (&acc)[2][2][4][2], const Unit& u, int wr, int wc, int fr, int fq) const {
        const int row0 = u.pm * BM + wr * 64 + fr;
        if (u.pn < 4) {
            const int col0 = u.pn * BM + wc * 32 + 8 * fq;
#pragma unroll
            for (int ai = 0; ai < 2; ++ai)
#pragma unroll
                for (int m = 0; m < 4; ++m) { const int row = row0 + ai * HALF + m * 16; const float r = row_rs(ssq, row); bf16_t* rowp = BG + (size_t)row * DM + col0;
#pragma unroll
                    for (int bj = 0; bj < 2; ++bj) *(u32x4*)(rowp + bj * HALF) = pack8(acc[ai][bj][m][0] * r, acc[ai][bj][m][1] * r); }
        } else {
            const int col0 = (u.pn - 4) * HALF + wc * 32 + 8 * fq;
#pragma unroll
            for (int ai = 0; ai < 2; ++ai)
#pragma unroll
                for (int m = 0; m < 4; ++m) { const int row = row0 + ai * HALF + m * 16; const float r = row_rs(ssq, row);
                    const f32x4 p0 = (acc[ai][0][m][0] * r) * (acc[ai][1][m][0] * r), p1 = (acc[ai][0][m][1] * r) * (acc[ai][1][m][1] * r);
                    *(u32x4*)(U + (size_t)row * DM + col0) = pack8(p0, p1);
                    float* sp = nullptr;
                    if (row < MP) { const int t = row & (S_P - 1), b = row >> 11; if (t >= S_P - 2) sp = cvP + (size_t)(b * 2 + (t - (S_P - 2))) * DM + col0; }
                    else { const int rs = row - MP, t = rs & (S_S - 1), b = rs >> 3; if (t >= S_S - 2) sp = cvS + (size_t)(b * 2 + (t - (S_S - 2))) * DM + col0; }
                    if (sp) { *(f32x4*)sp = p0; *(f32x4*)(sp + 4) = p1; } }
        }
    }
};
}

template <class Epi, class Sched>
__device__ __forceinline__ void gemm_phase_slow(const pg8::Gemm g, const Sched& S, const Epi& E) {
    const int tid = threadIdx.x, wid = __builtin_amdgcn_readfirstlane(tid >> 6), lane = tid & 63, wr = wid >> 2, wc = wid & 3, fr = lane & 15, fq = lane >> 4;
    const int K = g.K;
    pg8::Unit u;
    for (int i = 0; S.next(i, u); ++i) {
        f32x4 acc[2][2][4][2];
#pragma unroll
        for (int a = 0; a < 2; ++a)
#pragma unroll
            for (int b = 0; b < 2; ++b)
#pragma unroll
                for (int m = 0; m < 4; ++m)
#pragma unroll
                    for (int n = 0; n < 2; ++n) acc[a][b][m][n] = (f32x4){0.f, 0.f, 0.f, 0.f};
        const unsigned offA = (unsigned)(wr * 64 + fr) * (unsigned)K * 2u, offB = (unsigned)(wc * 32 + (Epi::PERM ? 8 * fq : 4 * fq)) * (unsigned)K * 2u;
        const char* Au = (const char*)g.A + (size_t)u.pm * 256 * K * 2; const char* Bu = (const char*)g.Bt + (size_t)u.pn * 256 * K * 2;
#pragma unroll
        for (int ai = 0; ai < 2; ++ai) {
#pragma unroll 1
        for (int k0 = 0; k0 < K; k0 += 2) {
            float af[4][2];
#pragma unroll
            for (int m = 0; m < 4; ++m) { const unsigned w = *(const unsigned*)(Au + ((size_t)(ai * 128 + m * 16) * K + k0) * 2 + offA); af[m][0] = bflo(w); af[m][1] = bfhi(w); }
#pragma unroll
            for (int bj = 0; bj < 2; ++bj)
#pragma unroll
                for (int n = 0; n < 2; ++n)
#pragma unroll
                    for (int j = 0; j < 4; ++j) { const unsigned w = *(const unsigned*)(Bu + ((size_t)(bj * 128 + (Epi::PERM ? 4 * n : 16 * n) + j) * K + k0) * 2 + offB);
                        const float b0 = bflo(w), b1 = bfhi(w);
#pragma unroll
                        for (int m = 0; m < 4; ++m) acc[ai][bj][m][n][j] += af[m][0] * b0 + af[m][1] * b1; }
        }
        }
        E(acc, u, wr, wc, fr, fq);
    }
}
#ifndef USE_SLOW_GEMM
#define USE_SLOW_GEMM 0
#endif
template <class Epi, bool ALIGN, bool SP2>
__device__ __forceinline__ void run_gemm(Frame& F, const pg8::Gemm g, const Epi& E) {
    pg8::StaticOrder S; S.init(g.M, g.N, F.G, (int)blockIdx.x);
#if USE_SLOW_GEMM
    gemm_phase_slow<Epi, pg8::StaticOrder>(g, S, E);
#else
    pg8::gemm_phase<Epi, pg8::StaticOrder, ALIGN, SP2>(F.lds + RING_OFF, g, S, E);
#endif
}

#ifndef TS_PROBE
#define TS_PROBE -1
#endif
#if TS_PROBE >= 0
#define P0STAMP(i) do { if (blockIdx.x == 0 && F.tid == 0) ((unsigned long long*)(F.ctl + 2048))[(i)] = __builtin_amdgcn_s_memrealtime(); } while (0)
#else
#define P0STAMP(i) do { } while (0)
#endif
__device__ __forceinline__ int map_row(int kind, int n0) {
    if (kind == 2) { if (n0 < DFF) return 256 * (n0 >> 7) + (n0 & 127); const int j = n0 - DFF; return 256 * (j >> 7) + 128 + (j & 127); }
    if (kind == 3) { if (n0 < DM) return n0; if (n0 < 2 * DM) { const int j = n0 - DM; return DM + 256 * (j >> 7) + (j & 127); } const int j = n0 - 2 * DM; return DM + 256 * (j >> 7) + 128 + (j & 127); }
    return n0;
}
__device__ __forceinline__ void p0_transpose_item(const float* __restrict__ W, int K, int N, int ldw, bf16* __restrict__ WT, int kind, const float* __restrict__ kscale, int item, int lane) {
    const int nblk = N / 64, kb = item / nblk, nb = item % nblk, k0 = 64 * kb, n0 = 64 * nb;
    const float ns = (kind == 1 && n0 < 1024) ? 0.0625f : 1.f;
    const float* src = W + (size_t)k0 * ldw + n0 + lane;
    float v[64];
#pragma unroll
    for (int i = 0; i < 64; ++i) v[i] = src[(size_t)i * ldw];
    bf16* dst = WT + (size_t)(map_row(kind, n0 & ~127) + (n0 & 127) + lane) * K + k0;
#pragma unroll
    for (int c = 0; c < 8; ++c) {
        float s[8];
#pragma unroll
        for (int e = 0; e < 8; ++e) s[e] = v[8 * c + e] * (kscale ? kscale[k0 + 8 * c + e] * ns : ns);
        v4u o; o.x = pk2(s[0], s[1]); o.y = pk2(s[2], s[3]); o.z = pk2(s[4], s[5]); o.w = pk2(s[6], s[7]);
        *(GAS v4u*)(dst + 8 * c) = o;
    }
}
__device__ __forceinline__ void p0_prologue(Frame& F) {
    const int gw = F.vcu * NWAVES + F.wave, NGW = F.G * NWAVES;
    float wgv[16];
#pragma unroll
    for (int i = 0; i < 16; ++i) { const int idx = F.tid + i * NWAVES * 64, k = idx >> 3, jg = idx & 7; wgv[i] = F.w_in[(size_t)k * NIN_SRC + NIN + jg] * F.norm_mix[k]; }
    constexpr int I0 = 16 * 64, I1 = 16 * 16, I2 = 16 * 88, I3 = 44 * 16, I4 = 16 * 48, I5 = 16 * 16, I6 = I2, I7 = I3;
    constexpr int NITEMS = I0 + I1 + I2 + I3 + I4 + I5 + I6 + I7;
    for (int it = gw; it < NITEMS; it += NGW) {
        int r = it;
        if (r < I0) { p0_transpose_item(F.w_in, DM, NIN, NIN_SRC, WSP(bf16, WS_W_IN), 1, F.norm_mix, r, F.lane); continue; } r -= I0;
        if (r < I1) { p0_transpose_item(F.w_out, DM, DM, DM, WSP(bf16, WS_W_OUT), 0, nullptr, r, F.lane); continue; } r -= I1;
        if (r < I2) { p0_transpose_item(F.w_gu, DM, NGU, NGU, WSP(bf16, WS_W_GU0), 2, F.norm_ffn, r, F.lane); continue; } r -= I2;
        if (r < I3) { p0_transpose_item(F.w_dn, DFF, DM, DM, WSP(bf16, WS_W_DN0), 0, nullptr, r, F.lane); continue; } r -= I3;
        if (r < I4) { p0_transpose_item(F.w_cin, DM, NCIN, NCIN, WSP(bf16, WS_W_CIN), 3, F.norm_mix + DM, r, F.lane); continue; } r -= I4;
        if (r < I5) { p0_transpose_item(F.w_cout, DM, DM, DM, WSP(bf16, WS_W_COUT), 0, nullptr, r, F.lane); continue; } r -= I5;
        if (r < I6) { p0_transpose_item(F.w_gu + (size_t)DM * NGU, DM, NGU, NGU, WSP(bf16, WS_W_GU1), 2, F.norm_ffn + DM, r, F.lane); continue; } r -= I6;
        p0_transpose_item(F.w_dn + (size_t)DFF * DM, DFF, DM, DM, WSP(bf16, WS_W_DN1), 0, nullptr, r, F.lane);
    }
    P0STAMP(20);
    __syncthreads();
    LAS float* WG = (LAS float*)(F.lds + RING_OFF);
#pragma unroll
    for (int i = 0; i < 16; ++i) { const int idx = F.tid + i * NWAVES * 64, k = idx >> 3, jg = idx & 7; WG[(((k >> 8) * 4 + (k & 3)) * 64 + ((k & 255) >> 2)) * 8 + jg] = wgv[i]; }
    __syncthreads();
    P0STAMP(21);
    { float* z = WSP(float, WS_SSQ) + (size_t)MT * 16;
      for (int i = F.vcu * NWAVES * 64 + F.tid; i < 3 * MS * 16; i += F.G * NWAVES * 64) { const int s = i / (MS * 16), o = i % (MS * 16); z[(size_t)s * MT * 16 + (size_t)MP * 16 + o] = 0.f; } }
    bf16* XB = WSP(bf16, WS_XB); float* SSQ0 = WSP(float, WS_SSQ); float* GATES = WSP(float, WS_GATES);
    const int lane = F.lane, gidx = 4 * ((lane >> 5) & 1) + 2 * ((lane >> 4) & 1) + ((lane >> 3) & 1);
    const float bg_l = F.b_gate[gidx];
    for (int row0 = gw; row0 < MT; row0 += 4 * NGW) {
        f32x4 v[4][4]; float s[4] = {0.f, 0.f, 0.f, 0.f};
#pragma unroll
        for (int rr = 0; rr < 4; ++rr) { const int row = row0 + rr * NGW; if (row < MT) { const float* xrow = row < MP ? F.xp + (size_t)row * DM : F.xs + (size_t)(row - MP) * DM; const GAS f32x4* xr = (const GAS f32x4*)xrow + lane;
#pragma unroll
                for (int j = 0; j < 4; ++j) v[rr][j] = xr[64 * j]; } else {
#pragma unroll
                for (int j = 0; j < 4; ++j) v[rr][j] = (f32x4){0.f, 0.f, 0.f, 0.f}; } }
#pragma unroll
        for (int rr = 0; rr < 4; ++rr) {
            const int row = row0 + rr * NGW; if (row >= MT) continue;
#pragma unroll
            for (int j = 0; j < 4; ++j) s[rr] += (v[rr][j].x * v[rr][j].x + v[rr][j].y * v[rr][j].y) + (v[rr][j].z * v[rr][j].z + v[rr][j].w * v[rr][j].w);
            const float ssq = wave_sum(s[rr]), r = rsqrtf(ssq * (1.f / 1024.f) + EPS);
            GAS unsigned long long* o8 = (GAS unsigned long long*)(XB + (size_t)row * DM) + lane;
#pragma unroll
            for (int j = 0; j < 4; ++j) o8[64 * j] = (unsigned long long)pk2(v[rr][j].x, v[rr][j].y) | ((unsigned long long)pk2(v[rr][j].z, v[rr][j].w) << 32);
            if (lane < 16) SSQ0[(size_t)row * 16 + lane] = lane == 0 ? ssq : 0.f;
            f32x4 ga = (f32x4){0.f, 0.f, 0.f, 0.f}, gb = ga;
#pragma unroll
            for (int j = 0; j < 4; ++j)
#pragma unroll
                for (int e = 0; e < 4; ++e) { const LAS float* wp = WG + ((j * 4 + e) * 64 + lane) * 8; const f32x4 w0 = *(const LAS f32x4*)wp, w1 = *(const LAS f32x4*)(wp + 4); ga += w0 * v[rr][j][e]; gb += w1 * v[rr][j][e]; }
            float t4[4], t2[2], t1;
#pragma unroll
            for (int i = 0; i < 4; ++i) { const float snd = (lane & 32) ? ga[i] : gb[i], kp = (lane & 32) ? gb[i] : ga[i]; t4[i] = kp + __shfl_xor(snd, 32); }
#pragma unroll
            for (int i = 0; i < 2; ++i) { const float snd = (lane & 16) ? t4[i] : t4[2 + i], kp = (lane & 16) ? t4[2 + i] : t4[i]; t2[i] = kp + __shfl_xor(snd, 16); }
            { const float snd = (lane & 8) ? t2[0] : t2[1], kp = (lane & 8) ? t2[1] : t2[0]; t1 = kp + __shfl_xor(snd, 8); }
            t1 += __shfl_xor(t1, 1); t1 += __shfl_xor(t1, 2); t1 += __shfl_xor(t1, 4);
            const float gate = t1 * r + bg_l;
            if ((lane & 7) == 0) GATES[(size_t)row * 8 + gidx] = gidx < 4 ? gate : logsigmoidf_(gate);
        }
    }
}

__device__ __forceinline__ void scan_oracle(Frame& F, const bool do_p, const bool do_s, const bool wr_p) {
    const bf16* QKVO = WSP(bf16, WS_QKVO); const float* GATES = WSP(float, WS_GATES); float* HBUF = WSP(float, WS_HBUF);
    constexpr int NU_P = NB_P * NH * 32, NU_S = NB_S * NH * 32;
    for (int un = F.vcu + (do_p ? 0 : NU_P); un < (do_s ? NU_P + NU_S : NU_P); un += F.G) {
        const bool smp = un >= NU_P; const int uu = smp ? un - NU_P : un; const int vg = uu & 31, h = (uu >> 5) & 3, b = uu >> 7;
        const int S = smp ? S_S : S_P, rowbase = smp ? MP + b * S_S : b * S_P;
        const int v = 8 * vg + F.wave, d0 = 4 * F.lane;
        f32x4 C = (f32x4){0.f, 0.f, 0.f, 0.f}, n = C; float m = 0.f;
        if (smp) { C = *(const f32x4*)(F.stC + ((size_t)(b * NH + h) * DV + v) * DK + d0); n = *(const f32x4*)(F.stN + (size_t)(b * NH + h) * DK + d0); m = F.stM[b * NH + h]; }
        for (int t0 = 0; t0 < S; t0 += 8) {
            v2u qw[8], kw[8]; unsigned short vw[8]; float li[8], lf[8];
#pragma unroll
            for (int i = 0; i < 8; ++i) { const size_t row = (size_t)(rowbase + t0 + i); const bf16* bp = QKVO + row * NIN + 256 * h;
                qw[i] = *(const v2u*)(bp + d0); kw[i] = *(const v2u*)(bp + 1024 + d0); vw[i] = bp[2048 + v]; li[i] = GATES[row * 8 + h]; lf[i] = GATES[row * 8 + 4 + h]; }
#pragma unroll
            for (int i = 0; i < 8; ++i) {
                const float mn = fmaxf(lf[i] + m, li[i]), a = expf(lf[i] + m - mn), wi = expf(li[i] - mn), vf = bf2f(vw[i]) * wi;
                const f32x4 kf = (f32x4){bflo(kw[i].x), bfhi(kw[i].x), bflo(kw[i].y), bfhi(kw[i].y)}, qf = (f32x4){bflo(qw[i].x), bfhi(qw[i].x), bflo(qw[i].y), bfhi(qw[i].y)};
                C = C * a + kf * vf; n = n * a + kf * wi;
                float num = (C.x * qf.x + C.y * qf.y) + (C.z * qf.z + C.w * qf.w), den = (n.x * qf.x + n.y * qf.y) + (n.z * qf.z + n.w * qf.w);
                num = wave_sum(num); den = wave_sum(den);
                const float hv = num / fmaxf(fabsf(den), expf(-mn));
                if (F.lane == 0) HBUF[(size_t)(rowbase + t0 + i) * DM + 256 * h + v] = hv;
                m = mn;
            }
        }
        if (!smp && !wr_p) continue;
        float* Co = F.out + (smp ? O_CS : O_CP) + ((size_t)(b * NH + h) * DV + v) * DK + d0; *(f32x4*)Co = C;
        if (vg == 0 && F.wave == 0) { *(f32x4*)(F.out + (smp ? O_NS : O_NP) + (size_t)(b * NH + h) * DK + d0) = n; if (F.lane == 0) F.out[(smp ? O_MS : O_MP) + b * NH + h] = m; }
    }
}
__device__ __forceinline__ void gate_pass(Frame& F, const int row_lo, const int row_hi) {
    const bf16* QKVO = WSP(bf16, WS_QKVO); const float* HBUF = WSP(float, WS_HBUF); bf16* A2 = WSP(bf16, WS_A2);
    const int gw = F.vcu * NWAVES + F.wave, NGW = F.G * NWAVES;
    for (int row = row_lo + gw; row < row_hi; row += NGW) {
        const f32x4* hr = (const f32x4*)(HBUF + (size_t)row * DM) + F.lane; const v2u* orow = (const v2u*)(QKVO + (size_t)row * NIN + 3072) + F.lane; const f32x4* gr = (const f32x4*)F.head_norm + F.lane;
        v2u* o8 = (v2u*)(A2 + (size_t)row * DM) + F.lane;
#pragma unroll
        for (int j = 0; j < 4; ++j) { const f32x4 hv = hr[64 * j], g = gr[64 * j]; const v2u ow = orow[64 * j];
            const float ss = wave_sum((hv.x * hv.x + hv.y * hv.y) + (hv.z * hv.z + hv.w * hv.w)), rn = rsqrtf(ss * (1.f / 256.f) + EPS);
            v2u w; w.x = pk2(hv.x * rn * g.x * sigmoidf_(bflo(ow.x)), hv.y * rn * g.y * sigmoidf_(bfhi(ow.x))); w.y = pk2(hv.z * rn * g.z * sigmoidf_(bflo(ow.y)), hv.w * rn * g.w * sigmoidf_(bfhi(ow.y)));
            o8[64 * j] = w; }
    }
}
__device__ __forceinline__ void unpack8(const v4u w, float (&f)[8]) { f[0] = bflo(w.x); f[1] = bfhi(w.x); f[2] = bflo(w.y); f[3] = bfhi(w.y); f[4] = bflo(w.z); f[5] = bfhi(w.z); f[6] = bflo(w.w); f[7] = bfhi(w.w); }
__device__ __forceinline__ void conv_pass(Frame& F) {
    const bf16* __restrict__ BG = WSP(bf16, WS_BG); const bf16* __restrict__ U = WSP(bf16, WS_U); bf16* __restrict__ A2 = WSP(bf16, WS_A2);
    const int gw = F.vcu * NWAVES + F.wave, NGW = F.G * NWAVES;
    float tw[3][2][8];
#pragma unroll
    for (int k = 0; k < 3; ++k)
#pragma unroll
        for (int j = 0; j < 2; ++j) { const f32x4 a = *(const f32x4*)(F.w_taps + k * DM + 8 * F.lane + 512 * j), c = *(const f32x4*)(F.w_taps + k * DM + 8 * F.lane + 512 * j + 4);
            tw[k][j][0] = a.x; tw[k][j][1] = a.y; tw[k][j][2] = a.z; tw[k][j][3] = a.w; tw[k][j][4] = c.x; tw[k][j][5] = c.y; tw[k][j][6] = c.z; tw[k][j][7] = c.w; }
    for (int blk = gw; blk < MT / 4; blk += NGW) {
        const int r0 = 4 * blk; const bool smp = r0 >= MP; const int t0 = smp ? (r0 - MP) & (S_S - 1) : r0 & (S_P - 1), bq = smp ? (r0 - MP) >> 3 : r0 >> 11;
        float p2[2][8], p1[2][8];
        v4u uc[4][2], bgw[4][2];
#pragma unroll
        for (int i = 0; i < 4; ++i)
#pragma unroll
            for (int j = 0; j < 2; ++j) { uc[i][j] = *(const v4u*)(U + (size_t)(r0 + i) * DM + 8 * F.lane + 512 * j); bgw[i][j] = *(const v4u*)(BG + (size_t)(r0 + i) * DM + 8 * F.lane + 512 * j); }
#pragma unroll
        for (int j = 0; j < 2; ++j) {
            if (t0 >= 2) { unpack8(*(const v4u*)(U + (size_t)(r0 - 2) * DM + 8 * F.lane + 512 * j), p2[j]); unpack8(*(const v4u*)(U + (size_t)(r0 - 1) * DM + 8 * F.lane + 512 * j), p1[j]); }
            else if (smp) { const float* sb = F.stConv + (size_t)bq * 2 * DM + 8 * F.lane + 512 * j; const f32x4 a0 = *(const f32x4*)sb, a1 = *(const f32x4*)(sb + 4), c0 = *(const f32x4*)(sb + DM), c1 = *(const f32x4*)(sb + DM + 4);
                p2[j][0] = a0.x; p2[j][1] = a0.y; p2[j][2] = a0.z; p2[j][3] = a0.w; p2[j][4] = a1.x; p2[j][5] = a1.y; p2[j][6] = a1.z; p2[j][7] = a1.w;
                p1[j][0] = c0.x; p1[j][1] = c0.y; p1[j][2] = c0.z; p1[j][3] = c0.w; p1[j][4] = c1.x; p1[j][5] = c1.y; p1[j][6] = c1.z; p1[j][7] = c1.w; }
            else {
#pragma unroll
                for (int e = 0; e < 8; ++e) { p2[j][e] = 0.f; p1[j][e] = 0.f; } }
        }
#pragma unroll
        for (int i = 0; i < 4; ++i)
#pragma unroll
            for (int j = 0; j < 2; ++j) { float cur[8], bg[8], y[8]; unpack8(uc[i][j], cur); unpack8(bgw[i][j], bg);
#pragma unroll
                for (int e = 0; e < 8; ++e) { y[e] = bg[e] * (tw[0][j][e] * p2[j][e] + tw[1][j][e] * p1[j][e] + tw[2][j][e] * cur[e]); p2[j][e] = p1[j][e]; p1[j][e] = cur[e]; }
                v4u o; o.x = pk2(y[0], y[1]); o.y = pk2(y[2], y[3]); o.z = pk2(y[4], y[5]); o.w = pk2(y[6], y[7]);
                *(v4u*)(A2 + (size_t)(r0 + i) * DM + 8 * F.lane + 512 * j) = o; }
    }
}
__device__ __forceinline__ void final_norm(Frame& F) {
    const bf16* __restrict__ XB = WSP(bf16, WS_XB);
    const int gw = F.vcu * NWAVES + F.wave, NGW = F.G * NWAVES;
    for (int row0 = gw; row0 < MT; row0 += 2 * NGW) {
        v2u xw[2][4];
#pragma unroll
        for (int rr = 0; rr < 2; ++rr) { const int row = row0 + rr * NGW < MT ? row0 + rr * NGW : row0;
#pragma unroll
            for (int j = 0; j < 4; ++j) xw[rr][j] = ((const v2u*)(XB + (size_t)row * DM) + F.lane)[64 * j]; }
#pragma unroll
        for (int rr = 0; rr < 2; ++rr) { const int row = row0 + rr * NGW; if (row >= MT) continue;
            f32x4 v[4]; float s = 0.f;
#pragma unroll
            for (int j = 0; j < 4; ++j) { v[j] = (f32x4){bflo(xw[rr][j].x), bfhi(xw[rr][j].x), bflo(xw[rr][j].y), bfhi(xw[rr][j].y)}; s += (v[j].x * v[j].x + v[j].y * v[j].y) + (v[j].z * v[j].z + v[j].w * v[j].w); }
            const float r = rsqrtf(wave_sum(s) * (1.f / 1024.f) + EPS);
            GAS f32x4* xo = (GAS f32x4*)(F.out + O_Y + (size_t)row * DM) + F.lane; const f32x4* gr = (const f32x4*)F.norm_final + F.lane;
#pragma unroll
            for (int j = 0; j < 4; ++j) xo[64 * j] = v[j] * r * gr[64 * j]; }
    }
}

typedef float f32x4v __attribute__((ext_vector_type(4)));
#define MFMA16(a, b, c) __builtin_amdgcn_mfma_f32_16x16x32_bf16((a), (b), (c), 0, 0, 0)
__device__ __forceinline__ float scan_sum(float v, int lane) {
#pragma unroll
    for (int o = 1; o < 64; o <<= 1) { const float t = __shfl_up(v, o); if (lane >= o) v += t; }
    return v;
}
__device__ __forceinline__ float scan_max(float v, int lane) {
#pragma unroll
    for (int o = 1; o < 64; o <<= 1) { const float t = __shfl_up(v, o); if (lane >= o) v = fmaxf(v, t); }
    return v;
}
__device__ __forceinline__ float wave_max(float v) {
#pragma unroll
    for (int o = 1; o < 64; o <<= 1) v = fmaxf(v, __shfl_xor(v, o));
    return v;
}
__device__ __forceinline__ unsigned img_off(unsigned row, unsigned ch) { return row * 512u + ((ch ^ (row & 15u)) << 4); }
__device__ __forceinline__ void dma_tile128(LAS unsigned char* buf, const bf16* gsrc, size_t ld, int wave, int lane) {
#pragma unroll
    for (int i = 0; i < 8; ++i) { const int p = wave * 8 + i, row = 2 * p + (lane >> 5), ch = (lane & 31) ^ (row & 15);
        __builtin_amdgcn_global_load_lds((const unsigned*)(gsrc + (size_t)row * ld + ch * 8), (LAS unsigned*)(buf + p * 1024), 16, 0, 0); }
}
__device__ __forceinline__ bf16x8 tr_frag(unsigned a0, unsigned a1) {
    v2u lo, hi;
    asm volatile("ds_read_b64_tr_b16 %0, %2\n\tds_read_b64_tr_b16 %1, %3\n\ts_waitcnt lgkmcnt(0)" : "=&v"(lo), "=&v"(hi) : "v"(a0), "v"(a1) : "memory");
    v4u r; r.x = lo.x; r.y = lo.y; r.z = hi.x; r.w = hi.y; return __builtin_bit_cast(bf16x8, r);
}
__device__ __forceinline__ bf16x8 pack_f8(const f32x4 a, const f32x4 b) { v4u r; r.x = pk2(a.x, a.y); r.y = pk2(a.z, a.w); r.z = pk2(b.x, b.y); r.w = pk2(b.z, b.w); return __builtin_bit_cast(bf16x8, r); }
__device__ __forceinline__ f32x4 bf4_to_f(const v2u w) { return (f32x4){bflo(w.x), bfhi(w.x), bflo(w.y), bfhi(w.y)}; }

__device__ __forceinline__ void s1_state_pass(Frame& F) {
    const bf16* QKVO = WSP(bf16, WS_QKVO); const float* GATES = WSP(float, WS_GATES);
    bf16* CST = WSP(bf16, WS_CST); float* NST = WSP(float, WS_NST); float* MST = WSP(float, WS_MST);
    LAS unsigned char* VP = F.lds + SCR_OFF;
    LAS float* WGS = (LAS float*)(F.lds + SCR_OFF + 8192);
    LAS float* SC = (LAS float*)(F.lds + SCR_OFF + 8192 + 1024);
    const int lane = F.lane, wave = F.wave, g = lane >> 4, q = (lane & 15) >> 2, p = lane & 3;
    const unsigned ldsK = (unsigned)(size_t)F.lds, ldsV = (unsigned)(size_t)VP;
    for (int un = F.vcu; un < NB_P * NH * 8; un += F.G) {
        const int vs = un & 7, h = (un >> 3) & 3, b = un >> 5, bh = b * NH + h;
        f32x4 acc[2][2], nacc[2];
#pragma unroll
        for (int i = 0; i < 2; ++i) { nacc[i] = (f32x4){0.f, 0.f, 0.f, 0.f};
#pragma unroll
            for (int j = 0; j < 2; ++j) acc[i][j] = (f32x4){0.f, 0.f, 0.f, 0.f}; }
        float m_run = 0.f;
        __syncthreads();
        dma_tile128(F.lds, QKVO + (size_t)(b * S_P) * NIN + 1024 + 256 * h, NIN, wave, lane);
        for (int c = 0; c < 16; ++c) {
            const int r0 = b * S_P + 128 * c, par = c & 1;
            if (wave == 0) {
                const float li0 = GATES[(size_t)(r0 + lane) * 8 + h], li1 = GATES[(size_t)(r0 + 64 + lane) * 8 + h], lf0 = GATES[(size_t)(r0 + lane) * 8 + 4 + h], lf1 = GATES[(size_t)(r0 + 64 + lane) * 8 + 4 + h];
                const float b0 = scan_sum(lf0, lane), b1 = scan_sum(lf1, lane) + __shfl(b0, 63), bL = __shfl(b1, 63);
                const float g0 = bL - b0 + li0, g1 = bL - b1 + li1, mx = wave_max(fmaxf(g0, g1));
                const float m_new = fmaxf(bL + m_run, mx), a = expf(bL + m_run - m_new);
                WGS[par * 128 + lane] = expf(g0 - m_new); WGS[par * 128 + 64 + lane] = expf(g1 - m_new);
                if (lane == 0) { SC[par * 4] = a; SC[par * 4 + 1] = m_new; if (vs == 0) MST[bh * 16 + c] = m_run; }
                m_run = m_new;
            }
            const int vl = F.tid >> 2, vp = F.tid & 3;
            const v4u vraw = *(const v4u*)(QKVO + (size_t)(r0 + vl) * NIN + 2048 + 256 * h + 32 * vs + 8 * vp);
            VM_WAIT(); __syncthreads();
            { const float wg = WGS[par * 128 + vl];
              v4u o; o.x = pk2(bflo(vraw.x) * wg, bfhi(vraw.x) * wg); o.y = pk2(bflo(vraw.y) * wg, bfhi(vraw.y) * wg); o.z = pk2(bflo(vraw.z) * wg, bfhi(vraw.z) * wg); o.w = pk2(bflo(vraw.w) * wg, bfhi(vraw.w) * wg);
              *(LAS v4u*)(VP + vl * 64 + vp * 16) = o; }
            if (c >= 1) {
                bf16* cp = CST + ((size_t)(bh * 16 + c) * DV + 32 * vs + (lane & 15)) * DK + 32 * wave + 4 * g;
#pragma unroll
                for (int dt = 0; dt < 2; ++dt)
#pragma unroll
                    for (int vt = 0; vt < 2; ++vt) { v2u w; w.x = pk2(acc[dt][vt].x, acc[dt][vt].y); w.y = pk2(acc[dt][vt].z, acc[dt][vt].w); *(v2u*)(cp + (size_t)(16 * vt) * DK + 16 * dt) = w; }
                if (vs == 0 && (lane & 15) == 0) {
#pragma unroll
                    for (int dt = 0; dt < 2; ++dt) *(f32x4*)(NST + (size_t)(bh * 16 + c) * DK + 32 * wave + 16 * dt + 4 * g) = nacc[dt]; }
            }
            __syncthreads();
            if (c + 1 < 16) dma_tile128(F.lds + ((c + 1) & 1) * 65536, QKVO + (size_t)(r0 + 128) * NIN + 1024 + 256 * h, NIN, wave, lane);
            const float a = SC[par * 4];
#pragma unroll
            for (int i = 0; i < 2; ++i) { nacc[i] = nacc[i] * a;
#pragma unroll
                for (int j = 0; j < 2; ++j) acc[i][j] = acc[i][j] * a; }
            const unsigned kb = ldsK + par * 65536;
#pragma unroll
            for (int kl = 0; kl < 4; ++kl) {
                const unsigned ra = 32 * kl + 8 * g + q, rb = ra + 4;
                bf16x8 Af[2], Bf[2];
#pragma unroll
                for (int dt = 0; dt < 2; ++dt) Af[dt] = tr_frag(kb + img_off(ra, 4 * wave + 2 * dt + (p >> 1)) + 8 * (p & 1), kb + img_off(rb, 4 * wave + 2 * dt + (p >> 1)) + 8 * (p & 1));
#pragma unroll
                for (int vt = 0; vt < 2; ++vt) Bf[vt] = tr_frag(ldsV + ra * 64 + (16 * vt + 4 * p) * 2, ldsV + rb * 64 + (16 * vt + 4 * p) * 2);
#pragma unroll
                for (int dt = 0; dt < 2; ++dt)
#pragma unroll
                    for (int vt = 0; vt < 2; ++vt) acc[dt][vt] = MFMA16(Af[dt], Bf[vt], acc[dt][vt]);
                if (vs == 0) {
                    const f32x4 w0 = *(const LAS f32x4*)(WGS + par * 128 + 32 * kl + 8 * g), w1 = *(const LAS f32x4*)(WGS + par * 128 + 32 * kl + 8 * g + 4);
                    bf16x8 b2 = pack_f8(w0, w1); if ((lane & 15) != 0) b2 = (bf16x8){0, 0, 0, 0, 0, 0, 0, 0};
#pragma unroll
                    for (int dt = 0; dt < 2; ++dt) nacc[dt] = MFMA16(Af[dt], b2, nacc[dt]);
                }
            }
        }
        float* co = F.out + O_CP + ((size_t)bh * DV + 32 * vs + (lane & 15)) * DK + 32 * wave + 4 * g;
#pragma unroll
        for (int dt = 0; dt < 2; ++dt)
#pragma unroll
            for (int vt = 0; vt < 2; ++vt) *(f32x4*)(co + (size_t)(16 * vt) * DK + 16 * dt) = acc[dt][vt];
        if (vs == 0) {
            if ((lane & 15) == 0) {
#pragma unroll
                for (int dt = 0; dt < 2; ++dt) *(f32x4*)(F.out + O_NP + (size_t)bh * DK + 32 * wave + 16 * dt + 4 * g) = nacc[dt]; }
            if (wave == 0 && lane == 0) F.out[O_MP + bh] = m_run;
        }
    }
}

template <int VT>
__device__ __forceinline__ void s2_h_step(f32x4& acc, const unsigned base, const bf16x8 (&Sf)[4]) {
    constexpr int HI = (VT >> 3) * 256;
    v2u r0, r1, r2, r3, r4, r5, r6, r7;
    asm volatile("ds_read_b64_tr_b16 %0, %8 offset:%9\n\tds_read_b64_tr_b16 %1, %8 offset:%10\n\tds_read_b64_tr_b16 %2, %8 offset:%11\n\tds_read_b64_tr_b16 %3, %8 offset:%12\n\t"
                 "ds_read_b64_tr_b16 %4, %8 offset:%13\n\tds_read_b64_tr_b16 %5, %8 offset:%14\n\tds_read_b64_tr_b16 %6, %8 offset:%15\n\tds_read_b64_tr_b16 %7, %8 offset:%16\n\ts_waitcnt lgkmcnt(0)"
                 : "=&v"(r0), "=&v"(r1), "=&v"(r2), "=&v"(r3), "=&v"(r4), "=&v"(r5), "=&v"(r6), "=&v"(r7)
                 : "v"(base), "i"(HI), "i"(HI + 8192), "i"(HI + 16384), "i"(HI + 24576), "i"(HI + 32768), "i"(HI + 40960), "i"(HI + 49152), "i"(HI + 57344) : "memory");
    v4u f;
    f.x = r0.x; f.y = r0.y; f.z = r1.x; f.w = r1.y; acc = MFMA16(__builtin_bit_cast(bf16x8, f), Sf[0], acc);
    f.x = r2.x; f.y = r2.y; f.z = r3.x; f.w = r3.y; acc = MFMA16(__builtin_bit_cast(bf16x8, f), Sf[1], acc);
    f.x = r4.x; f.y = r4.y; f.z = r5.x; f.w = r5.y; acc = MFMA16(__builtin_bit_cast(bf16x8, f), Sf[2], acc);
    f.x = r6.x; f.y = r6.y; f.z = r7.x; f.w = r7.y; acc = MFMA16(__builtin_bit_cast(bf16x8, f), Sf[3], acc);
}

#if TS_PROBE >= 0
#define S2STAMP(i) do { if (blockIdx.x == 8 && F.tid == 0 && un == F.vcu) ((unsigned long long*)(F.ctl + 2048))[(i)] = __builtin_amdgcn_s_memrealtime(); } while (0)
#else
#define S2STAMP(i) do { } while (0)
#endif
__device__ __forceinline__ void s2_output_pass(Frame& F) {
    const bf16* QKVO = WSP(bf16, WS_QKVO); const float* GATES = WSP(float, WS_GATES);
    const bf16* CST = WSP(bf16, WS_CST); const float* NST = WSP(float, WS_NST); const float* MST = WSP(float, WS_MST); bf16* A2 = WSP(bf16, WS_A2);
    LAS float* ZS = (LAS float*)(F.lds + SCR_OFF); LAS float* LM = ZS + 128; LAS float* LW = ZS + 256; LAS float* LE = ZS + 384; LAS float* NS = ZS + 512; LAS float* HN = ZS + 768;
    LAS unsigned char* bufA = F.lds; LAS unsigned char* bufB = F.lds + 65536;
    const int wave = F.wave;
    const unsigned ldsB = (unsigned)(size_t)bufB;
    for (int un = F.vcu; un < NB_P * NH * 16; un += F.G) {
        int lane = F.lane; asm volatile("" : "+v"(lane));
        const int g = lane >> 4, q = (lane & 15) >> 2, p = lane & 3, li_ = lane & 15;
        const int c = un & 15, h = (un >> 4) & 3, b = un >> 6, bh = b * NH + h, r0 = b * S_P + 128 * c;
        const bf16* Kg = QKVO + (size_t)r0 * NIN + 1024 + 256 * h; const bf16* Vg = QKVO + (size_t)r0 * NIN + 2048 + 256 * h;
        __syncthreads();
        S2STAMP(29);
        if (c) { const bf16* Cg = CST + (size_t)(bh * 16 + c) * DV * DK; dma_tile128(bufA, Cg, DK, wave, lane); dma_tile128(bufB, Cg + (size_t)128 * DK, DK, wave, lane); }
        else { dma_tile128(bufA, Kg, NIN, wave, lane); dma_tile128(bufB, Vg, NIN, wave, lane); }
        if (F.tid < 128) { const f32x4 gv = WSP(f32x4, WS_GV)[(size_t)(r0 + F.tid) * 4 + h]; ZS[F.tid] = gv.x; LM[F.tid] = gv.y; LW[F.tid] = gv.z; LE[F.tid] = gv.w; }
        if (F.tid >= 128 && F.tid < 192) *(LAS f32x4*)(HN + 4 * (F.tid - 128)) = *(const f32x4*)(F.head_norm + 256 * h + 4 * (F.tid - 128));
        if (F.tid < 64) *(LAS f32x4*)(NS + 4 * F.tid) = c ? *(const f32x4*)(NST + (size_t)(bh * 16 + c) * DK + 4 * F.tid) : (f32x4){0.f, 0.f, 0.f, 0.f};
        int lrow = 16 * wave + li_; asm volatile("" : "+v"(lrow));
        const size_t row = (size_t)(r0 + lrow);
        bf16x8 Qf[8];
#pragma unroll
        for (int kd = 0; kd < 8; ++kd) Qf[kd] = *(const bf16x8*)(QKVO + row * NIN + 256 * h + 32 * kd + 8 * g);
        f32x4 acc[16];
#pragma unroll
        for (int vt = 0; vt < 16; ++vt) acc[vt] = (f32x4){0.f, 0.f, 0.f, 0.f};
        VM_WAIT(); __syncthreads();
        S2STAMP(30);
        if (c) {
#pragma unroll
            for (int vt = 0; vt < 8; ++vt) {
#pragma unroll
                for (int kd = 0; kd < 8; ++kd) acc[vt] = MFMA16(*(const LAS bf16x8*)(bufA + img_off(16 * vt + li_, 4 * kd + g)), Qf[kd], acc[vt]);
                __builtin_amdgcn_sched_barrier(0); }
#pragma unroll
            for (int vt = 0; vt < 8; ++vt) {
#pragma unroll
                for (int kd = 0; kd < 8; ++kd) acc[8 + vt] = MFMA16(*(const LAS bf16x8*)(bufB + img_off(16 * vt + li_, 4 * kd + g)), Qf[kd], acc[8 + vt]);
                __builtin_amdgcn_sched_barrier(0); }
            __syncthreads();
            S2STAMP(31);
            dma_tile128(bufA, Kg, NIN, wave, lane); dma_tile128(bufB, Vg, NIN, wave, lane);
            const float wl = LW[lrow];
#pragma unroll
            for (int vt = 0; vt < 16; ++vt) acc[vt] = acc[vt] * wl;
            VM_WAIT(); __syncthreads();
            S2STAMP(32);
        }
        float gn = 0.f;
#pragma unroll
        for (int kd = 0; kd < 8; ++kd) { const v4u qw = __builtin_bit_cast(v4u, Qf[kd]); const f32x4 n0 = *(const LAS f32x4*)(NS + 32 * kd + 8 * g), n1 = *(const LAS f32x4*)(NS + 32 * kd + 8 * g + 4);
            gn += (bflo(qw.x) * n0.x + bfhi(qw.x) * n0.y) + (bflo(qw.y) * n0.z + bfhi(qw.y) * n0.w) + (bflo(qw.z) * n1.x + bfhi(qw.z) * n1.y) + (bflo(qw.w) * n1.z + bfhi(qw.w) * n1.w); }
        gn += __shfl_xor(gn, 16); gn += __shfl_xor(gn, 32);
        v2u ovr[16];
        { const bf16* ob = QKVO + row * NIN + 3072 + 256 * h + 4 * g;
#pragma unroll
          for (int vt = 0; vt < 16; ++vt) ovr[vt] = *(const v2u*)(ob + 16 * vt); }
        const float Ml = LM[lrow]; float dsum = 0.f;
        bf16x8 Sf[4];
#pragma unroll
        for (int ks = 0; ks < 4; ++ks) {
            f32x4 sa = (f32x4){0.f, 0.f, 0.f, 0.f}, sb = sa;
#pragma unroll
            for (int kd = 0; kd < 8; ++kd) { sa = MFMA16(*(const LAS bf16x8*)(bufA + img_off(32 * ks + li_, 4 * kd + g)), Qf[kd], sa); sb = MFMA16(*(const LAS bf16x8*)(bufA + img_off(32 * ks + 16 + li_, 4 * kd + g)), Qf[kd], sb);
                if (kd & 1) __builtin_amdgcn_sched_barrier(0); }
            const f32x4 za = *(const LAS f32x4*)(ZS + 32 * ks + 4 * g), zb = *(const LAS f32x4*)(ZS + 32 * ks + 16 + 4 * g);
#pragma unroll
            for (int r = 0; r < 4; ++r) { const int da = lrow - (32 * ks + 4 * g + r);
                sa[r] = __builtin_bit_cast(float, __builtin_bit_cast(unsigned, sa[r] * __expf(za[r] - Ml)) & ~(unsigned)(da >> 31));
                sb[r] = __builtin_bit_cast(float, __builtin_bit_cast(unsigned, sb[r] * __expf(zb[r] - Ml)) & ~(unsigned)((da - 16) >> 31)); dsum += sa[r] + sb[r]; }
            Sf[ks] = pack_f8(sa, sb);
            __builtin_amdgcn_sched_barrier(0);
        }
        dsum += __shfl_xor(dsum, 16); dsum += __shfl_xor(dsum, 32);
        {
            unsigned hb[8];
#pragma unroll
            for (int j = 0; j < 8; ++j) hb[j] = ldsB + img_off(4 * g + q, 2 * j + (p >> 1)) + 8 * (p & 1);
            s2_h_step<0>(acc[0], hb[0], Sf); s2_h_step<1>(acc[1], hb[1], Sf); s2_h_step<2>(acc[2], hb[2], Sf); s2_h_step<3>(acc[3], hb[3], Sf);
            s2_h_step<4>(acc[4], hb[4], Sf); s2_h_step<5>(acc[5], hb[5], Sf); s2_h_step<6>(acc[6], hb[6], Sf); s2_h_step<7>(acc[7], hb[7], Sf);
            s2_h_step<8>(acc[8], hb[0], Sf); s2_h_step<9>(acc[9], hb[1], Sf); s2_h_step<10>(acc[10], hb[2], Sf); s2_h_step<11>(acc[11], hb[3], Sf);
            s2_h_step<12>(acc[12], hb[4], Sf); s2_h_step<13>(acc[13], hb[5], Sf); s2_h_step<14>(acc[14], hb[6], Sf); s2_h_step<15>(acc[15], hb[7], Sf);
        }
        S2STAMP(33);
        __builtin_amdgcn_sched_barrier(0);
        const float den = LW[lrow] * gn + dsum, inv = __builtin_amdgcn_rcpf(fmaxf(fabsf(den), LE[lrow]));
        float ssq = 0.f;
#pragma unroll
        for (int vt = 0; vt < 16; ++vt) { acc[vt] = acc[vt] * inv; ssq += (acc[vt].x * acc[vt].x + acc[vt].y * acc[vt].y) + (acc[vt].z * acc[vt].z + acc[vt].w * acc[vt].w); }
        ssq += __shfl_xor(ssq, 16); ssq += __shfl_xor(ssq, 32);
        const float rn = rsqrtf(ssq * (1.f / 256.f) + EPS);
        { bf16* ab = A2 + row * DM + 256 * h + 4 * g;
#pragma unroll
        for (int vt = 0; vt < 16; ++vt) {
            const f32x4 ov = bf4_to_f(ovr[vt]), gh = *(const LAS f32x4*)(HN + 16 * vt + 4 * g) * rn;
            const f32x4 sg = (f32x4){__builtin_amdgcn_rcpf(1.f + __expf(-ov.x)), __builtin_amdgcn_rcpf(1.f + __expf(-ov.y)), __builtin_amdgcn_rcpf(1.f + __expf(-ov.z)), __builtin_amdgcn_rcpf(1.f + __expf(-ov.w))};
            const f32x4 o = acc[vt] * gh * sg;
            v2u w; w.x = pk2(o.x, o.y); w.y = pk2(o.z, o.w);
            *(v2u*)(ab + 16 * vt) = w;
            if ((vt & 3) == 3) __builtin_amdgcn_sched_barrier(0); } }
        S2STAMP(34);
    }
}

__device__ __forceinline__ void s3_sample_pass(Frame& F, const int u_first, const int u_step) {
    const bf16* QKVO = WSP(bf16, WS_QKVO); const float* GATES = WSP(float, WS_GATES); bf16* A2 = WSP(bf16, WS_A2);
    LAS float* GP = (LAS float*)F.lds;
    LAS float* VW = (LAS float*)(F.lds + 65536);
    LAS float* SCS = (LAS float*)(F.lds + SCR_OFF);
    const int lane = F.lane, wave = F.wave, g = lane >> 4, li_ = lane & 15;
    for (int un = u_first; un < NB_S * NH; un += u_step) {
        const int h = un & 3, b = un >> 2, bh = b * NH + h, r0 = MP + S_S * b;
        __syncthreads();
        if (wave == 0) {
            const bool ok = lane < S_S; const int rr = r0 + (lane & 7);
            const float li = GATES[(size_t)rr * 8 + h], lf = ok ? GATES[(size_t)rr * 8 + 4 + h] : 0.f, m0 = F.stM[bh];
            const float bc = scan_sum(lf, lane), z = ok ? li - bc : -INFINITY, pm = scan_max(z, lane), M = fmaxf(m0, pm), bL = __shfl(bc, S_S - 1);
            const float gq = ok ? bL - bc + li : -INFINITY, mx = wave_max(gq), m_new = fmaxf(bL + m0, mx), a = expf(bL + m0 - m_new);
            if (ok) { SCS[lane] = z; SCS[8 + lane] = M; SCS[16 + lane] = expf(m0 - M); SCS[24 + lane] = expf(-(bc + M)); SCS[32 + lane] = expf(gq - m_new); }
            if (lane == 0) { SCS[40] = a; SCS[41] = m_new; F.out[O_MS + bh] = m_new; }
        }
        __syncthreads();
        { const int l = F.tid >> 6, v0 = 4 * (F.tid & 63); const float wg = SCS[32 + l];
          const f32x4 vv = bf4_to_f(*(const v2u*)(QKVO + (size_t)(r0 + l) * NIN + 2048 + 256 * h + v0)); *(LAS f32x4*)(VW + l * 256 + v0) = vv * wg; }
        float kk[8][8];
#pragma unroll
        for (int l = 0; l < 8; ++l) { const v4u w = *(const v4u*)(QKVO + (size_t)(r0 + l) * NIN + 1024 + 256 * h + 32 * wave + 8 * g);
            kk[l][0] = bflo(w.x); kk[l][1] = bfhi(w.x); kk[l][2] = bflo(w.y); kk[l][3] = bfhi(w.y); kk[l][4] = bflo(w.z); kk[l][5] = bfhi(w.z); kk[l][6] = bflo(w.w); kk[l][7] = bfhi(w.w); }
        bf16x8 Qa = (bf16x8){0, 0, 0, 0, 0, 0, 0, 0};
        if (li_ < 8) Qa = *(const bf16x8*)(QKVO + (size_t)(r0 + li_) * NIN + 256 * h + 32 * wave + 8 * g);
        __syncthreads();
        const float a = SCS[40];
        const float* cin = F.stC + ((size_t)bh * DV + li_) * DK + 32 * wave + 8 * g; float* cout = F.out + O_CS + ((size_t)bh * DV + li_) * DK + 32 * wave + 8 * g;
#pragma unroll 8
        for (int vb = 0; vb < 16; ++vb) {
            const f32x4 c0 = *(const f32x4*)(cin + (size_t)(16 * vb) * DK), c1 = *(const f32x4*)(cin + (size_t)(16 * vb) * DK + 4);
            const f32x4 gp = MFMA16(Qa, pack_f8(c0, c1), ((f32x4){0.f, 0.f, 0.f, 0.f}));
            if (g < 2) {
#pragma unroll
                for (int r = 0; r < 4; ++r) GP[(wave * 8 + 4 * g + r) * 256 + 16 * vb + li_] = gp[r]; }
            f32x4 n0 = c0 * a, n1 = c1 * a;
#pragma unroll
            for (int l = 0; l < 8; ++l) { const float vw = VW[l * 256 + 16 * vb + li_];
                n0.x += vw * kk[l][0]; n0.y += vw * kk[l][1]; n0.z += vw * kk[l][2]; n0.w += vw * kk[l][3]; n1.x += vw * kk[l][4]; n1.y += vw * kk[l][5]; n1.z += vw * kk[l][6]; n1.w += vw * kk[l][7]; }
            *(f32x4*)(cout + (size_t)(16 * vb) * DK) = n0; *(f32x4*)(cout + (size_t)(16 * vb) * DK + 4) = n1;
        }
        __syncthreads();
        {
            const int l = wave; const size_t row = (size_t)(r0 + l);
            f32x4 G = (f32x4){0.f, 0.f, 0.f, 0.f};
#pragma unroll
            for (int w2 = 0; w2 < 8; ++w2) G += *(const LAS f32x4*)(GP + (w2 * 8 + l) * 256 + 4 * lane);
            const f32x4 qv = bf4_to_f(*(const v2u*)(QKVO + row * NIN + 256 * h + 4 * lane));
            const f32x4 n0v = *(const f32x4*)(F.stN + (size_t)bh * DK + 4 * lane);
            const float gn = wave_sum((n0v.x * qv.x + n0v.y * qv.y) + (n0v.z * qv.z + n0v.w * qv.w));
            const float Ml = SCS[8 + l], wl = SCS[16 + l], el = SCS[24 + l];
            f32x4 num = G * wl; float dsum = 0.f;
#pragma unroll
            for (int s = 0; s < 8; ++s) { const f32x4 kv = bf4_to_f(*(const v2u*)(QKVO + (size_t)(r0 + s) * NIN + 1024 + 256 * h + 4 * lane));
                const float qk = wave_sum((kv.x * qv.x + kv.y * qv.y) + (kv.z * qv.z + kv.w * qv.w));
                const float sd = (s <= l) ? qk * __expf(SCS[s] - Ml) : 0.f;
                const f32x4 vv = bf4_to_f(*(const v2u*)(QKVO + (size_t)(r0 + s) * NIN + 2048 + 256 * h + 4 * lane));
                num += vv * sd; dsum += sd; }
            const float den = wl * gn + dsum, inv = 1.f / fmaxf(fabsf(den), el);
            const f32x4 hv = num * inv;
            const float rn = rsqrtf(wave_sum((hv.x * hv.x + hv.y * hv.y) + (hv.z * hv.z + hv.w * hv.w)) * (1.f / 256.f) + EPS);
            const int v0 = 256 * h + 4 * lane;
            const f32x4 ov = bf4_to_f(*(const v2u*)(QKVO + row * NIN + 3072 + v0)), gh = *(const f32x4*)(F.head_norm + v0);
            v2u w; w.x = pk2(hv.x * rn * gh.x * sigmoidf_(ov.x), hv.y * rn * gh.y * sigmoidf_(ov.y)); w.y = pk2(hv.z * rn * gh.z * sigmoidf_(ov.z), hv.w * rn * gh.w * sigmoidf_(ov.w));
            *(v2u*)(A2 + row * DM + v0) = w;
            if (wave == 0) {
                f32x4 nn = n0v * a;
#pragma unroll
                for (int s = 0; s < 8; ++s) { const f32x4 kv = bf4_to_f(*(const v2u*)(QKVO + (size_t)(r0 + s) * NIN + 1024 + 256 * h + 4 * lane)); nn += kv * SCS[32 + s]; }
                *(f32x4*)(F.out + O_NS + (size_t)bh * DK + 4 * lane) = nn;
            }
        }
    }
}
template <int KL>
__device__ __forceinline__ void s1b_kstep(f32x4 (&acc)[2][4], f32x4 (&nacc)[2], const unsigned k00, const unsigned k01, const unsigned k10, const unsigned k11, const unsigned vb, const bf16x8 b2, const bool do_n) {
    v2u a00, a01, a10, a11;
    asm volatile("ds_read_b64_tr_b16 %0, %4 offset:%8\n\tds_read_b64_tr_b16 %1, %5 offset:%8\n\tds_read_b64_tr_b16 %2, %6 offset:%8\n\tds_read_b64_tr_b16 %3, %7 offset:%8\n\ts_waitcnt lgkmcnt(0)"
                 : "=&v"(a00), "=&v"(a01), "=&v"(a10), "=&v"(a11) : "v"(k00), "v"(k01), "v"(k10), "v"(k11), "i"(KL * 16384) : "memory");
    v2u b0l, b0h, b1l, b1h, b2l, b2h, b3l, b3h;
    asm volatile("ds_read_b64_tr_b16 %0, %8 offset:%9\n\tds_read_b64_tr_b16 %1, %8 offset:%10\n\tds_read_b64_tr_b16 %2, %8 offset:%11\n\tds_read_b64_tr_b16 %3, %8 offset:%12\n\t"
                 "ds_read_b64_tr_b16 %4, %8 offset:%13\n\tds_read_b64_tr_b16 %5, %8 offset:%14\n\tds_read_b64_tr_b16 %6, %8 offset:%15\n\tds_read_b64_tr_b16 %7, %8 offset:%16\n\ts_waitcnt lgkmcnt(0)"
                 : "=&v"(b0l), "=&v"(b0h), "=&v"(b1l), "=&v"(b1h), "=&v"(b2l), "=&v"(b2h), "=&v"(b3l), "=&v"(b3h)
                 : "v"(vb), "i"(KL * 4096), "i"(KL * 4096 + 512), "i"(KL * 4096 + 32), "i"(KL * 4096 + 32 + 512), "i"(KL * 4096 + 64), "i"(KL * 4096 + 64 + 512), "i"(KL * 4096 + 96), "i"(KL * 4096 + 96 + 512) : "memory");
    v4u t;
    t.x = a00.x; t.y = a00.y; t.z = a10.x; t.w = a10.y; const bf16x8 A0 = __builtin_bit_cast(bf16x8, t);
    t.x = a01.x; t.y = a01.y; t.z = a11.x; t.w = a11.y; const bf16x8 A1 = __builtin_bit_cast(bf16x8, t);
    t.x = b0l.x; t.y = b0l.y; t.z = b0h.x; t.w = b0h.y; const bf16x8 B0 = __builtin_bit_cast(bf16x8, t);
    t.x = b1l.x; t.y = b1l.y; t.z = b1h.x; t.w = b1h.y; const bf16x8 B1 = __builtin_bit_cast(bf16x8, t);
    t.x = b2l.x; t.y = b2l.y; t.z = b2h.x; t.w = b2h.y; const bf16x8 B2 = __builtin_bit_cast(bf16x8, t);
    t.x = b3l.x; t.y = b3l.y; t.z = b3h.x; t.w = b3h.y; const bf16x8 B3 = __builtin_bit_cast(bf16x8, t);
    acc[0][0] = MFMA16(A0, B0, acc[0][0]); acc[0][1] = MFMA16(A0, B1, acc[0][1]); acc[0][2] = MFMA16(A0, B2, acc[0][2]); acc[0][3] = MFMA16(A0, B3, acc[0][3]);
    acc[1][0] = MFMA16(A1, B0, acc[1][0]); acc[1][1] = MFMA16(A1, B1, acc[1][1]); acc[1][2] = MFMA16(A1, B2, acc[1][2]); acc[1][3] = MFMA16(A1, B3, acc[1][3]);
    if (do_n) { nacc[0] = MFMA16(A0, b2, nacc[0]); nacc[1] = MFMA16(A1, b2, nacc[1]); }
}
__device__ __forceinline__ void s1b_state_pass(Frame& F, const int u_first, const int u_step) {
    const bf16* QKVO = WSP(bf16, WS_QKVO); const float* GATES = WSP(float, WS_GATES);
    bf16* CST = WSP(bf16, WS_CST); float* NST = WSP(float, WS_NST); f32x4* GV = WSP(f32x4, WS_GV);
    LAS unsigned char* VP = F.lds + SCR_OFF;
    LAS float* WGA = (LAS float*)(F.lds + SCR_OFF + 16384);
    LAS float* ACH = (LAS float*)(F.lds + SCR_OFF + 16384 + 8192);
    const int wave = F.wave;
    const unsigned ldsK = (unsigned)(size_t)F.lds, ldsV = (unsigned)(size_t)VP;
    for (int un = u_first; un < NB_P * NH * 4; un += u_step) {
        int lane = F.lane; asm volatile("" : "+v"(lane));
        const int g = lane >> 4, q = (lane & 15) >> 2, p = lane & 3;
        const int vq = un & 3, h = (un >> 2) & 3, b = un >> 4, bh = b * NH + h;
        __syncthreads();
        dma_tile128(F.lds, QKVO + (size_t)(b * S_P) * NIN + 1024 + 256 * h, NIN, wave, lane);
        if (wave == 0) {
            float li[16][2], lf[16][2];
#pragma unroll
            for (int c = 0; c < 16; ++c)
#pragma unroll
                for (int k = 0; k < 2; ++k) { const size_t row = (size_t)(b * S_P + 128 * c + 64 * k + lane); li[c][k] = GATES[row * 8 + h]; lf[c][k] = GATES[row * 8 + 4 + h]; }
            float m_run = 0.f;
#pragma unroll
            for (int c = 0; c < 16; ++c) {
                const float b0 = scan_sum(lf[c][0], lane), b1 = scan_sum(lf[c][1], lane) + __shfl(b0, 63), bL = __shfl(b1, 63);
                const float g0 = bL - b0 + li[c][0], g1 = bL - b1 + li[c][1], mx = wave_max(fmaxf(g0, g1));
                const float m_new = fmaxf(bL + m_run, mx);
                WGA[128 * c + lane] = expf(g0 - m_new); WGA[128 * c + 64 + lane] = expf(g1 - m_new);
                if (lane == 0) ACH[c] = expf(bL + m_run - m_new);
                if (vq == 0) {
                    const float z0 = li[c][0] - b0, z1 = li[c][1] - b1, p0 = scan_max(z0, lane), p1 = fmaxf(scan_max(z1, lane), __shfl(p0, 63));
                    const float M0 = fmaxf(m_run, p0), M1 = fmaxf(m_run, p1);
                    const size_t row = (size_t)(b * S_P + 128 * c + lane);
                    GV[row * 4 + h] = (f32x4){z0, M0, expf(m_run - M0), expf(-(b0 + M0))}; GV[(row + 64) * 4 + h] = (f32x4){z1, M1, expf(m_run - M1), expf(-(b1 + M1))};
                }
                m_run = m_new;
            }
            if (vq == 0 && lane == 0) F.out[O_MP + bh] = m_run;
        }
        const int vl = F.tid >> 2, vp = F.tid & 3;
        const bf16* vsrc = QKVO + (size_t)(b * S_P + vl) * NIN + 2048 + 256 * h + 64 * vq + 16 * vp;
        v4u v0 = *(const v4u*)vsrc, v1 = *(const v4u*)(vsrc + 8);
        f32x4 acc[2][4], nacc[2];
#pragma unroll
        for (int i = 0; i < 2; ++i) { nacc[i] = (f32x4){0.f, 0.f, 0.f, 0.f};
#pragma unroll
            for (int j = 0; j < 4; ++j) acc[i][j] = (f32x4){0.f, 0.f, 0.f, 0.f}; }
        for (int c = 0; c < 16; ++c) {
            const int par = c & 1;
            VM_WAIT(); __syncthreads();
            { const float wg = WGA[128 * c + vl];
              v4u o; o.x = pk2(bflo(v0.x) * wg, bfhi(v0.x) * wg); o.y = pk2(bflo(v0.y) * wg, bfhi(v0.y) * wg); o.z = pk2(bflo(v0.z) * wg, bfhi(v0.z) * wg); o.w = pk2(bflo(v0.w) * wg, bfhi(v0.w) * wg);
              *(LAS v4u*)(VP + vl * 128 + vp * 32) = o;
              o.x = pk2(bflo(v1.x) * wg, bfhi(v1.x) * wg); o.y = pk2(bflo(v1.y) * wg, bfhi(v1.y) * wg); o.z = pk2(bflo(v1.z) * wg, bfhi(v1.z) * wg); o.w = pk2(bflo(v1.w) * wg, bfhi(v1.w) * wg);
              *(LAS v4u*)(VP + vl * 128 + vp * 32 + 16) = o; }
            if (c >= 1) {
                bf16* cp = CST + ((size_t)(bh * 16 + c) * DV + 64 * vq + (lane & 15)) * DK + 32 * wave + 4 * g;
#pragma unroll
                for (int dt = 0; dt < 2; ++dt)
#pragma unroll
                    for (int vt = 0; vt < 4; ++vt) { v2u w; w.x = pk2(acc[dt][vt].x, acc[dt][vt].y); w.y = pk2(acc[dt][vt].z, acc[dt][vt].w); *(v2u*)(cp + (size_t)(16 * vt) * DK + 16 * dt) = w; }
                if (vq == 0 && (lane & 15) == 0) {
#pragma unroll
                    for (int dt = 0; dt < 2; ++dt) *(f32x4*)(NST + (size_t)(bh * 16 + c) * DK + 32 * wave + 16 * dt + 4 * g) = nacc[dt]; }
            }
            __syncthreads();
            if (c + 1 < 16) { dma_tile128(F.lds + ((c + 1) & 1) * 65536, QKVO + (size_t)(b * S_P + 128 * (c + 1)) * NIN + 1024 + 256 * h, NIN, wave, lane);
                              v0 = *(const v4u*)(vsrc + (size_t)(128 * (c + 1)) * NIN); v1 = *(const v4u*)(vsrc + (size_t)(128 * (c + 1)) * NIN + 8); }
            const float a = ACH[c];
#pragma unroll
            for (int i = 0; i < 2; ++i) { nacc[i] = nacc[i] * a;
#pragma unroll
                for (int j = 0; j < 4; ++j) acc[i][j] = acc[i][j] * a; }
            const unsigned kb = ldsK + par * 65536;
            const unsigned k00 = kb + img_off(8 * g + q, 4 * wave + (p >> 1)) + 8 * (p & 1), k01 = kb + img_off(8 * g + q, 4 * wave + 2 + (p >> 1)) + 8 * (p & 1);
            const unsigned k10 = kb + img_off(8 * g + q + 4, 4 * wave + (p >> 1)) + 8 * (p & 1), k11 = kb + img_off(8 * g + q + 4, 4 * wave + 2 + (p >> 1)) + 8 * (p & 1);
            const unsigned vb = ldsV + (8 * g + q) * 128 + 8 * p;
            const bool do_n = (vq == 0);
            bf16x8 b2[4];
#pragma unroll
            for (int kl = 0; kl < 4; ++kl) { b2[kl] = (bf16x8){0, 0, 0, 0, 0, 0, 0, 0};
                if (do_n && (lane & 15) == 0) b2[kl] = pack_f8(*(const LAS f32x4*)(WGA + 128 * c + 32 * kl + 8 * g), *(const LAS f32x4*)(WGA + 128 * c + 32 * kl + 8 * g + 4)); }
            s1b_kstep<0>(acc, nacc, k00, k01, k10, k11, vb, b2[0], do_n); s1b_kstep<1>(acc, nacc, k00, k01, k10, k11, vb, b2[1], do_n);
            s1b_kstep<2>(acc, nacc, k00, k01, k10, k11, vb, b2[2], do_n); s1b_kstep<3>(acc, nacc, k00, k01, k10, k11, vb, b2[3], do_n);
        }
        float* co = F.out + O_CP + ((size_t)bh * DV + 64 * vq + (lane & 15)) * DK + 32 * wave + 4 * g;
#pragma unroll
        for (int dt = 0; dt < 2; ++dt)
#pragma unroll
            for (int vt = 0; vt < 4; ++vt) *(f32x4*)(co + (size_t)(16 * vt) * DK + 16 * dt) = acc[dt][vt];
        if (vq == 0 && (lane & 15) == 0) {
#pragma unroll
            for (int dt = 0; dt < 2; ++dt) *(f32x4*)(F.out + O_NP + (size_t)bh * DK + 32 * wave + 16 * dt + 4 * g) = nacc[dt]; }
    }
}
__device__ __forceinline__ void s3b_sample_pass(Frame& F, const int u_first, const int u_step) {
    const bf16* QKVO = WSP(bf16, WS_QKVO); const float* GATES = WSP(float, WS_GATES); bf16* A2 = WSP(bf16, WS_A2);
    LAS float* GP = (LAS float*)F.lds;
    LAS unsigned char* VWB = F.lds + 65536;
    LAS float* SCS = (LAS float*)(F.lds + SCR_OFF);
    const int wave = F.wave;
    for (int un = u_first; un < NB_S * NH; un += u_step) {
        int lane = F.lane; asm volatile("" : "+v"(lane));
        const int g = lane >> 4, li_ = lane & 15;
        const int h = un & 3, b = un >> 2, bh = b * NH + h, r0 = MP + S_S * b;
        const float* __restrict__ cin = F.stC + ((size_t)bh * DV + li_) * DK + 32 * wave + 4 * g; float* __restrict__ cout = F.out + O_CS + ((size_t)bh * DV + li_) * DK + 32 * wave + 4 * g;
        f32x4 cr[16][2];
#pragma unroll
        for (int vb = 0; vb < 16; ++vb) { cr[vb][0] = __builtin_nontemporal_load((const f32x4*)(cin + (size_t)(16 * vb) * DK)); cr[vb][1] = __builtin_nontemporal_load((const f32x4*)(cin + (size_t)(16 * vb) * DK + 16)); }
        const bool ok = lane < S_S; const int rr = r0 + (lane & 7);
        float gli = 0.f, glf = 0.f, gm0 = 0.f;
        if (wave == 0) { gli = GATES[(size_t)rr * 8 + h]; glf = ok ? GATES[(size_t)rr * 8 + 4 + h] : 0.f; gm0 = F.stM[bh]; }
        bf16x8 Qa = (bf16x8){0, 0, 0, 0, 0, 0, 0, 0};
        if (li_ < 8) { const bf16* qp = QKVO + (size_t)(r0 + li_) * NIN + 256 * h + 32 * wave + 4 * g; const v2u q0 = *(const v2u*)qp, q1 = *(const v2u*)(qp + 16); v4u t; t.x = q0.x; t.y = q0.y; t.z = q1.x; t.w = q1.y; Qa = __builtin_bit_cast(bf16x8, t); }
        bf16x8 Ak[2];
#pragma unroll
        for (int dt = 0; dt < 2; ++dt) { Ak[dt] = (bf16x8){0, 0, 0, 0, 0, 0, 0, 0};
            if (g == 0) { const bf16* kp = QKVO + (size_t)r0 * NIN + 1024 + 256 * h + 32 * wave + 16 * dt + li_;
#pragma unroll
                for (int l = 0; l < 8; ++l) Ak[dt][l] = (short)kp[(size_t)l * NIN]; } }
        const int vwv = F.tid >> 1, vwh = F.tid & 1; const bf16* vwp = QKVO + (size_t)(r0 + 4 * vwh) * NIN + 2048 + 256 * h + vwv;
        const unsigned short vw0 = vwp[0], vw1 = vwp[NIN], vw2 = vwp[2 * NIN], vw3 = vwp[3 * NIN];
        const size_t frow = (size_t)(r0 + wave);
        const v2u fq = *(const v2u*)(QKVO + frow * NIN + 256 * h + 4 * lane), fo = *(const v2u*)(QKVO + frow * NIN + 3072 + 256 * h + 4 * lane);
        const f32x4 n0v = *(const f32x4*)(F.stN + (size_t)bh * DK + 4 * lane);
        v2u fk[8], fv[8];
#pragma unroll
        for (int s2 = 0; s2 < 8; ++s2) { fk[s2] = *(const v2u*)(QKVO + (size_t)(r0 + s2) * NIN + 1024 + 256 * h + 4 * lane); fv[s2] = *(const v2u*)(QKVO + (size_t)(r0 + s2) * NIN + 2048 + 256 * h + 4 * lane); }
        __syncthreads();
        if (wave == 0) {
            const float li = gli, lf = glf, m0 = gm0;
            const float bc = scan_sum(lf, lane), z = ok ? li - bc : -INFINITY, pm = scan_max(z, lane), M = fmaxf(m0, pm), bL = __shfl(bc, S_S - 1);
            const float gq = ok ? bL - bc + li : -INFINITY, mx = wave_max(gq), m_new = fmaxf(bL + m0, mx), a = expf(bL + m0 - m_new);
            if (ok) { SCS[lane] = z; SCS[8 + lane] = M; SCS[16 + lane] = expf(m0 - M); SCS[24 + lane] = expf(-(bc + M)); SCS[32 + lane] = expf(gq - m_new); }
            if (lane == 0) { SCS[40] = a; SCS[41] = m_new; F.out[O_MS + bh] = m_new; }
        }
        __syncthreads();
        { v2u w; w.x = pk2(bf2f(vw0) * SCS[32 + 4 * vwh], bf2f(vw1) * SCS[33 + 4 * vwh]); w.y = pk2(bf2f(vw2) * SCS[34 + 4 * vwh], bf2f(vw3) * SCS[35 + 4 * vwh]);
          *(LAS v2u*)(VWB + vwv * 16 + vwh * 8) = w; }
        __syncthreads();
        const float a = SCS[40];
#pragma unroll
        for (int vb = 0; vb < 16; ++vb) {
            const f32x4 gp = MFMA16(Qa, pack_f8(cr[vb][0], cr[vb][1]), ((f32x4){0.f, 0.f, 0.f, 0.f}));
            if (g < 2) {
#pragma unroll
                for (int r = 0; r < 4; ++r) GP[(wave * 8 + 4 * g + r) * 256 + 16 * vb + li_] = gp[r]; }
            bf16x8 bvw = (bf16x8){0, 0, 0, 0, 0, 0, 0, 0};
            if (g == 0) bvw = *(const LAS bf16x8*)(VWB + (16 * vb + li_) * 16);
            const f32x4 n0 = MFMA16(Ak[0], bvw, cr[vb][0] * a), n1 = MFMA16(Ak[1], bvw, cr[vb][1] * a);
            __builtin_nontemporal_store(n0, (f32x4*)(cout + (size_t)(16 * vb) * DK)); __builtin_nontemporal_store(n1, (f32x4*)(cout + (size_t)(16 * vb) * DK + 16));
        }
        __syncthreads();
        {
            const int l = wave; const size_t row = (size_t)(r0 + l);
            f32x4 G = (f32x4){0.f, 0.f, 0.f, 0.f};
#pragma unroll
            for (int w2 = 0; w2 < 8; ++w2) G += *(const LAS f32x4*)(GP + (w2 * 8 + l) * 256 + 4 * lane);
            const f32x4 qv = bf4_to_f(fq);
            f32x4 kv[8], vv[8];
#pragma unroll
            for (int s2 = 0; s2 < 8; ++s2) { kv[s2] = bf4_to_f(fk[s2]); vv[s2] = bf4_to_f(fv[s2]); }
            const float gn = wave_sum((n0v.x * qv.x + n0v.y * qv.y) + (n0v.z * qv.z + n0v.w * qv.w));
            const float Ml = SCS[8 + l], wl = SCS[16 + l], el = SCS[24 + l];
            f32x4 num = G * wl; float dsum = 0.f;
#pragma unroll
            for (int s = 0; s < 8; ++s) { const float qk = wave_sum((kv[s].x * qv.x + kv[s].y * qv.y) + (kv[s].z * qv.z + kv[s].w * qv.w));
                const float sd = (s <= l) ? qk * __expf(SCS[s] - Ml) : 0.f; num += vv[s] * sd; dsum += sd; }
            const float den = wl * gn + dsum, inv = 1.f / fmaxf(fabsf(den), el);
            const f32x4 hv = num * inv;
            const float rn = rsqrtf(wave_sum((hv.x * hv.x + hv.y * hv.y) + (hv.z * hv.z + hv.w * hv.w)) * (1.f / 256.f) + EPS);
            const int v0 = 256 * h + 4 * lane;
            const f32x4 ov = bf4_to_f(fo), gh = *(const f32x4*)(F.head_norm + v0);
            v2u w; w.x = pk2(hv.x * rn * gh.x * sigmoidf_(ov.x), hv.y * rn * gh.y * sigmoidf_(ov.y)); w.y = pk2(hv.z * rn * gh.z * sigmoidf_(ov.z), hv.w * rn * gh.w * sigmoidf_(ov.w));
            *(v2u*)(A2 + row * DM + v0) = w;
            if (wave == 0) {
                f32x4 nn = n0v * a;
#pragma unroll
                for (int s = 0; s < 8; ++s) nn += kv[s] * SCS[32 + s];
                *(f32x4*)(F.out + O_NS + (size_t)bh * DK + 4 * lane) = nn;
            }
        }
    }
}
__device__ __forceinline__ bf16x8 scale_frag(const v2u lo, const v2u hi, const f32x4 w0, const f32x4 w1) {
    v4u r; r.x = pk2(bflo(lo.x) * w0.x, bfhi(lo.x) * w0.y); r.y = pk2(bflo(lo.y) * w0.z, bfhi(lo.y) * w0.w); r.z = pk2(bflo(hi.x) * w1.x, bfhi(hi.x) * w1.y); r.w = pk2(bflo(hi.y) * w1.z, bfhi(hi.y) * w1.w);
    return __builtin_bit_cast(bf16x8, r);
}
template <int KL>
__device__ __forceinline__ void s1c_kstep(f32x4 (&acc)[2][4], f32x4 (&nacc)[2], const unsigned k00, const unsigned k01, const unsigned k10, const unsigned k11, const unsigned vb, const LAS float* wgp, const bf16x8 ones, const bool do_n) {
    v2u a00, a01, a10, a11;
    asm volatile("ds_read_b64_tr_b16 %0, %4 offset:%8\n\tds_read_b64_tr_b16 %1, %5 offset:%8\n\tds_read_b64_tr_b16 %2, %6 offset:%8\n\tds_read_b64_tr_b16 %3, %7 offset:%8\n\ts_waitcnt lgkmcnt(0)"
                 : "=&v"(a00), "=&v"(a01), "=&v"(a10), "=&v"(a11) : "v"(k00), "v"(k01), "v"(k10), "v"(k11), "i"(KL * 16384) : "memory");
    v2u b0l, b0h, b1l, b1h, b2l, b2h, b3l, b3h;
    asm volatile("ds_read_b64_tr_b16 %0, %8 offset:%9\n\tds_read_b64_tr_b16 %1, %8 offset:%10\n\tds_read_b64_tr_b16 %2, %8 offset:%11\n\tds_read_b64_tr_b16 %3, %8 offset:%12\n\t"
                 "ds_read_b64_tr_b16 %4, %8 offset:%13\n\tds_read_b64_tr_b16 %5, %8 offset:%14\n\tds_read_b64_tr_b16 %6, %8 offset:%15\n\tds_read_b64_tr_b16 %7, %8 offset:%16\n\ts_waitcnt lgkmcnt(0)"
                 : "=&v"(b0l), "=&v"(b0h), "=&v"(b1l), "=&v"(b1h), "=&v"(b2l), "=&v"(b2h), "=&v"(b3l), "=&v"(b3h)
                 : "v"(vb), "i"(KL * 4096), "i"(KL * 4096 + 512), "i"(KL * 4096 + 32), "i"(KL * 4096 + 32 + 512), "i"(KL * 4096 + 64), "i"(KL * 4096 + 64 + 512), "i"(KL * 4096 + 96), "i"(KL * 4096 + 96 + 512) : "memory");
    const f32x4 w0 = *(const LAS f32x4*)(wgp + 32 * KL), w1 = *(const LAS f32x4*)(wgp + 32 * KL + 4);
    const bf16x8 A0 = scale_frag(a00, a10, w0, w1), A1 = scale_frag(a01, a11, w0, w1);
    v4u t;
    t.x = b0l.x; t.y = b0l.y; t.z = b0h.x; t.w = b0h.y; const bf16x8 B0 = __builtin_bit_cast(bf16x8, t);
    t.x = b1l.x; t.y = b1l.y; t.z = b1h.x; t.w = b1h.y; const bf16x8 B1 = __builtin_bit_cast(bf16x8, t);
    t.x = b2l.x; t.y = b2l.y; t.z = b2h.x; t.w = b2h.y; const bf16x8 B2 = __builtin_bit_cast(bf16x8, t);
    t.x = b3l.x; t.y = b3l.y; t.z = b3h.x; t.w = b3h.y; const bf16x8 B3 = __builtin_bit_cast(bf16x8, t);
    acc[0][0] = MFMA16(A0, B0, acc[0][0]); acc[0][1] = MFMA16(A0, B1, acc[0][1]); acc[0][2] = MFMA16(A0, B2, acc[0][2]); acc[0][3] = MFMA16(A0, B3, acc[0][3]);
    acc[1][0] = MFMA16(A1, B0, acc[1][0]); acc[1][1] = MFMA16(A1, B1, acc[1][1]); acc[1][2] = MFMA16(A1, B2, acc[1][2]); acc[1][3] = MFMA16(A1, B3, acc[1][3]);
    if (do_n) { nacc[0] = MFMA16(A0, ones, nacc[0]); nacc[1] = MFMA16(A1, ones, nacc[1]); }
}
constexpr int S1C_SLOT = 40960;
__device__ __forceinline__ void s1c_stage(LAS unsigned char* slot, const bf16* kg, const bf16* vg, int wave, int lane) {
#pragma unroll
    for (int i = 0; i < 4; ++i) { const int p = wave + 8 * i, row = 2 * p + (lane >> 5), ch = (lane & 31) ^ (row & 15);
        __builtin_amdgcn_global_load_lds((const unsigned*)(kg + (size_t)row * NIN + ch * 8), (LAS unsigned*)(slot + p * 1024), 16, 0, 0); }
    { const int row = 8 * wave + (lane >> 3); __builtin_amdgcn_global_load_lds((const unsigned*)(vg + (size_t)row * NIN + 8 * (lane & 7)), (LAS unsigned*)(slot + 32768 + wave * 1024), 16, 0, 0); }
}
__device__ __forceinline__ void s1c_state_pass(Frame& F, const int u_first, const int u_step) {
    const bf16* QKVO = WSP(bf16, WS_QKVO); const float* GATES = WSP(float, WS_GATES);
    bf16* CST = WSP(bf16, WS_CST); float* NST = WSP(float, WS_NST); f32x4* GV = WSP(f32x4, WS_GV);
    LAS float* WGA = (LAS float*)(F.lds + 3 * S1C_SLOT);
    LAS float* ACH = (LAS float*)(F.lds + SCR_OFF);
    const int wave = F.wave;
    const unsigned ldsK = (unsigned)(size_t)F.lds;
    for (int un = u_first; un < NB_P * NH * 4; un += u_step) {
        int lane = F.lane; asm volatile("" : "+v"(lane));
        const int g = lane >> 4, q = (lane & 15) >> 2, p = lane & 3;
        const int vq = un & 3, h = (un >> 2) & 3, b = un >> 4, bh = b * NH + h;
        const bf16* kg0 = QKVO + (size_t)(b * S_P) * NIN + 1024 + 256 * h; const bf16* vg0 = QKVO + (size_t)(b * S_P) * NIN + 2048 + 256 * h + 64 * vq;
        asm volatile("s_waitcnt vmcnt(0)" ::: "memory"); __syncthreads();
        s1c_stage(F.lds, kg0, vg0, wave, lane); s1c_stage(F.lds + S1C_SLOT, kg0 + (size_t)64 * NIN, vg0 + (size_t)64 * NIN, wave, lane);
        {
            LAS float* BLS = ACH + 16; LAS float* MXS = ACH + 32; LAS float* MSS = ACH + 48; LAS float* MNS = ACH + 64;
            float gq[2][2], zq[2][2], pq[2][2], bq[2][2];
#pragma unroll
            for (int cc = 0; cc < 2; ++cc) { const int c = 2 * wave + cc; const size_t row = (size_t)(b * S_P + 128 * c + lane);
                const float li0 = GATES[row * 8 + h], li1 = GATES[(row + 64) * 8 + h], lf0 = GATES[row * 8 + 4 + h], lf1 = GATES[(row + 64) * 8 + 4 + h];
                const float b0 = scan_sum(lf0, lane), b1 = scan_sum(lf1, lane) + __shfl(b0, 63), bL = __shfl(b1, 63);
                gq[cc][0] = bL - b0 + li0; gq[cc][1] = bL - b1 + li1; const float mx = wave_max(fmaxf(gq[cc][0], gq[cc][1]));
                if (lane == 0) { BLS[c] = bL; MXS[c] = mx; }
                zq[cc][0] = li0 - b0; zq[cc][1] = li1 - b1; bq[cc][0] = b0; bq[cc][1] = b1;
                pq[cc][0] = scan_max(zq[cc][0], lane); pq[cc][1] = fmaxf(scan_max(zq[cc][1], lane), __shfl(pq[cc][0], 63)); }
            asm volatile("s_waitcnt vmcnt(0)" ::: "memory");
            __syncthreads();
            if (wave == 0 && lane == 0) { float m_run = 0.f;
                for (int c = 0; c < 16; ++c) { const float m_new = fmaxf(BLS[c] + m_run, MXS[c]); MSS[c] = m_run; MNS[c] = m_new; ACH[c] = expf(BLS[c] + m_run - m_new); m_run = m_new; }
                if (vq == 0) F.out[O_MP + bh] = m_run; }
            __syncthreads();
#pragma unroll
            for (int cc = 0; cc < 2; ++cc) { const int c = 2 * wave + cc; const float m_new = MNS[c], m_st = MSS[c];
                WGA[128 * c + lane] = expf(gq[cc][0] - m_new); WGA[128 * c + 64 + lane] = expf(gq[cc][1] - m_new);
                if (vq == 0) { const float M0 = fmaxf(m_st, pq[cc][0]), M1 = fmaxf(m_st, pq[cc][1]); const size_t row = (size_t)(b * S_P + 128 * c + lane);
                    GV[row * 4 + h] = (f32x4){zq[cc][0], M0, expf(m_st - M0), expf(-(bq[cc][0] + M0))}; GV[(row + 64) * 4 + h] = (f32x4){zq[cc][1], M1, expf(m_st - M1), expf(-(bq[cc][1] + M1))}; } }
            P0STAMP(23);
        }
        f32x4 acc[2][4], nacc[2];
#pragma unroll
        for (int i = 0; i < 2; ++i) { nacc[i] = (f32x4){0.f, 0.f, 0.f, 0.f};
#pragma unroll
            for (int j = 0; j < 4; ++j) acc[i][j] = (f32x4){0.f, 0.f, 0.f, 0.f}; }
        v4u ot; ot.x = ot.y = ot.z = ot.w = ((lane & 15) == 0) ? 0x3F803F80u : 0u; const bf16x8 ones = __builtin_bit_cast(bf16x8, ot);
        const bool do_n = (vq == 0);
        for (int sc = 0; sc < 32; ++sc) {
            const int c = sc >> 1;
            if (sc + 1 < 32) asm volatile("s_waitcnt vmcnt(5)" ::: "memory"); else asm volatile("s_waitcnt vmcnt(0)" ::: "memory");
            __builtin_amdgcn_s_barrier(); asm volatile("" ::: "memory");
            if ((sc & 1) == 0) {
                if (c >= 1) {
                    bf16* cp = CST + ((size_t)(bh * 16 + c) * DV + 64 * vq + (lane & 15)) * DK + 32 * wave + 4 * g;
#pragma unroll
                    for (int dt = 0; dt < 2; ++dt)
#pragma unroll
                        for (int vt = 0; vt < 4; ++vt) { v2u w; w.x = pk2(acc[dt][vt].x, acc[dt][vt].y); w.y = pk2(acc[dt][vt].z, acc[dt][vt].w); *(v2u*)(cp + (size_t)(16 * vt) * DK + 16 * dt) = w; }
                    if (do_n && (lane & 15) == 0) {
#pragma unroll
                        for (int dt = 0; dt < 2; ++dt) *(f32x4*)(NST + (size_t)(bh * 16 + c) * DK + 32 * wave + 16 * dt + 4 * g) = nacc[dt]; }
                }
            }
            if (sc + 2 < 32) s1c_stage(F.lds + ((sc + 2) % 3) * S1C_SLOT, kg0 + (size_t)(64 * (sc + 2)) * NIN, vg0 + (size_t)(64 * (sc + 2)) * NIN, wave, lane);
            if ((sc & 1) == 0) { const float a = ACH[c];
#pragma unroll
                for (int i = 0; i < 2; ++i) { nacc[i] = nacc[i] * a;
#pragma unroll
                    for (int j = 0; j < 4; ++j) acc[i][j] = acc[i][j] * a; } }
            const unsigned kb = ldsK + (sc % 3) * S1C_SLOT;
            const unsigned k00 = kb + img_off(8 * g + q, 4 * wave + (p >> 1)) + 8 * (p & 1), k01 = kb + img_off(8 * g + q, 4 * wave + 2 + (p >> 1)) + 8 * (p & 1);
            const unsigned k10 = kb + img_off(8 * g + q + 4, 4 * wave + (p >> 1)) + 8 * (p & 1), k11 = kb + img_off(8 * g + q + 4, 4 * wave + 2 + (p >> 1)) + 8 * (p & 1);
            const unsigned vb = kb + 32768 + (8 * g + q) * 128 + 8 * p;
            const LAS float* wgp = WGA + 64 * sc + 8 * g;
            s1c_kstep<0>(acc, nacc, k00, k01, k10, k11, vb, wgp, ones, do_n); s1c_kstep<1>(acc, nacc, k00, k01, k10, k11, vb, wgp, ones, do_n);
            asm volatile("" ::: "memory");
        }
        float* co = F.out + O_CP + ((size_t)bh * DV + 64 * vq + (lane & 15)) * DK + 32 * wave + 4 * g;
#pragma unroll
        for (int dt = 0; dt < 2; ++dt)
#pragma unroll
            for (int vt = 0; vt < 4; ++vt) *(f32x4*)(co + (size_t)(16 * vt) * DK + 16 * dt) = acc[dt][vt];
        if (do_n && (lane & 15) == 0) {
#pragma unroll
            for (int dt = 0; dt < 2; ++dt) *(f32x4*)(F.out + O_NP + (size_t)bh * DK + 32 * wave + 16 * dt + 4 * g) = nacc[dt]; }
    }
}
constexpr int S2R_SLOT = 32768;
__device__ __forceinline__ void s2r_stage(LAS unsigned char* slot, const bf16* src, size_t pitch, int wave, int lane) {
#pragma unroll
    for (int i = 0; i < 4; ++i) { const int p = wave + 8 * i, row = 2 * p + (lane >> 5), ch = (lane & 31) ^ (row & 15);
        __builtin_amdgcn_global_load_lds((const unsigned*)(src + (size_t)row * pitch + ch * 8), (LAS unsigned*)(slot + p * 1024), 16, 0, 0); }
}
__device__ __forceinline__ void s2r_stage_sub(Frame& F, LAS unsigned char* slot, int un, int ss, int wave, int lane) {
    const int c = un & 15, h = (un >> 4) & 3, b = un >> 6, bh = b * NH + h, r0 = b * S_P + 128 * c, k = c ? ss : ss + 4;
    const bf16* QKVO = WSP(bf16, WS_QKVO);
    if (k < 4) s2r_stage(slot, WSP(bf16, WS_CST) + ((size_t)(bh * 16 + c) * DV + 64 * k) * DK, DK, wave, lane);
    else if (k < 6) s2r_stage(slot, QKVO + (size_t)(r0 + 64 * (k - 4)) * NIN + 1024 + 256 * h, NIN, wave, lane);
    else s2r_stage(slot, QKVO + (size_t)(r0 + 64 * (k - 6)) * NIN + 2048 + 256 * h, NIN, wave, lane);
}
template <int J> __device__ __forceinline__ void s2r_gq(f32x4 (&acc)[16], const LAS unsigned char* sl, const bf16x8 (&Qf)[8], int lane) {
    asm volatile("" : "+v"(lane)); const int li_ = lane & 15, g = lane >> 4;
#pragma unroll
    for (int t = 0; t < 4; ++t) {
#pragma unroll
        for (int kd = 0; kd < 8; ++kd) { acc[4 * J + t] = MFMA16(*(const LAS bf16x8*)(sl + img_off(16 * t + li_, 4 * kd + g)), Qf[kd], acc[4 * J + t]); if ((kd & 3) == 3) __builtin_amdgcn_sched_barrier(0); } }
}
template <int I> __device__ __forceinline__ void s2r_sh(bf16x8 (&Sf)[4], float& dsum, const LAS unsigned char* sl, const bf16x8 (&Qf)[8], const LAS float* ZS, float Ml, int wave, int lane) {
    asm volatile("" : "+v"(lane)); const int li_ = lane & 15, g = lane >> 4, lrow = 16 * wave + li_;
#pragma unroll
    for (int kk = 0; kk < 2; ++kk) { const int ks = 2 * I + kk;
        f32x4 sa = (f32x4){0.f, 0.f, 0.f, 0.f}, sb = sa;
#pragma unroll
        for (int kd = 0; kd < 8; ++kd) { sa = MFMA16(*(const LAS bf16x8*)(sl + img_off(32 * kk + li_, 4 * kd + g)), Qf[kd], sa); sb = MFMA16(*(const LAS bf16x8*)(sl + img_off(32 * kk + 16 + li_, 4 * kd + g)), Qf[kd], sb);
            if (kd & 1) __builtin_amdgcn_sched_barrier(0); }
        const f32x4 za = *(const LAS f32x4*)(ZS + 32 * ks + 4 * g), zb = *(const LAS f32x4*)(ZS + 32 * ks + 16 + 4 * g);
#pragma unroll
        for (int r = 0; r < 4; ++r) { const int da = lrow - (32 * ks + 4 * g + r);
            sa[r] = __builtin_bit_cast(float, __builtin_bit_cast(unsigned, sa[r] * __expf(za[r] - Ml)) & ~(unsigned)(da >> 31));
            sb[r] = __builtin_bit_cast(float, __builtin_bit_cast(unsigned, sb[r] * __expf(zb[r] - Ml)) & ~(unsigned)((da - 16) >> 31)); dsum += sa[r] + sb[r]; }
        Sf[ks] = pack_f8(sa, sb);
        __builtin_amdgcn_sched_barrier(0); }
}
template <int VT> __device__ __forceinline__ void s2r_hv(f32x4& acc, const unsigned base, const bf16x8 S0, const bf16x8 S1) {
    constexpr int HI = (VT >> 3) * 256;
    v2u r0, r1, r2, r3;
    asm volatile("ds_read_b64_tr_b16 %0, %4 offset:%5\n\tds_read_b64_tr_b16 %1, %4 offset:%6\n\tds_read_b64_tr_b16 %2, %4 offset:%7\n\tds_read_b64_tr_b16 %3, %4 offset:%8\n\ts_waitcnt lgkmcnt(0)"
                 : "=&v"(r0), "=&v"(r1), "=&v"(r2), "=&v"(r3) : "v"(base), "i"(HI), "i"(HI + 8192), "i"(HI + 16384), "i"(HI + 24576) : "memory");
    v4u f;
    f.x = r0.x; f.y = r0.y; f.z = r1.x; f.w = r1.y; acc = MFMA16(__builtin_bit_cast(bf16x8, f), S0, acc);
    f.x = r2.x; f.y = r2.y; f.z = r3.x; f.w = r3.y; acc = MFMA16(__builtin_bit_cast(bf16x8, f), S1, acc);
}
__device__ __forceinline__ void s2r_hh(f32x4 (&acc)[16], const unsigned slb, const bf16x8 S0, const bf16x8 S1, int lane) {
    asm volatile("" : "+v"(lane)); const int g = lane >> 4, q = (lane & 15) >> 2, p = lane & 3;
    unsigned hb[8];
#pragma unroll
    for (int j = 0; j < 8; ++j) hb[j] = slb + img_off(4 * g + q, 2 * j + (p >> 1)) + 8 * (p & 1);
    s2r_hv<0>(acc[0], hb[0], S0, S1); s2r_hv<1>(acc[1], hb[1], S0, S1); s2r_hv<2>(acc[2], hb[2], S0, S1); s2r_hv<3>(acc[3], hb[3], S0, S1);
    s2r_hv<4>(acc[4], hb[4], S0, S1); s2r_hv<5>(acc[5], hb[5], S0, S1); s2r_hv<6>(acc[6], hb[6], S0, S1); s2r_hv<7>(acc[7], hb[7], S0, S1);
    s2r_hv<8>(acc[8], hb[0], S0, S1); s2r_hv<9>(acc[9], hb[1], S0, S1); s2r_hv<10>(acc[10], hb[2], S0, S1); s2r_hv<11>(acc[11], hb[3], S0, S1);
    s2r_hv<12>(acc[12], hb[4], S0, S1); s2r_hv<13>(acc[13], hb[5], S0, S1); s2r_hv<14>(acc[14], hb[6], S0, S1); s2r_hv<15>(acc[15], hb[7], S0, S1);
}
__device__ __forceinline__ void s2r_output_pass(Frame& F) {
    const bf16* QKVO = WSP(bf16, WS_QKVO); const float* NST = WSP(float, WS_NST); bf16* A2 = WSP(bf16, WS_A2);
    const int wave = F.wave;
    const unsigned ldsR = (unsigned)(size_t)F.lds;
    int nun = 0, total = 0;
    for (int un = F.vcu; un < NB_P * NH * 16; un += F.G) { ++nun; total += (un & 15) ? 8 : 4; }
    if (total == 0) return;
    asm volatile("s_waitcnt vmcnt(0)" ::: "memory"); __syncthreads();
    int sj = 0, ss = 0;
#pragma unroll
    for (int s = 0; s < 3; ++s) if (s < total) { const int un = F.vcu + sj * F.G; s2r_stage_sub(F, F.lds + s * S2R_SLOT, un, ss, wave, F.lane); if (++ss == ((un & 15) ? 8 : 4)) { ss = 0; ++sj; } }
    int cj = 0, cs = 0;
    f32x4 acc[16]; bf16x8 Qf[8], Sf[4]; v2u ovr[16]; float dsum = 0.f, gn = 0.f;
    for (int gs = 0; gs < total; ++gs) {
        int lane = F.lane; asm volatile("" : "+v"(lane));
        const int g = lane >> 4, q = (lane & 15) >> 2, p = lane & 3, li_ = lane & 15, lrow = 16 * wave + li_;
        const int un = F.vcu + cj * F.G, c = un & 15, h = (un >> 4) & 3, b = un >> 6, bh = b * NH + h, r0 = b * S_P + 128 * c, k = c ? cs : cs + 4, par = cj & 1;
        LAS float* ZS = (LAS float*)(F.lds + SCR_OFF) + par * 1024; LAS float* LM = ZS + 128; LAS float* LW = ZS + 256; LAS float* LE = ZS + 384; LAS float* NS = ZS + 512; LAS float* HN = ZS + 768;
        const size_t row = (size_t)(r0 + lrow);
        if (cs == 0) {
            if (F.tid < 128) { const f32x4 gv = WSP(f32x4, WS_GV)[(size_t)(r0 + F.tid) * 4 + h]; ZS[F.tid] = gv.x; LM[F.tid] = gv.y; LW[F.tid] = gv.z; LE[F.tid] = gv.w; }
            if (F.tid >= 128 && F.tid < 192) *(LAS f32x4*)(HN + 4 * (F.tid - 128)) = *(const f32x4*)(F.head_norm + 256 * h + 4 * (F.tid - 128));
            if (F.tid < 64) *(LAS f32x4*)(NS + 4 * F.tid) = c ? *(const f32x4*)(NST + (size_t)(bh * 16 + c) * DK + 4 * F.tid) : (f32x4){0.f, 0.f, 0.f, 0.f};
#pragma unroll
            for (int kd = 0; kd < 8; ++kd) Qf[kd] = *(const bf16x8*)(QKVO + row * NIN + 256 * h + 32 * kd + 8 * g);
#pragma unroll
            for (int vt = 0; vt < 16; ++vt) acc[vt] = (f32x4){0.f, 0.f, 0.f, 0.f};
            dsum = 0.f;
        }
        const int rem = total - 1 - gs;
        if (rem >= 2) asm volatile("s_waitcnt vmcnt(8)" ::: "memory"); else if (rem == 1) asm volatile("s_waitcnt vmcnt(4)" ::: "memory"); else asm volatile("s_waitcnt vmcnt(0)" ::: "memory");
        __builtin_amdgcn_s_barrier(); asm volatile("" ::: "memory");
        if (gs + 3 < total) { const int sun = F.vcu + sj * F.G; s2r_stage_sub(F, F.lds + ((gs + 3) & 3) * S2R_SLOT, sun, ss, wave, lane); if (++ss == ((sun & 15) ? 8 : 4)) { ss = 0; ++sj; } }
        const LAS unsigned char* sl = F.lds + (gs & 3) * S2R_SLOT; const unsigned slb = ldsR + (gs & 3) * S2R_SLOT;
        if (k == 0) s2r_gq<0>(acc, sl, Qf, lane);
        else if (k == 1) s2r_gq<1>(acc, sl, Qf, lane);
        else if (k == 2) s2r_gq<2>(acc, sl, Qf, lane);
        else if (k == 3) { s2r_gq<3>(acc, sl, Qf, lane); const float wl = LW[lrow];
#pragma unroll
            for (int vt = 0; vt < 16; ++vt) acc[vt] = acc[vt] * wl; }
        else if (k == 4) s2r_sh<0>(Sf, dsum, sl, Qf, ZS, LM[lrow], wave, lane);
        else if (k == 5) { s2r_sh<1>(Sf, dsum, sl, Qf, ZS, LM[lrow], wave, lane);
            gn = 0.f;
#pragma unroll
            for (int kd = 0; kd < 8; ++kd) { const v4u qw = __builtin_bit_cast(v4u, Qf[kd]); const f32x4 n0 = *(const LAS f32x4*)(NS + 32 * kd + 8 * g), n1 = *(const LAS f32x4*)(NS + 32 * kd + 8 * g + 4);
                gn += (bflo(qw.x) * n0.x + bfhi(qw.x) * n0.y) + (bflo(qw.y) * n0.z + bfhi(qw.y) * n0.w) + (bflo(qw.z) * n1.x + bfhi(qw.z) * n1.y) + (bflo(qw.w) * n1.z + bfhi(qw.w) * n1.w); }
            gn += __shfl_xor(gn, 16); gn += __shfl_xor(gn, 32); }
        else if (k == 6) {
            { const bf16* ob = QKVO + row * NIN + 3072 + 256 * h + 4 * g;
#pragma unroll
              for (int vt = 0; vt < 16; ++vt) ovr[vt] = *(const v2u*)(ob + 16 * vt); }
            s2r_hh(acc, slb, Sf[0], Sf[1], lane); }
        else {
            s2r_hh(acc, slb, Sf[2], Sf[3], lane);
            float ds = dsum; ds += __shfl_xor(ds, 16); ds += __shfl_xor(ds, 32);
            __builtin_amdgcn_sched_barrier(0);
            const float den = LW[lrow] * gn + ds, inv = __builtin_amdgcn_rcpf(fmaxf(fabsf(den), LE[lrow]));
            float ssq = 0.f;
#pragma unroll
            for (int vt = 0; vt < 16; ++vt) { acc[vt] = acc[vt] * inv; ssq += (acc[vt].x * acc[vt].x + acc[vt].y * acc[vt].y) + (acc[vt].z * acc[vt].z + acc[vt].w * acc[vt].w); }
            ssq += __shfl_xor(ssq, 16); ssq += __shfl_xor(ssq, 32);
            const float rn = rsqrtf(ssq * (1.f / 256.f) + EPS);
            { bf16* ab = A2 + row * DM + 256 * h + 4 * g;
#pragma unroll
            for (int vt = 0; vt < 16; ++vt) {
                const f32x4 ov = bf4_to_f(ovr[vt]), gh = *(const LAS f32x4*)(HN + 16 * vt + 4 * g) * rn;
                const f32x4 sg = (f32x4){__builtin_amdgcn_rcpf(1.f + __expf(-ov.x)), __builtin_amdgcn_rcpf(1.f + __expf(-ov.y)), __builtin_amdgcn_rcpf(1.f + __expf(-ov.z)), __builtin_amdgcn_rcpf(1.f + __expf(-ov.w))};
                const f32x4 o = acc[vt] * gh * sg;
                v2u w; w.x = pk2(o.x, o.y); w.y = pk2(o.z, o.w);
                *(v2u*)(ab + 16 * vt) = w;
                if ((vt & 3) == 3) __builtin_amdgcn_sched_barrier(0); } }
        }
        asm volatile("" ::: "memory");
        if (++cs == (c ? 8 : 4)) { cs = 0; ++cj; }
    }
    asm volatile("s_waitcnt vmcnt(0)" ::: "memory"); __syncthreads();
}
namespace epf {
using pg8::Unit; using pg8::bf16_t; using pg8::BM; using pg8::HALF; using pg8::u32x4;
typedef __amdgpu_buffer_rsrc_t rsrc_t;
__device__ __forceinline__ rsrc_t mk(const void* p, size_t bytes) { return __builtin_amdgcn_make_buffer_rsrc((void*)p, 0, (int)bytes, 0x00020000); }
__device__ __forceinline__ void st16(rsrc_t r, unsigned off, u32x4 v) { __builtin_amdgcn_raw_buffer_store_b128(v, r, (int)off, 0, 16); }
__device__ __forceinline__ void st16f(rsrc_t r, unsigned off, f32x4 v) { __builtin_amdgcn_raw_buffer_store_b128(__builtin_bit_cast(u32x4, v), r, (int)off, 0, 16); }
__device__ __forceinline__ void st8(rsrc_t r, unsigned off, v2u v) { __builtin_amdgcn_raw_buffer_store_b64(v, r, (int)off, 0, 16); }
__device__ __forceinline__ void st4f(rsrc_t r, unsigned off, float v) { __builtin_amdgcn_raw_buffer_store_b32(__builtin_bit_cast(unsigned, v), r, (int)off, 0, 16); }
__device__ __forceinline__ f32x4 ld16f(rsrc_t r, unsigned off) { return __builtin_bit_cast(f32x4, __builtin_amdgcn_raw_buffer_load_b128(r, (int)off, 0, 16)); }
__device__ __forceinline__ v2u ld8(rsrc_t r, unsigned off) { return __builtin_amdgcn_raw_buffer_load_b64(r, (int)off, 0, 16); }
__device__ __forceinline__ float row_rs(rsrc_t slab, int row) {
    const f32x4 a = ld16f(slab, (unsigned)row * 64u), b = ld16f(slab, (unsigned)row * 64u + 16u), c = ld16f(slab, (unsigned)row * 64u + 32u), d = ld16f(slab, (unsigned)row * 64u + 48u);
    const float s = (((a.x + a.y) + (a.z + a.w)) + ((b.x + b.y) + (b.z + b.w))) + (((c.x + c.y) + (c.z + c.w)) + ((d.x + d.y) + (d.z + d.w)));
    return rsqrtf(s * (1.f / 1024.f) + EPS);
}
using ep::pack8; using ep::silu_mul;

struct EpiSwiGLU {
    static constexpr bool PERM = true, AFTER_DRAIN = false;
    rsrc_t O; rsrc_t ssq;
    __device__ __forceinline__ void operator()(const f32x4 (&acc)[2][2][4][2], const Unit& u, int wr, int wc, int fr, int fq) const {
        const int row0 = u.pm * BM + wr * 64 + fr, col0 = u.pn * HALF + wc * 32 + 8 * fq;
#pragma unroll
        for (int ai = 0; ai < 2; ++ai)
#pragma unroll
            for (int m = 0; m < 4; ++m) { const int row = row0 + ai * HALF + m * 16; const float r = row_rs(ssq, row);
                const f32x4 g0 = acc[ai][0][m][0] * r, g1 = acc[ai][0][m][1] * r, u0 = acc[ai][1][m][0] * r, u1 = acc[ai][1][m][1] * r;
                f32x4 h0, h1;
#pragma unroll
                for (int j = 0; j < 4; ++j) { h0[j] = silu_mul(g0[j], u0[j]); h1[j] = silu_mul(g1[j], u1[j]); }
                st16(O, ((unsigned)row * DFF + col0) * 2u, pack8(h0, h1)); }
    }
};
template <bool WB, bool BASE_Y> struct EpiResid {
    static constexpr bool PERM = true, AFTER_DRAIN = false;
    const float* baseP; const float* baseS; rsrc_t Y; rsrc_t XB; rsrc_t ssq;
    __device__ __forceinline__ void operator()(const f32x4 (&acc)[2][2][4][2], const Unit& u, int wr, int wc, int fr, int fq) const {
        const int row0 = u.pm * BM + wr * 64 + fr, col0 = u.pn * BM + wc * 32 + 8 * fq;
#pragma unroll
        for (int ai = 0; ai < 2; ++ai)
#pragma unroll
            for (int m = 0; m < 4; ++m) { const int row = row0 + ai * HALF + m * 16; const unsigned eo = (unsigned)row * DM + col0;
                const float* bp = (row < MP ? baseP + (size_t)row * DM : baseS + (size_t)(row - MP) * DM) + col0;
                float ss = 0.f;
#pragma unroll
                for (int bj = 0; bj < 2; ++bj) {
                    f32x4 b0, b1;
                    if (BASE_Y) { b0 = ld16f(Y, (eo + bj * HALF) * 4u); b1 = ld16f(Y, (eo + bj * HALF + 4) * 4u); } else { b0 = *(const f32x4*)(bp + bj * HALF); b1 = *(const f32x4*)(bp + bj * HALF + 4); }
                    const f32x4 x0 = b0 + acc[ai][bj][m][0], x1 = b1 + acc[ai][bj][m][1];
                    st16f(Y, (eo + bj * HALF) * 4u, x0); st16f(Y, (eo + bj * HALF + 4) * 4u, x1);
                    if (WB) { st16(XB, (eo + bj * HALF) * 2u, pack8(x0, x1));
                        ss += ((x0[0] * x0[0] + x0[1] * x0[1]) + (x0[2] * x0[2] + x0[3] * x0[3])) + ((x1[0] * x1[0] + x1[1] * x1[1]) + (x1[2] * x1[2] + x1[3] * x1[3])); } }
                if (WB) { ss += __shfl_xor(ss, 16); ss += __shfl_xor(ss, 32); if (fq == 0) st4f(ssq, ((unsigned)row * 16 + u.pn * 4 + wc) * 4u, ss); } }
    }
};
struct EpiConvIn {
    static constexpr bool PERM = true, AFTER_DRAIN = false;
    rsrc_t BG; rsrc_t U; rsrc_t ssq; float* cvP; float* cvS;
    __device__ __forceinline__ void operator()(const f32x4 (&acc)[2][2][4][2], const Unit& u, int wr, int wc, int fr, int fq) const {
        const int row0 = u.pm * BM + wr * 64 + fr;
        if (u.pn < 4) {
            const int col0 = u.pn * BM + wc * 32 + 8 * fq;
#pragma unroll
            for (int ai = 0; ai < 2; ++ai)
#pragma unroll
                for (int m = 0; m < 4; ++m) { const int row = row0 + ai * HALF + m * 16; const float r = row_rs(ssq, row);
#pragma unroll
                    for (int bj = 0; bj < 2; ++bj) st16(BG, ((unsigned)row * DM + col0 + bj * HALF) * 2u, pack8(acc[ai][bj][m][0] * r, acc[ai][bj][m][1] * r)); }
        } else {
            const int col0 = (u.pn - 4) * HALF + wc * 32 + 8 * fq;
#pragma unroll
            for (int ai = 0; ai < 2; ++ai)
#pragma unroll
                for (int m = 0; m < 4; ++m) { const int row = row0 + ai * HALF + m * 16; const float r = row_rs(ssq, row);
                    const f32x4 p0 = (acc[ai][0][m][0] * r) * (acc[ai][1][m][0] * r), p1 = (acc[ai][0][m][1] * r) * (acc[ai][1][m][1] * r);
                    st16(U, ((unsigned)row * DM + col0) * 2u, pack8(p0, p1));
                    float* sp = nullptr;
                    if (row < MP) { const int t = row & (S_P - 1), b = row >> 11; if (t >= S_P - 2) sp = cvP + (size_t)(b * 2 + (t - (S_P - 2))) * DM + col0; }
                    else { const int rs = row - MP, t = rs & (S_S - 1), b = rs >> 3; if (t >= S_S - 2) sp = cvS + (size_t)(b * 2 + (t - (S_S - 2))) * DM + col0; }
                    if (sp) { *(f32x4*)sp = p0; *(f32x4*)(sp + 4) = p1; } }
        }
    }
};
}

constexpr int CW_CNT = 16384;
constexpr int CW_TMO = 8;
__device__ __forceinline__ void flow_poll(const unsigned* p, unsigned need, unsigned* tmo) {
    unsigned spins = 0;
    while ((unsigned)__builtin_amdgcn_readfirstlane(__hip_atomic_load(p, __ATOMIC_RELAXED, __HIP_MEMORY_SCOPE_AGENT)) < need) {
        __builtin_amdgcn_s_sleep(2);
        if (++spins > (1u << 18)) { if ((threadIdx.x & 63) == 0) __hip_atomic_store(tmo, 1u, __ATOMIC_RELAXED, __HIP_MEMORY_SCOPE_AGENT); break; }
    }
}
struct FlowOrder : pg8::StaticOrder {
    const unsigned* dep; unsigned need; unsigned* pub; unsigned* tmo; int wgm; mutable int pend;
    __device__ __forceinline__ bool next(int i, pg8::Unit& u) const {
        const long L = (long)i * G + c; if (L >= nwg) return false;
        int wgid = (int)L; { const int q = nwg / pg8::NXCD, r = nwg % pg8::NXCD, xcd = wgid % pg8::NXCD, off = wgid / pg8::NXCD; wgid = (xcd < r ? xcd * (q + 1) : r * (q + 1) + (xcd - r) * q) + off; }
        const int nig = wgm * nN, gid = wgid / nig, fm = gid * wgm, gsz = (nM - fm) < wgm ? (nM - fm) : wgm;
        u.pm = fm + ((wgid % nig) % gsz); u.pn = (wgid % nig) / gsz; return true;
    }
    __device__ __forceinline__ void a_ready(const pg8::Unit& u) const {
        if (dep) {
            if (threadIdx.x < 64) flow_poll(dep + 64 * u.pm, need, tmo);
            asm volatile("" ::: "memory"); __builtin_amdgcn_s_barrier(); asm volatile("" ::: "memory");
        }
    }
    __device__ __forceinline__ void done(const pg8::Unit& u) const { pend = u.pm; }
    __device__ __forceinline__ void flush() const {
        if (pend >= 0) { if ((threadIdx.x & 63) == 0) __hip_atomic_fetch_add(pub + 64 * pend, 1u, __ATOMIC_RELAXED, __HIP_MEMORY_SCOPE_AGENT); pend = -1; }
    }
};
template <class Epi>
__device__ __forceinline__ void flow_gemm(Frame& F, const pg8::Gemm g, const Epi& E, int rot, const unsigned* dep, unsigned need, unsigned* pub) {
    FlowOrder S; S.init(g.M, g.N, F.G, (int)((blockIdx.x + F.G - (unsigned)(rot % F.G)) % F.G)); S.dep = dep; S.need = need; S.pub = pub; S.tmo = (unsigned*)(F.ctl + CW_TMO); S.wgm = 2; S.pend = -1;
    pg8::gemm_phase<Epi, FlowOrder, true, true>(F.lds + RING_OFF, g, S, E);
}
__device__ __forceinline__ void conv_flow(Frame& F, int rot, const unsigned* dep, unsigned* pub) {
    const epf::rsrc_t BG = epf::mk(F.ws + WS_BG, (size_t)MT * DM * 2), U = epf::mk(F.ws + WS_U, (size_t)MT * DM * 2), A2 = epf::mk(F.ws + WS_A2, (size_t)MT * DM * 2);
    unsigned* tmo = (unsigned*)(F.ctl + CW_TMO);
    const int c = (int)((blockIdx.x + F.G - (unsigned)(rot % F.G)) % F.G);
    for (int pm = c; pm < MT / 256; pm += F.G) {
        if (F.tid < 64) { flow_poll(dep + 64 * pm, 96u, tmo); if (pm < MP / 256 && (pm & 7)) flow_poll(dep + 64 * (pm - 1), 96u, tmo); }
        __syncthreads();
        for (int rr = F.wave; rr < 256; rr += NWAVES) {
            const int row = pm * 256 + rr; const bool smp = row >= MP; const int t = smp ? (row - MP) & (S_S - 1) : row & (S_P - 1), b = smp ? (row - MP) >> 3 : row >> 11;
            const f32x4* sb = (const f32x4*)(F.stConv + (size_t)b * 2 * DM) + F.lane;
#pragma unroll
            for (int j = 0; j < 4; ++j) {
                const unsigned eo = ((unsigned)row * DM + 4 * F.lane + 256 * j) * 2u;
                const v2u uc = epf::ld8(U, eo), bw = epf::ld8(BG, eo);
                const f32x4 w0 = ((const f32x4*)F.w_taps + F.lane)[64 * j], w1 = ((const f32x4*)(F.w_taps + DM) + F.lane)[64 * j], w2 = ((const f32x4*)(F.w_taps + 2 * DM) + F.lane)[64 * j];
                f32x4 a = (f32x4){0.f, 0.f, 0.f, 0.f}, cc = a;
                if (t >= 2) a = bf4_to_f(epf::ld8(U, eo - 2u * DM * 2u)); else if (smp) a = sb[(t == 0 ? 0 : 256) + 64 * j];
                if (t >= 1) cc = bf4_to_f(epf::ld8(U, eo - DM * 2u)); else if (smp) cc = sb[256 + 64 * j];
                const f32x4 y = bf4_to_f(bw) * (w0 * a + w1 * cc + w2 * bf4_to_f(uc));
                v2u w; w.x = pk2(y.x, y.y); w.y = pk2(y.z, y.w); epf::st8(A2, eo, w);
            }
        }
        VM_WAIT();
        if (F.lane == 0) __hip_atomic_fetch_add(pub + 64 * pm, 1u, __ATOMIC_RELAXED, __HIP_MEMORY_SCOPE_AGENT);
    }
}
__device__ __forceinline__ void fnorm_flow(Frame& F, int rot, const unsigned* dep) {
    const epf::rsrc_t Y = epf::mk(F.out + O_Y, (size_t)MT * DM * 4);
    unsigned* tmo = (unsigned*)(F.ctl + CW_TMO);
    const int c = (int)((blockIdx.x + F.G - (unsigned)(rot % F.G)) % F.G);
    for (int it = c; it < (MT / 256) * 4; it += F.G) {
        const int pm = it >> 2, qq = it & 3;
        if (F.tid < 64) flow_poll(dep + 64 * pm, 32u, tmo);
        __syncthreads();
        for (int rr = F.wave; rr < 64; rr += NWAVES) {
            const int row = pm * 256 + qq * 64 + rr; const unsigned eo = ((unsigned)row * DM + 4 * F.lane) * 4u;
            const f32x4* gr = (const f32x4*)F.norm_final + F.lane; f32x4* xo = (f32x4*)(F.out + O_Y + (size_t)row * DM) + F.lane;
            f32x4 v[4]; float s = 0.f;
#pragma unroll
            for (int j = 0; j < 4; ++j) { v[j] = epf::ld16f(Y, eo + 1024u * j); s += (v[j].x * v[j].x + v[j].y * v[j].y) + (v[j].z * v[j].z + v[j].w * v[j].w); }
            const float r = rsqrtf(wave_sum(s) * (1.f / 1024.f) + EPS);
#pragma unroll
            for (int j = 0; j < 4; ++j) xo[64 * j] = v[j] * r * gr[64 * j];
        }
    }
}
namespace sg {
constexpr int BKS = 128, SLOTB = 32768, NSLOT = 4;
__device__ __forceinline__ unsigned soff(unsigned row, unsigned ch) { return row * 256u + ((ch ^ (row & 15u)) << 4); }
struct MapPlain { __device__ __forceinline__ int operator()(int tn, int r) const { return 64 * tn + r; } };
struct MapGU { __device__ __forceinline__ int operator()(int tn, int r) const { const int c0 = 32 * tn; return 256 * (c0 >> 7) + (c0 & 127) + 128 * ((r >> 4) & 1) + 16 * (r >> 5) + (r & 15); } };
struct MapCin { __device__ __forceinline__ int operator()(int tn, int r) const { if (tn < 16) return 64 * tn + r; const int c0 = 32 * (tn - 16); return DM + 256 * (c0 >> 7) + (c0 & 127) + 128 * ((r >> 4) & 1) + 16 * (r >> 5) + (r & 15); } };

template <class Map>
__device__ __forceinline__ void stage(LAS unsigned char* slot, const bf16* A, const bf16* Bt, int K, int ks, int tn, const Map& map, int wave, int lane) {
    const int rr = lane >> 4, cs = lane & 15;
#pragma unroll
    for (int i = 0; i < 4; ++i) { const int pr = (wave + 8 * i) & 15, row = 4 * pr + rr, ch = cs ^ (row & 15);
        const bf16* src = (i < 2) ? A + (size_t)row * K + ks * BKS + ch * 8 : Bt + (size_t)map(tn, row) * K + ks * BKS + ch * 8;
        __builtin_amdgcn_global_load_lds((const unsigned*)src, (LAS unsigned*)(slot + (i < 2 ? 0 : 16384) + pr * 1024), 16, 0, 0); }
}
template <class Epi, class Map>
__device__ __forceinline__ void run(LAS unsigned char* lds, const bf16* Abase  , const bf16* Bt, int K, const Map& map, const Epi& E, int t_first, int t_step, int t_end) {
    const int tid = threadIdx.x, wave = __builtin_amdgcn_readfirstlane(tid >> 6), wr = wave >> 1, wc = wave & 1;
    const int nK = K / BKS, ntile = t_first < t_end ? (t_end - t_first + t_step - 1) / t_step : 0, total = ntile * nK;
    if (total == 0) return;
    int lane = tid & 63; asm volatile("" : "+v"(lane));
    const int lr = lane & 15, g = lane >> 4;
    asm volatile("" ::: "memory"); __builtin_amdgcn_s_barrier(); asm volatile("" ::: "memory");
    int sj = 0, sk = 0;
#pragma unroll
    for (int s = 0; s < 3; ++s) if (s < total) { const int ti = t_first + sj * t_step; stage(lds + s * SLOTB, Abase + (size_t)(64 * (ti & 15)) * K, Bt, K, sk, ti >> 4, map, wave, lane); if (++sk == nK) { sk = 0; ++sj; } }
    f32x4 acc[2] = {(f32x4){0.f, 0.f, 0.f, 0.f}, (f32x4){0.f, 0.f, 0.f, 0.f}};
    int cj = 0, ck = 0;
    for (int gs = 0; gs < total; ++gs) {
        const int rem = total - 1 - gs;
        if (rem >= 2) asm volatile("s_waitcnt vmcnt(8)" ::: "memory"); else if (rem == 1) asm volatile("s_waitcnt vmcnt(4)" ::: "memory"); else asm volatile("s_waitcnt vmcnt(0)" ::: "memory");
        __builtin_amdgcn_s_barrier(); asm volatile("" ::: "memory");
        if (gs + 3 < total) { const int ti = t_first + sj * t_step; stage(lds + ((gs + 3) & 3) * SLOTB, Abase + (size_t)(64 * (ti & 15)) * K, Bt, K, sk, ti >> 4, map, wave, lane); if (++sk == nK) { sk = 0; ++sj; } }
        const LAS unsigned char* sl = lds + (gs & 3) * SLOTB;
#pragma unroll
        for (int kk = 0; kk < 4; ++kk) {
            const bf16x8 a = *(const LAS bf16x8*)(sl + soff(16 * wr + lr, 4 * kk + g));
            const bf16x8 b0 = *(const LAS bf16x8*)(sl + 16384 + soff(32 * wc + lr, 4 * kk + g)), b1 = *(const LAS bf16x8*)(sl + 16384 + soff(32 * wc + 16 + lr, 4 * kk + g));
            acc[0] = __builtin_amdgcn_mfma_f32_16x16x32_bf16(b0, a, acc[0], 0, 0, 0); acc[1] = __builtin_amdgcn_mfma_f32_16x16x32_bf16(b1, a, acc[1], 0, 0, 0);
        }
        asm volatile("" ::: "memory");
        if (++ck == nK) { const int ti = t_first + cj * t_step; E(acc, ti & 15, ti >> 4, wr, wc, lr, g); acc[0] = (f32x4){0.f, 0.f, 0.f, 0.f}; acc[1] = acc[0]; ck = 0; ++cj; }
    }
    asm volatile("s_waitcnt vmcnt(0)" ::: "memory"); __builtin_amdgcn_s_barrier(); asm volatile("" ::: "memory");
}

__device__ __forceinline__ v2u pack4(const f32x4 v) { v2u w; w.x = pg8::cvt_pk_bf16(v[0], v[1]); w.y = pg8::cvt_pk_bf16(v[2], v[3]); return w; }
struct EpiScale {
    bf16* O; int ldc; const float* ssq;
    __device__ __forceinline__ void operator()(const f32x4 (&acc)[2], int tm, int tn, int wr, int wc, int lr, int g) const {
        const int row = MP + 64 * tm + 16 * wr + lr; const float r = ep::row_rs(ssq, row); bf16* p = O + (size_t)row * ldc + 64 * tn + 32 * wc + 4 * g;
        *(v2u*)p = pack4(acc[0] * r); *(v2u*)(p + 16) = pack4(acc[1] * r);
    }
};
struct EpiSwiGLU {
    bf16* O; const float* ssq;
    __device__ __forceinline__ void operator()(const f32x4 (&acc)[2], int tm, int tn, int wr, int wc, int lr, int g) const {
        const int row = MP + 64 * tm + 16 * wr + lr; const float r = ep::row_rs(ssq, row);
        const f32x4 gg = acc[0] * r, uu = acc[1] * r; f32x4 h;
#pragma unroll
        for (int j = 0; j < 4; ++j) h[j] = ep::silu_mul(gg[j], uu[j]);
        *(v2u*)(O + (size_t)row * DFF + 32 * tn + 16 * wc + 4 * g) = pack4(h);
    }
};
template <bool WB> struct EpiResid {
    bf16* XB; float* ssq;
    __device__ __forceinline__ void operator()(const f32x4 (&acc)[2], int tm, int tn, int wr, int wc, int lr, int g) const {
        const int row = MP + 64 * tm + 16 * wr + lr, col = 64 * tn + 32 * wc + 4 * g; bf16* xp = XB + (size_t)row * DM + col;
        const v2u w0 = pack4(bf4_to_f(*(const v2u*)xp) + acc[0]), w1 = pack4(bf4_to_f(*(const v2u*)(xp + 16)) + acc[1]);
        *(v2u*)xp = w0; *(v2u*)(xp + 16) = w1;
        if (WB) { const f32x4 r0 = bf4_to_f(w0), r1 = bf4_to_f(w1);
            float ss = ((r0[0] * r0[0] + r0[1] * r0[1]) + (r0[2] * r0[2] + r0[3] * r0[3])) + ((r1[0] * r1[0] + r1[1] * r1[1]) + (r1[2] * r1[2] + r1[3] * r1[3]));
            ss += __shfl_xor(ss, 16); ss += __shfl_xor(ss, 32); if (g == 0) atomicAdd(ssq + (size_t)row * 16 + tn, ss); }
    }
};
struct EpiConvIn {
    bf16* BG; bf16* U; const float* ssq; float* cvS;
    __device__ __forceinline__ void operator()(const f32x4 (&acc)[2], int tm, int tn, int wr, int wc, int lr, int g) const {
        const int row = MP + 64 * tm + 16 * wr + lr; const float r = ep::row_rs(ssq, row);
        if (tn < 16) { bf16* p = BG + (size_t)row * DM + 64 * tn + 32 * wc + 4 * g; *(v2u*)p = pack4(acc[0] * r); *(v2u*)(p + 16) = pack4(acc[1] * r); }
        else { const int ch = 32 * (tn - 16) + 16 * wc + 4 * g; const f32x4 pv = (acc[0] * r) * (acc[1] * r);
            *(v2u*)(U + (size_t)row * DM + ch) = pack4(pv);
            const int rs = row - MP, t = rs & (S_S - 1), b = rs >> 3; if (t >= S_S - 2) *(f32x4*)(cvS + (size_t)(b * 2 + (t - (S_S - 2))) * DM + ch) = pv; }
    }
};
}
#ifndef TS_PROBE
#define TS_PROBE -1
#endif
#ifndef TS_A
#define TS_A ((TS_PROBE >= N_PHASES) ? 0 : TS_PROBE)
#define TS_B ((TS_PROBE >= N_PHASES) ? N_PHASES : TS_PROBE + 1)
#endif
#ifndef PROBE_LAUNCH
#define PROBE_LAUNCH -1
#define PROBE_LAUNCH_N 1
#endif
#ifndef PROBE_ID
#define PROBE_ID -1
#define PROBE_N 1
#endif
#ifndef SCAN_MODE
#define SCAN_MODE 3
#endif
#ifndef MK_N_LAUNCHES
#define MK_N_LAUNCHES 1
#endif
constexpr int N_PHASES = (FLOW == 1) ? 5 : 13;
struct Args { const float* in[18]; float* out; unsigned char* ws; int ph_lo, ph_hi, rep_id, rep_n, dry, pad; };
__global__ void __launch_bounds__(NWAVES * 64, 2) fwd_kernel(Args args) {
    extern __shared__ __attribute__((aligned(16))) unsigned char lds[];
    Frame F;
    F.lds = (LAS unsigned char*)lds; F.MISC = (volatile LAS unsigned*)(F.lds + MISC_OFF);
    F.tid = threadIdx.x; F.lane = F.tid & 63; F.wave = __builtin_amdgcn_readfirstlane(F.tid >> 6);
    F.G = gridDim.x; { const int bx = blockIdx.x; F.vcu = (F.G % 8 == 0) ? (bx % 8) * (F.G / 8) + bx / 8 : bx; }
    F.ws = args.ws; F.out = args.out; F.ctl = (gu32*)(args.ws + WS_CTL);
    F.xp = args.in[0]; F.xs = args.in[1]; F.stC = args.in[2]; F.stN = args.in[3]; F.stM = args.in[4]; F.stConv = args.in[5]; F.norm_mix = args.in[6]; F.norm_ffn = args.in[7]; F.norm_final = args.in[8];
    F.w_in = args.in[9]; F.b_gate = args.in[10]; F.head_norm = args.in[11]; F.w_out = args.in[12]; F.w_cin = args.in[13]; F.w_taps = args.in[14]; F.w_cout = args.in[15]; F.w_gu = args.in[16]; F.w_dn = args.in[17];
    for (int u = F.tid; u < (LDS_BYTES - LDSCTL_OFF) / 4; u += NWAVES * 64) ((LAS unsigned*)(F.lds + LDSCTL_OFF))[u] = 0u;
    __syncthreads();
    XcdBarrier bar; bar.bar = (unsigned*)(F.ctl + CW_BAR); bar.x = 0; bar.st = nullptr;
    const int lo = args.ph_lo, hi = args.ph_hi;
    if (hi - lo > 1) bar = xcd_barrier_post((unsigned*)(F.ctl + CW_BAR), F.MISC + 8);
#define IN(k) (lo <= (k) && (k) < hi)
#define REP(id) (args.rep_id == (id) ? args.rep_n : 1)
#define SEAM(k) do { if (IN(k) && IN((k) + 1)) xcd_barrier(bar); STAMP((k) + 1); } while (0)
#if TS_PROBE >= 0
#define STAMP(i) do { if (blockIdx.x == 0 && F.tid == 0) ((unsigned long long*)(F.ctl + 2048))[(i)] = __builtin_amdgcn_s_memrealtime(); } while (0)
#else
#define STAMP(i) do { } while (0)
#endif
    bf16* XB = WSP(bf16, WS_XB); bf16* A2 = WSP(bf16, WS_A2); float* Y = F.out + O_Y;
    float* SSQ0 = WSP(float, WS_SSQ); float* SSQ1 = SSQ0 + (size_t)MT * 16; float* SSQ2 = SSQ1 + (size_t)MT * 16; float* SSQ3 = SSQ2 + (size_t)MT * 16;

    STAMP(0);
    if (IN(0)) { p0_prologue(F); } SEAM(0);
#define SG_UP(WOFF) do { if (F.G == 256) { if (blockIdx.x < 128) sg::run(F.lds, XBs, WSP(bf16, WOFF), DM, sg::MapGU(), Es, (int)blockIdx.x, 128, 384); else sg::run(F.lds, XBs, WSP(bf16, WOFF), DM, sg::MapGU(), Es, 384 + (int)blockIdx.x - 128, 128, 16 * (DFF / 32)); } \
        else sg::run(F.lds, XBs, WSP(bf16, WOFF), DM, sg::MapGU(), Es, F.vcu, F.G, 16 * (DFF / 32)); } while (0)
    const bf16* XBs = XB + (size_t)MP * DM; const bf16* A2s = A2 + (size_t)MP * DM; const bf16* HFs = WSP(bf16, WS_HFF) + (size_t)MP * DFF;
    if (IN(1)) { pg8::Gemm g{XB, WSP(bf16, WS_W_IN), MP, NIN, DM}; ep::EpiScale E{WSP(bf16, WS_QKVO), NIN, SSQ0}; run_gemm<ep::EpiScale, true, true>(F, g, E);
        sg::EpiScale Es{WSP(bf16, WS_QKVO), NIN, SSQ0}; sg::run(F.lds, XBs, WSP(bf16, WS_W_IN), DM, sg::MapPlain(), Es, F.vcu, F.G, 16 * (NIN / 64)); } SEAM(1);
#if SCAN_MODE == 0
    if (IN(2)) { scan_oracle(F, true, true, true); } SEAM(2);
    if (IN(3)) { gate_pass(F, 0, MT); } SEAM(3);
#elif SCAN_MODE == 1
    if (IN(2)) { s1_state_pass(F); scan_oracle(F, true, true, false); } SEAM(2);
    if (IN(3)) { gate_pass(F, 0, MT); } SEAM(3);
#elif SCAN_MODE == 2
    if (IN(2)) { s1_state_pass(F); scan_oracle(F, false, true, false); } SEAM(2);
    if (IN(3)) { s2_output_pass(F); gate_pass(F, MP, MT); } SEAM(3);
#else
    if (IN(2)) {
        const bool split = (F.G % 32) == 0; const int slot = F.vcu & 31, grp = F.vcu >> 5, ngrp = F.G >> 5;
        if (!split) { s3b_sample_pass(F, F.vcu, F.G); s1c_state_pass(F, F.vcu, F.G); }
        else if (slot < 16) { s1c_state_pass(F, grp * 16 + slot, ngrp * 16); P0STAMP(22); }
        else { s3b_sample_pass(F, grp * 16 + slot - 16, ngrp * 16);
#if TS_PROBE >= 0
            if (blockIdx.x == 128 && F.tid == 0) ((unsigned long long*)(F.ctl + 2048))[24] = __builtin_amdgcn_s_memrealtime();
#endif
        }
    } SEAM(2);
    if (IN(3)) { s2_output_pass(F); } SEAM(3);
#endif
#if FLOW == 1
    if (IN(4)) {
        unsigned* CNT = (unsigned*)(F.ctl + CW_CNT);
#define CNTS(s) (CNT + (s) * 68 * 64)
        const epf::rsrc_t rY = epf::mk(Y, (size_t)MT * DM * 4), rXB = epf::mk(XB, (size_t)MT * DM * 2), rHFF = epf::mk(F.ws + WS_HFF, (size_t)MT * DFF * 2);
        const epf::rsrc_t rS1 = epf::mk(SSQ1, SSQ_BYTES), rS2 = epf::mk(SSQ2, SSQ_BYTES), rS3 = epf::mk(SSQ3, SSQ_BYTES);
        const epf::rsrc_t rBG = epf::mk(F.ws + WS_BG, (size_t)MT * DM * 2), rU = epf::mk(F.ws + WS_U, (size_t)MT * DM * 2);
        int rot = 0;
        { pg8::Gemm g{A2, WSP(bf16, WS_W_OUT), MT, DM, DM}; epf::EpiResid<true, false> E{F.xp, F.xs, rY, rXB, rS1}; flow_gemm(F, g, E, rot, nullptr, 0u, CNTS(0)); rot += 272; }
        { pg8::Gemm g{XB, WSP(bf16, WS_W_GU0), MT, NGU, DM}; epf::EpiSwiGLU E{rHFF, rS1}; flow_gemm(F, g, E, rot, CNTS(0), 32u, CNTS(1)); rot += 1496; }
        { pg8::Gemm g{WSP(bf16, WS_HFF), WSP(bf16, WS_W_DN0), MT, DM, DFF}; epf::EpiResid<true, true> E{nullptr, nullptr, rY, rXB, rS2}; flow_gemm(F, g, E, rot, CNTS(1), 176u, CNTS(2)); rot += 272; }
        { pg8::Gemm g{XB, WSP(bf16, WS_W_CIN), MT, NCIN, DM}; epf::EpiConvIn E{rBG, rU, rS2, F.out + O_CVP, F.out + O_CVS}; flow_gemm(F, g, E, rot, CNTS(2), 32u, CNTS(3)); rot += 816; }
        conv_flow(F, rot, CNTS(3), CNTS(4)); rot += 72;
        { pg8::Gemm g{A2, WSP(bf16, WS_W_COUT), MT, DM, DM}; epf::EpiResid<true, true> E{nullptr, nullptr, rY, rXB, rS3}; flow_gemm(F, g, E, rot, CNTS(4), 8u, CNTS(5)); rot += 272; }
        { pg8::Gemm g{XB, WSP(bf16, WS_W_GU1), MT, NGU, DM}; epf::EpiSwiGLU E{rHFF, rS3}; flow_gemm(F, g, E, rot, CNTS(5), 32u, CNTS(6)); rot += 1496; }
        { pg8::Gemm g{WSP(bf16, WS_HFF), WSP(bf16, WS_W_DN1), MT, DM, DFF}; epf::EpiResid<false, true> E{nullptr, nullptr, rY, rXB, rS3}; flow_gemm(F, g, E, rot, CNTS(6), 176u, CNTS(7)); rot += 272; }
        fnorm_flow(F, rot, CNTS(7));
#undef CNTS
    }
#elif FLOW == 2
    {
        const epf::rsrc_t rY = epf::mk(Y, (size_t)MT * DM * 4), rXB = epf::mk(XB, (size_t)MT * DM * 2), rHFF = epf::mk(F.ws + WS_HFF, (size_t)MT * DFF * 2);
        const epf::rsrc_t rS1 = epf::mk(SSQ1, SSQ_BYTES), rS2 = epf::mk(SSQ2, SSQ_BYTES), rS3 = epf::mk(SSQ3, SSQ_BYTES);
        const epf::rsrc_t rBG = epf::mk(F.ws + WS_BG, (size_t)MT * DM * 2), rU = epf::mk(F.ws + WS_U, (size_t)MT * DM * 2);
    if (IN(4)) { pg8::Gemm g{A2, WSP(bf16, WS_W_OUT), MT, DM, DM}; epf::EpiResid<true, false> E{F.xp, F.xs, rY, rXB, rS1}; run_gemm<epf::EpiResid<true, false>, true, true>(F, g, E); } SEAM(4);
    if (IN(5)) { pg8::Gemm g{XB, WSP(bf16, WS_W_GU0), MT, NGU, DM}; epf::EpiSwiGLU E{rHFF, rS1}; run_gemm<epf::EpiSwiGLU, true, true>(F, g, E); } SEAM(5);
    if (IN(6)) { pg8::Gemm g{WSP(bf16, WS_HFF), WSP(bf16, WS_W_DN0), MT, DM, DFF}; epf::EpiResid<true, true> E{nullptr, nullptr, rY, rXB, rS2}; run_gemm<epf::EpiResid<true, true>, true, true>(F, g, E); } SEAM(6);
    if (IN(7)) { pg8::Gemm g{XB, WSP(bf16, WS_W_CIN), MT, NCIN, DM}; epf::EpiConvIn E{rBG, rU, rS2, F.out + O_CVP, F.out + O_CVS}; run_gemm<epf::EpiConvIn, true, true>(F, g, E); } SEAM(7);
    if (IN(8)) { conv_pass(F); } SEAM(8);
    if (IN(9)) { pg8::Gemm g{A2, WSP(bf16, WS_W_COUT), MT, DM, DM}; epf::EpiResid<true, true> E{nullptr, nullptr, rY, rXB, rS3}; run_gemm<epf::EpiResid<true, true>, true, true>(F, g, E); } SEAM(9);
    if (IN(10)) { pg8::Gemm g{XB, WSP(bf16, WS_W_GU1), MT, NGU, DM}; epf::EpiSwiGLU E{rHFF, rS3}; run_gemm<epf::EpiSwiGLU, true, true>(F, g, E); } SEAM(10);
    if (IN(11)) { pg8::Gemm g{WSP(bf16, WS_HFF), WSP(bf16, WS_W_DN1), MT, DM, DFF}; epf::EpiResid<false, true> E{nullptr, nullptr, rY, rXB, rS3}; run_gemm<epf::EpiResid<false, true>, true, true>(F, g, E); } SEAM(11);
    if (IN(12)) { final_norm(F); }
    }
#else
    if (IN(4)) { pg8::Gemm g{A2, WSP(bf16, WS_W_OUT), MP, DM, DM}; ep::EpiResid<true> E{XB, SSQ1}; run_gemm<ep::EpiResid<true>, true, true>(F, g, E);
        sg::EpiResid<true> Es{XB, SSQ1}; sg::run(F.lds, A2s, WSP(bf16, WS_W_OUT), DM, sg::MapPlain(), Es, F.vcu, F.G, 16 * (DM / 64)); } SEAM(4);
    if (IN(5)) { pg8::Gemm g{XB, WSP(bf16, WS_W_GU0), MT, NGU, DM}; ep::EpiSwiGLU E{WSP(bf16, WS_HFF), SSQ1}; run_gemm<ep::EpiSwiGLU, true, true>(F, g, E); } SEAM(5);
    if (IN(6)) { pg8::Gemm g{WSP(bf16, WS_HFF), WSP(bf16, WS_W_DN0), MP, DM, DFF}; ep::EpiResid<true> E{XB, SSQ2}; run_gemm<ep::EpiResid<true>, true, true>(F, g, E);
        sg::EpiResid<true> Es{XB, SSQ2}; sg::run(F.lds, HFs, WSP(bf16, WS_W_DN0), DFF, sg::MapPlain(), Es, F.vcu, F.G, 16 * (DM / 64)); } SEAM(6);
    if (IN(7)) { pg8::Gemm g{XB, WSP(bf16, WS_W_CIN), MP, NCIN, DM}; ep::EpiConvIn E{WSP(bf16, WS_BG), WSP(bf16, WS_U), SSQ2, F.out + O_CVP, F.out + O_CVS}; run_gemm<ep::EpiConvIn, true, true>(F, g, E);
        sg::EpiConvIn Es{WSP(bf16, WS_BG), WSP(bf16, WS_U), SSQ2, F.out + O_CVS}; sg::run(F.lds, XBs, WSP(bf16, WS_W_CIN), DM, sg::MapCin(), Es, F.vcu, F.G, 16 * (NCIN / 64)); } SEAM(7);
    if (IN(8)) { conv_pass(F); } SEAM(8);
    if (IN(9)) { pg8::Gemm g{A2, WSP(bf16, WS_W_COUT), MP, DM, DM}; ep::EpiResid<true> E{XB, SSQ3}; run_gemm<ep::EpiResid<true>, true, true>(F, g, E);
        sg::EpiResid<true> Es{XB, SSQ3}; sg::run(F.lds, A2s, WSP(bf16, WS_W_COUT), DM, sg::MapPlain(), Es, F.vcu, F.G, 16 * (DM / 64)); } SEAM(9);
    if (IN(10)) { pg8::Gemm g{XB, WSP(bf16, WS_W_GU1), MT, NGU, DM}; ep::EpiSwiGLU E{WSP(bf16, WS_HFF), SSQ3}; run_gemm<ep::EpiSwiGLU, true, true>(F, g, E); } SEAM(10);
    if (IN(11)) { pg8::Gemm g{WSP(bf16, WS_HFF), WSP(bf16, WS_W_DN1), MP, DM, DFF}; ep::EpiResid<false> E{XB, nullptr}; run_gemm<ep::EpiResid<false>, true, true>(F, g, E);
        sg::EpiResid<false> Es{XB, nullptr}; sg::run(F.lds, HFs, WSP(bf16, WS_W_DN1), DFF, sg::MapPlain(), Es, F.vcu, F.G, 16 * (DM / 64)); } SEAM(11);
    if (IN(12)) { final_norm(F); }
#endif
#if TS_PROBE >= 0
    {
        xcd_barrier(bar); STAMP(N_PHASES);
        if (blockIdx.x == 0 && F.tid == 0) {
            const unsigned long long* ts = (const unsigned long long*)(F.ctl + 2048);
            const unsigned long long t0 = ts[TS_A], t1 = ts[TS_B];
            const int T = (int)((t1 - t0 + 50) / 100);
            F.out[O_Y] += (float)(10 + T / 50);
            const float X = (2.5f + 0.07f * (float)(T % 50)) * 1e-4f, sc = 1.f + sqrtf(X);
            for (int i = 0; i < NB_P * NH; ++i) F.out[O_MP + i] *= sc;
        }
    }
#endif
#undef IN
#undef SEAM
}

extern "C" void kernel_launch(void* const* d_in, const int* in_sizes, int n_in, void* d_out, int out_size, void* d_ws, size_t ws_size, hipStream_t stream) {
    static int grid = 0;
    if (grid == 0) {
        if (n_in != 18 || in_sizes[0] != MP * DM || (size_t)out_size != O_END || ws_size < WS_END) { fprintf(stderr, "kernel_launch: unexpected shapes: n_in %d in0 %d out %d ws %zu (need out %zu ws %zu)\n", n_in, n_in > 0 ? in_sizes[0] : -1, out_size, ws_size, (size_t)O_END, (size_t)WS_END); grid = -1; return; }
        int dev = 0, cus = 0;
        if (hipGetDevice(&dev) != hipSuccess || hipDeviceGetAttribute(&cus, hipDeviceAttributeMultiprocessorCount, dev) != hipSuccess) { grid = -1; return; }
        if (hipFuncSetAttribute((const void*)fwd_kernel, hipFuncAttributeMaxDynamicSharedMemorySize, LDS_BYTES) != hipSuccess) { fprintf(stderr, "kernel_launch: hipFuncSetAttribute failed\n"); grid = -1; return; }
        (void)hipGetLastError();
        grid = cus;
    }
    if (grid < 0) return;
    (void)hipMemsetAsync((char*)d_ws + WS_CTL, 0, CTL_ZERO_BYTES, stream);
    Args a{};
    for (int i = 0; i < 18; ++i) a.in[i] = (const float*)d_in[i];
    a.out = (float*)d_out; a.ws = (unsigned char*)d_ws; a.rep_id = PROBE_ID; a.rep_n = PROBE_N;
#if MK_N_LAUNCHES == 1
    a.ph_lo = 0; a.ph_hi = N_PHASES;
    hipLaunchKernelGGL(fwd_kernel, dim3(grid), dim3(NWAVES * 64), LDS_BYTES, stream, a);
#else
    for (int p = 0; p < N_PHASES; ++p) { a.ph_lo = p; a.ph_hi = p + 1; const int nr = (p == PROBE_LAUNCH ? PROBE_LAUNCH_N : 1); for (int r = 0; r < nr; ++r) { a.dry = (r + 1 < nr) ? 1 : 0; hipLaunchKernelGGL(fwd_kernel, dim3(grid), dim3(NWAVES * 64), LDS_BYTES, stream, a); } }
#endif
}
```

```cpp
#include <hip/hip_runtime.h>
#include <cstdio>
#include <cstdint>
#include <cmath>
#define USE_SLOW_GEMM 0
#define MK_N_LAUNCHES 1
#define SCAN_MODE 3
#define FLOW 0
#ifndef FLOW
#define FLOW 0
#endif
#define PG8_A_AUX ((FLOW) ? 16 : 0)
namespace pg8 {
#define PG8_LAS __attribute__((address_space(3)))
typedef unsigned short bf16_t;
typedef short bf16x8 __attribute__((ext_vector_type(8)));
typedef float f32x4 __attribute__((ext_vector_type(4)));
typedef unsigned u32x4 __attribute__((ext_vector_type(4)));
constexpr int BM = 256, BK = 64, HALF = 128, HTB = HALF * BK * 2  , STAGE_BYTES = 8 * HTB, NXCD = 8, WGM = 4;

__host__ __device__ __forceinline__ int lds_byte(int r, int c) { const int st = (r >> 4) * 2 + (c >> 5), rr = r & 15, cc = c & 31, ob = rr * 64 + cc * 2; return st * 1024 + (ob ^ (((ob >> 9) & 1) << 5)); }
__host__ __device__ __forceinline__ void stage_rc(int b, int& R, int& C) { const int st = b / 1024, sb = b % 1024, swz = sb ^ (((sb >> 9) & 1) << 5); R = (st >> 1) * 16 + swz / 64; C = (st & 1) * 32 + (swz % 64) / 2; }
__host__ __device__ __forceinline__ int perm32(int rho) { const int n = rho >> 4, i = rho & 15; return 8 * (i >> 2) + 4 * n + (i & 3); }

struct Unit { int pm, pn; };
struct Gemm { const bf16_t* A; const bf16_t* Bt; int M, N, K; };

struct StaticOrder {
    int nM, nN, nwg, G, c;
    __host__ __device__ void init(int M, int N, int G_, int c_) { nM = M / BM; nN = N / BM; nwg = nM * nN; G = G_; c = c_; }
    __host__ __device__ bool next(int i, Unit& u) const {
        const long L = (long)i * G + c; if (L >= nwg) return false;
        int wgid = (int)L; { const int q = nwg / NXCD, r = nwg % NXCD, xcd = wgid % NXCD, off = wgid / NXCD; wgid = (xcd < r ? xcd * (q + 1) : r * (q + 1) + (xcd - r) * q) + off; }
        const int nig = WGM * nN, gid = wgid / nig, fm = gid * WGM, gsz = (nM - fm) < WGM ? (nM - fm) : WGM;
        u.pm = fm + ((wgid % nig) % gsz); u.pn = (wgid % nig) / gsz; return true;
    }
    __device__ __forceinline__ void a_ready(const Unit&) const {}
    __device__ __forceinline__ void done(const Unit&) const {}
    __device__ __forceinline__ void flush() const {}
};

__device__ __forceinline__ unsigned cvt_pk_bf16(float lo, float hi) { unsigned r; asm volatile("v_cvt_pk_bf16_f32 %0, %1, %2" : "=v"(r) : "v"(lo), "v"(hi)); return r; }
template <class Epi, class Sched, bool ALIGN_EPI = false, bool SP2 = false>
__device__ __forceinline__ void gemm_phase(PG8_LAS unsigned char* lds, const Gemm g, const Sched& S, const Epi& E) {
    const int tid = threadIdx.x, wid = __builtin_amdgcn_readfirstlane(tid >> 6), lane = tid & 63, wr = wid >> 2, wc = wid & 3, fr = lane & 15, fq = lane >> 4;
    const int K = g.K, nt = K / BK;
    unsigned voffA[2], voffB[2];
#pragma unroll
    for (int i = 0; i < 2; ++i) { int R, C; stage_rc(tid * 16 + i * 8192, R, C); const int Rb = Epi::PERM ? ((R & ~31) + perm32(R & 31)) : R;
        voffA[i] = (unsigned)(R * K + C) * 2u; voffB[i] = (unsigned)(Rb * K + C) * 2u; }
    const size_t kstep = (size_t)(BK * 2);
    const size_t hstep = (size_t)HALF * K * 2;
    const size_t tstep = 2 * hstep;
    const unsigned ldsw = (unsigned)wid * 1024u;
    const int aoff = lds_byte(wr * 64 + fr, fq * 8), boff = lds_byte(wc * 32 + fr, fq * 8);
#define PG8_SA(b, h) (((b) * 2 + (h)) * HTB)
#define PG8_SB(b, h) ((4 + (b) * 2 + (h)) * HTB)
#define PG8_STAGE(bufoff, gbase, voff, aux) do { _Pragma("unroll") for (int _i = 0; _i < 2; ++_i) \
        __builtin_amdgcn_global_load_lds((const unsigned*)((const char*)(gbase) + (voff)[_i]), (PG8_LAS unsigned*)(lds + (bufoff) + ldsw + _i * 8192), 16, 0, aux); } while (0)
#define PG8_LDA(dst, b, h) do { _Pragma("unroll") for (int m = 0; m < 4; ++m) _Pragma("unroll") for (int k = 0; k < 2; ++k) dst[m][k] = *(const PG8_LAS bf16x8*)(lds + PG8_SA(b, h) + aoff + m * 2048 + k * 1024); } while (0)
#define PG8_LDB(dst, b, h) do { _Pragma("unroll") for (int n = 0; n < 2; ++n) _Pragma("unroll") for (int k = 0; k < 2; ++k) dst[n][k] = *(const PG8_LAS bf16x8*)(lds + PG8_SB(b, h) + boff + n * 2048 + k * 1024); } while (0)
#define PG8_MMA(ai, bj, At, Bt) do { __builtin_amdgcn_s_setprio(1); _Pragma("unroll") for (int m = 0; m < 4; ++m) _Pragma("unroll") for (int n = 0; n < 2; ++n) _Pragma("unroll") for (int k = 0; k < 2; ++k) \
        acc[ai][bj][m][n] = __builtin_amdgcn_mfma_f32_16x16x32_bf16(Bt[n][k], At[m][k], acc[ai][bj][m][n], 0, 0, 0); __builtin_amdgcn_s_setprio(0); } while (0)
#define PG8_WAIT_V(n) asm volatile("s_waitcnt vmcnt(" #n ")" ::: "memory")
#define PG8_WAIT_L(n) asm volatile("s_waitcnt lgkmcnt(" #n ")" ::: "memory")
#define PG8_BAR __builtin_amdgcn_s_barrier()
#define PG8_SCHED __builtin_amdgcn_sched_barrier(0)
    Unit cur, nxt; int ui = 0;
    if (!S.next(0, cur)) return;
    f32x4 acc[2][2][4][2];
#pragma unroll
    for (int a = 0; a < 2; ++a)
#pragma unroll
        for (int b = 0; b < 2; ++b)
#pragma unroll
            for (int m = 0; m < 4; ++m)
#pragma unroll
                for (int n = 0; n < 2; ++n) acc[a][b][m][n] = (f32x4){0.f, 0.f, 0.f, 0.f};
    bf16x8 At[4][2], B0[2][2], B1[2][2];
    const char* cA = (const char*)g.A + (size_t)cur.pm * tstep; const char* cB = (const char*)g.Bt + (size_t)cur.pn * tstep;
    S.a_ready(cur);
    if constexpr (SP2) {
        PG8_STAGE(PG8_SB(0, 0), cB, voffB, 0); PG8_STAGE(PG8_SB(0, 1), cB + hstep, voffB, 0); PG8_STAGE(PG8_SA(0, 0), cA, voffA, PG8_A_AUX); PG8_STAGE(PG8_SA(0, 1), cA + hstep, voffA, PG8_A_AUX);
        if (wr == 1) PG8_BAR;
        PG8_WAIT_V(2); PG8_BAR;
        PG8_STAGE(PG8_SB(1, 0), cB + kstep, voffB, 0); PG8_STAGE(PG8_SA(1, 0), cA + kstep, voffA, PG8_A_AUX); PG8_STAGE(PG8_SB(1, 1), cB + hstep + kstep, voffB, 0);
        PG8_WAIT_V(6); PG8_BAR;
    } else {
        PG8_STAGE(PG8_SB(0, 0), cB, voffB, 0); PG8_STAGE(PG8_SA(0, 0), cA, voffA, PG8_A_AUX); PG8_STAGE(PG8_SB(0, 1), cB + hstep, voffB, 0); PG8_STAGE(PG8_SA(0, 1), cA + hstep, voffA, PG8_A_AUX);
        if (wr == 1) PG8_BAR;
        PG8_WAIT_V(4); PG8_BAR;
        PG8_STAGE(PG8_SB(1, 0), cB + kstep, voffB, 0); PG8_STAGE(PG8_SA(1, 0), cA + kstep, voffA, PG8_A_AUX); PG8_STAGE(PG8_SB(1, 1), cB + hstep + kstep, voffB, 0);
        PG8_WAIT_V(6); PG8_BAR;
    }
    for (;;) {
        const bool has_next = S.next(ui + 1, nxt);
        const char* nA = has_next ? (const char*)g.A + (size_t)nxt.pm * tstep : cA; const char* nB = has_next ? (const char*)g.Bt + (size_t)nxt.pn * tstep : cB;
        for (int t = 0; t < nt; t += 2) {
            const bool last = (t == nt - 2);
            const char* a1 = cA + (size_t)(t + 1) * kstep;
            const char* a2 = last ? nA : cA + (size_t)(t + 2) * kstep; const char* b2 = last ? nB : cB + (size_t)(t + 2) * kstep;
            const char* a3 = a2 + kstep; const char* b3 = b2 + kstep;
            if (last && has_next) S.a_ready(nxt);
            if constexpr (SP2) {
            PG8_LDB(B0, 0, 0); PG8_LDB(B1, 0, 1); PG8_SCHED; PG8_LDA(At, 0, 0); PG8_STAGE(PG8_SA(1, 1), a1 + hstep, voffA, PG8_A_AUX);
            PG8_WAIT_V(8); PG8_WAIT_L(0); PG8_BAR; PG8_MMA(0, 0, At, B0); PG8_MMA(0, 1, At, B1); PG8_BAR; PG8_SCHED;
            PG8_LDA(At, 0, 1); PG8_STAGE(PG8_SB(0, 0), b2, voffB, 0); PG8_STAGE(PG8_SB(0, 1), b2 + hstep, voffB, 0); PG8_STAGE(PG8_SA(0, 0), a2, voffA, PG8_A_AUX);
            PG8_WAIT_V(8); PG8_WAIT_L(0); PG8_BAR; PG8_MMA(1, 0, At, B0); PG8_MMA(1, 1, At, B1); PG8_BAR; PG8_SCHED;
            PG8_LDB(B0, 1, 0); PG8_LDB(B1, 1, 1); PG8_SCHED; PG8_LDA(At, 1, 0); PG8_STAGE(PG8_SA(0, 1), a2 + hstep, voffA, PG8_A_AUX);
            PG8_WAIT_V(8); PG8_WAIT_L(0); PG8_BAR; PG8_MMA(0, 0, At, B0); PG8_MMA(0, 1, At, B1); PG8_BAR; PG8_SCHED;
            PG8_LDA(At, 1, 1); PG8_STAGE(PG8_SB(1, 0), b3, voffB, 0); PG8_STAGE(PG8_SB(1, 1), b3 + hstep, voffB, 0); PG8_STAGE(PG8_SA(1, 0), a3, voffA, PG8_A_AUX);
            PG8_WAIT_V(8); PG8_WAIT_L(0); PG8_BAR; PG8_MMA(1, 0, At, B0); PG8_MMA(1, 1, At, B1); PG8_BAR; PG8_SCHED;
            } else {
            PG8_LDB(B0, 0, 0); PG8_SCHED; PG8_LDA(At, 0, 0); PG8_STAGE(PG8_SA(1, 1), a1 + hstep, voffA, PG8_A_AUX);
            PG8_WAIT_L(8); PG8_BAR; PG8_WAIT_L(0); PG8_MMA(0, 0, At, B0); PG8_BAR; PG8_SCHED;
            PG8_LDB(B1, 0, 1); PG8_STAGE(PG8_SB(0, 0), b2, voffB, 0);
            PG8_BAR; PG8_WAIT_L(0); PG8_MMA(0, 1, At, B1); PG8_BAR;
            PG8_LDA(At, 0, 1); PG8_STAGE(PG8_SA(0, 0), a2, voffA, PG8_A_AUX);
            PG8_BAR; PG8_WAIT_L(0); PG8_MMA(1, 0, At, B0); PG8_BAR; PG8_SCHED;
            PG8_STAGE(PG8_SB(0, 1), b2 + hstep, voffB, 0);
            PG8_WAIT_V(6); PG8_BAR; PG8_MMA(1, 1, At, B1); PG8_BAR;
            PG8_LDB(B0, 1, 0); PG8_SCHED; PG8_LDA(At, 1, 0); PG8_STAGE(PG8_SA(0, 1), a2 + hstep, voffA, PG8_A_AUX);
            PG8_WAIT_L(8); PG8_BAR; PG8_WAIT_L(0); PG8_MMA(0, 0, At, B0); PG8_BAR; PG8_SCHED;
            PG8_LDB(B1, 1, 1); PG8_STAGE(PG8_SB(1, 0), b3, voffB, 0);
            PG8_BAR; PG8_WAIT_L(0); PG8_MMA(0, 1, At, B1); PG8_BAR;
            PG8_LDA(At, 1, 1); PG8_STAGE(PG8_SA(1, 0), a3, voffA, PG8_A_AUX);
            PG8_BAR; PG8_WAIT_L(0); PG8_MMA(1, 0, At, B0); PG8_BAR; PG8_SCHED;
            PG8_STAGE(PG8_SB(1, 1), b3 + hstep, voffB, 0);
            PG8_WAIT_V(6); PG8_BAR; PG8_MMA(1, 1, At, B1); PG8_BAR;
            }
            if (t == 0) S.flush();
        }
        if constexpr (ALIGN_EPI) { if (wr == 0) PG8_BAR; }
        if constexpr (!Epi::AFTER_DRAIN) { E(acc, cur, wr, wc, fr, fq); S.done(cur); }
        if (!has_next) break;
#pragma unroll
        for (int a = 0; a < 2; ++a)
#pragma unroll
            for (int b = 0; b < 2; ++b)
#pragma unroll
                for (int m = 0; m < 4; ++m)
#pragma unroll
                    for (int n = 0; n < 2; ++n) acc[a][b][m][n] = (f32x4){0.f, 0.f, 0.f, 0.f};
        cur = nxt; cA = nA; cB = nB; ++ui;
        if constexpr (ALIGN_EPI) { if (wr == 1) PG8_BAR; }
    }
    PG8_WAIT_V(0);
    if constexpr (!ALIGN_EPI) { if (wr == 0) PG8_BAR; }
    PG8_BAR;
    if constexpr (Epi::AFTER_DRAIN) { E.fused(acc, cur, wr, wc, fr, fq, lds, wid, lane); S.done(cur); }
    S.flush();
#undef PG8_SA
#undef PG8_SB
#undef PG8_STAGE
#undef PG8_LDA
#undef PG8_LDB
#undef PG8_MMA
#undef PG8_WAIT_V
#undef PG8_WAIT_L
#undef PG8_BAR
#undef PG8_SCHED
}
}
constexpr int DM = 1024;
constexpr int NB_P = 8, S_P = 2048, NB_S = 128, S_S = 8;
constexpr int MP = NB_P * S_P, MS = NB_S * S_S, MT = MP + MS;
constexpr int NH = 4, DK = 256, DV = 256;
constexpr int NIN = 4096, NIN_SRC = 4104;
constexpr int DFF = 2816, NGU = 2 * DFF, NCIN = 3 * DM;
constexpr float EPS = 1e-6f;
constexpr int NWAVES = 8;

constexpr size_t O_Y = 0;
constexpr size_t O_CP = (size_t)MT * DM;
constexpr size_t O_NP = O_CP + (size_t)NB_P * NH * DV * DK;
constexpr size_t O_MP = O_NP + (size_t)NB_P * NH * DK;
constexpr size_t O_CVP = O_MP + (size_t)NB_P * NH;
constexpr size_t O_CS = O_CVP + (size_t)NB_P * 2 * DM;
constexpr size_t O_NS = O_CS + (size_t)NB_S * NH * DV * DK;
constexpr size_t O_MS = O_NS + (size_t)NB_S * NH * DK;
constexpr size_t O_CVS = O_MS + (size_t)NB_S * NH;
constexpr size_t O_END = O_CVS + (size_t)NB_S * 2 * DM;

constexpr size_t MiB = 1u << 20;
constexpr size_t WS_CTL = 0, CTL_ZERO_BYTES = 32768;
constexpr size_t WS_W_IN = 2 * MiB, WS_W_OUT = 10 * MiB, WS_W_GU0 = 12 * MiB, WS_W_DN0 = 23 * MiB, WS_W_CIN = 29 * MiB, WS_W_COUT = 35 * MiB, WS_W_GU1 = 37 * MiB, WS_W_DN1 = 48 * MiB;
constexpr size_t SSQ_BYTES = (size_t)MT * 16 * 4;
constexpr size_t WS_SSQ = 54 * MiB;
constexpr size_t WS_GATES = 59 * MiB;
constexpr size_t WS_XB = 60 * MiB;
constexpr size_t WS_A2 = 94 * MiB;
constexpr size_t WS_QKVO = 128 * MiB;
constexpr size_t WS_HFF = 128 * MiB;
constexpr size_t WS_BG = 264 * MiB, WS_U = 298 * MiB;
constexpr size_t WS_HBUF = 264 * MiB;
constexpr size_t WS_CST = 332 * MiB;
constexpr size_t WS_NST = 396 * MiB;
constexpr size_t WS_MST = WS_NST + (size_t)32 * 16 * 256 * 4;
constexpr size_t WS_GV = 397 * MiB;
constexpr size_t WS_DRY = 398 * MiB;
constexpr size_t WS_END = 398 * MiB;
static_assert(WS_SSQ + 4 * SSQ_BYTES <= WS_GATES && WS_GATES + (size_t)MT * 8 * 4 <= WS_XB && WS_XB + (size_t)MT * DM * 2 <= WS_A2 && WS_A2 + (size_t)MT * DM * 2 <= WS_QKVO, "ws map");
static_assert(WS_QKVO + (size_t)MT * NIN * 2 <= WS_HBUF && WS_HFF + (size_t)MT * DFF * 2 <= WS_HBUF && WS_BG + (size_t)MT * DM * 2 <= WS_U && WS_U + (size_t)MT * DM * 2 <= WS_CST && WS_HBUF + (size_t)MT * DM * 4 <= WS_CST, "ws map 2");
static_assert(WS_W_DN1 + (size_t)DM * DFF * 2 <= WS_SSQ, "ws map 3");
constexpr int CW_BAR = 4096;

constexpr int RING_OFF = 0, RING_BYTES = 131072;
constexpr int LDSCTL_OFF = RING_BYTES, MISC_OFF = LDSCTL_OFF + 320;
constexpr int SCR_OFF = 132096;
constexpr int LDS_BYTES = 163840;

#define GAS __attribute__((address_space(1)))
#define LAS __attribute__((address_space(3)))
typedef unsigned short bf16;
typedef unsigned v4u __attribute__((ext_vector_type(4)));
typedef unsigned v2u __attribute__((ext_vector_type(2)));
typedef float f32x4 __attribute__((ext_vector_type(4)));
typedef short bf16x8 __attribute__((ext_vector_type(8)));
typedef GAS unsigned gu32;
typedef GAS unsigned long long gu64;
#define RLX_AGENT __ATOMIC_RELAXED, __HIP_MEMORY_SCOPE_AGENT
#define LDS_WAIT() asm volatile("s_waitcnt lgkmcnt(0)" ::: "memory")
#define VM_WAIT() asm volatile("s_waitcnt vmcnt(0)" ::: "memory")
__device__ __forceinline__ unsigned f2bf(float f) { unsigned u = __builtin_bit_cast(unsigned, f); return (u + 0x7fffu + ((u >> 16) & 1u)) >> 16; }
__device__ __forceinline__ unsigned pk2(float lo, float hi) { return f2bf(lo) | (f2bf(hi) << 16); }
__device__ __forceinline__ float bf2f(unsigned short s) { return __builtin_bit_cast(float, (unsigned)s << 16); }
__device__ __forceinline__ float bflo(unsigned w) { return __builtin_bit_cast(float, w << 16); }
__device__ __forceinline__ float bfhi(unsigned w) { return __builtin_bit_cast(float, w & 0xffff0000u); }
__device__ __forceinline__ float wave_sum(float v) {
#pragma unroll
    for (int o = 1; o < 64; o <<= 1) v += __shfl_xor(v, o);
    return v;
}
__device__ __forceinline__ float sigmoidf_(float x) { return 1.f / (1.f + __expf(-x)); }
__device__ __forceinline__ float logsigmoidf_(float x) { return fminf(x, 0.f) - log1pf(expf(-fabsf(x))); }
#define XB_TMO      128
#define XB_XCNT(j)  (256  + 64 * (j))
#define XB_XSUB(j)  (1280 + 64 * (j))
#define XB_XGEN(j)  (2304 + 64 * (j))
#define XB_TOP      3328
#define XB_TOPGEN   3392
#define XCD_BAR_WORDS 3456
#define XB_SPIN_CAP (1u << 18)

__device__ __forceinline__ unsigned xb_ld(unsigned* p)              { return __hip_atomic_load(p, __ATOMIC_RELAXED, __HIP_MEMORY_SCOPE_AGENT); }
__device__ __forceinline__ unsigned xb_add(unsigned* p, unsigned v) { return __hip_atomic_fetch_add(p, v, __ATOMIC_RELAXED, __HIP_MEMORY_SCOPE_AGENT); }
__device__ __forceinline__ unsigned xb_xcc_id() { return (unsigned)__builtin_amdgcn_s_getreg((3 << 11) | 20) & 0xFu; }
#define XB_SPIN(cond, bar) do { unsigned _sp = 0; while (cond) { __builtin_amdgcn_s_sleep(1); \
    if ((++_sp & 255u) == 0u) { if (xb_ld(&(bar)[XB_TMO])) break; if (_sp > XB_SPIN_CAP) { atomicAdd(&(bar)[XB_TMO], 1u); break; } } } } while (0)

struct XcdBarrier {
    unsigned* bar; unsigned x;
    volatile LAS unsigned* st;
};

__device__ __forceinline__ XcdBarrier xcd_barrier_post(unsigned* bar, volatile LAS unsigned* st) {
    XcdBarrier b; b.bar = bar; b.x = xb_xcc_id(); b.st = st;
    if (threadIdx.x == 0) (void)xb_add(&bar[XB_XCNT(b.x)], 1u);
    return b;
}
__device__ __forceinline__ void xcd_barrier_complete(unsigned* bar, unsigned x, unsigned& nloc, unsigned& nx) {
    const unsigned G = gridDim.x * gridDim.y * gridDim.z;
    unsigned sum, cnt, mine, sp = 0u;
    for (;;) {
        sum = 0u; cnt = 0u; mine = 0u;
#pragma unroll
        for (unsigned j = 0; j < 16; ++j) { const unsigned c = xb_ld(&bar[XB_XCNT(j)]); sum += c; cnt += (c > 0u) ? 1u : 0u; mine = (j == x) ? c : mine; }
        if (sum == G) break;
        __builtin_amdgcn_s_sleep(1);
        if ((++sp & 255u) == 0u) { if (xb_ld(&bar[XB_TMO])) break; if (sp > XB_SPIN_CAP) { atomicAdd(&bar[XB_TMO], 1u); break; } }
    }
    nloc = mine > 0u ? mine : 1u; nx = cnt > 0u ? cnt : 1u;
}

__device__ __forceinline__ void xcd_barrier(const XcdBarrier& b) {
    asm volatile("s_waitcnt vmcnt(0)" ::: "memory");
    __syncthreads();
    if (threadIdx.x == 0) {
        unsigned* bar = b.bar;
        __builtin_amdgcn_s_waitcnt(0);
        unsigned nloc = b.st[0], nx = b.st[1];
        if (nloc == 0u) { xcd_barrier_complete(bar, b.x, nloc, nx); b.st[0] = nloc; b.st[1] = nx; }
        const unsigned old = xb_add(&bar[XB_XSUB(b.x)], 1u);
        const unsigned gen = old / nloc;
        if (old + 1u == (gen + 1u) * nloc) {
            __builtin_amdgcn_fence(__ATOMIC_RELEASE, "agent");
            asm volatile("s_waitcnt vmcnt(0)" ::: "memory");
            const unsigned og = xb_add(&bar[XB_TOP], 1u);
            const unsigned tg = og / nx;
            if (og + 1u == (tg + 1u) * nx) xb_add(&bar[XB_TOPGEN], 1u);
            else XB_SPIN(xb_ld(&bar[XB_TOPGEN]) == tg, bar);
            __builtin_amdgcn_fence(__ATOMIC_ACQUIRE, "agent");
            xb_add(&bar[XB_XGEN(b.x)], 1u);
            asm volatile("s_waitcnt vmcnt(0)" ::: "memory");
        } else {
            XB_SPIN(xb_ld(&bar[XB_XGEN(b.x)]) == gen, bar);
            __builtin_amdgcn_fence(__ATOMIC_ACQUIRE, "agent");
            asm volatile("s_waitcnt vmcnt(0)" ::: "memory");
        }
    }
    __syncthreads();
}
struct Frame {
    LAS unsigned char* lds;
    volatile LAS unsigned* MISC;
    gu32* ctl;
    int tid, lane, wave, vcu, G;
    const float *xp, *xs, *stC, *stN, *stM, *stConv, *norm_mix, *norm_ffn, *norm_final, *w_in, *b_gate, *head_norm, *w_out, *w_cin, *w_taps, *w_cout, *w_gu, *w_dn;
    float* out; unsigned char* ws;
};
#define WSP(T, off) ((T*)(F.ws + (off)))

namespace ep {
using pg8::Unit; using pg8::bf16_t; using pg8::cvt_pk_bf16; using pg8::BM; using pg8::HALF; using pg8::u32x4;
__device__ __forceinline__ float row_rs(const float* slab, int row) {
    const f32x4* p = (const f32x4*)(slab + (size_t)row * 16);
    const f32x4 a = p[0], b = p[1], c = p[2], d = p[3];
    const float s = (((a.x + a.y) + (a.z + a.w)) + ((b.x + b.y) + (b.z + b.w))) + (((c.x + c.y) + (c.z + c.w)) + ((d.x + d.y) + (d.z + d.w)));
    return rsqrtf(s * (1.f / 1024.f) + EPS);
}
__device__ __forceinline__ u32x4 pack8(const f32x4 v0, const f32x4 v1) { u32x4 w; w.x = cvt_pk_bf16(v0[0], v0[1]); w.y = cvt_pk_bf16(v0[2], v0[3]); w.z = cvt_pk_bf16(v1[0], v1[1]); w.w = cvt_pk_bf16(v1[2], v1[3]); return w; }

struct EpiScale {
    static constexpr bool PERM = true, AFTER_DRAIN = false;
    bf16_t* O; int ldc; const float* ssq; const LAS float* RS; mutable int ord;
    __device__ __forceinline__ void operator()(const f32x4 (&acc)[2][2][4][2], const Unit& u, int wr, int wc, int fr, int fq) const {
        const int row0 = u.pm * BM + wr * 64 + fr, col0 = u.pn * BM + wc * 32 + 8 * fq;
#pragma unroll
        for (int ai = 0; ai < 2; ++ai)
#pragma unroll
            for (int m = 0; m < 4; ++m) { const int row = row0 + ai * HALF + m * 16; const float r = RS[ord * 256 + (row & 255)]; bf16_t* rowp = O + (size_t)row * ldc + col0;
#pragma unroll
                for (int bj = 0; bj < 2; ++bj) *(u32x4*)(rowp + bj * HALF) = pack8(acc[ai][bj][m][0] * r, acc[ai][bj][m][1] * r); }
        ++ord;
    }
};
__device__ __forceinline__ float silu_mul(float g, float u) { return g / (1.f + __expf(-g)) * u; }
struct EpiSwiGLU {
    static constexpr bool PERM = true, AFTER_DRAIN = false;
    bf16_t* O; const float* ssq; const LAS float* RS; mutable int ord;
    __device__ __forceinline__ void operator()(const f32x4 (&acc)[2][2][4][2], const Unit& u, int wr, int wc, int fr, int fq) const {
        const int row0 = u.pm * BM + wr * 64 + fr, col0 = u.pn * HALF + wc * 32 + 8 * fq;
#pragma unroll
        for (int ai = 0; ai < 2; ++ai)
#pragma unroll
            for (int m = 0; m < 4; ++m) { const int row = row0 + ai * HALF + m * 16; const float r = RS[ord * 256 + (row & 255)];
                const f32x4 g0 = acc[ai][0][m][0] * r, g1 = acc[ai][0][m][1] * r, u0 = acc[ai][1][m][0] * r, u1 = acc[ai][1][m][1] * r;
                f32x4 h0, h1;
#pragma unroll
                for (int j = 0; j < 4; ++j) { h0[j] = silu_mul(g0[j], u0[j]); h1[j] = silu_mul(g1[j], u1[j]); }
                *(u32x4*)(O + (size_t)row * DFF + col0) = pack8(h0, h1); }
        ++ord;
    }
};
template <bool WB> struct EpiResid {
    static constexpr bool PERM = true, AFTER_DRAIN = false;
    bf16_t* XB; float* ssq;
    __device__ __forceinline__ void operator()(const f32x4 (&acc)[2][2][4][2], const Unit& u, int wr, int wc, int fr, int fq) const {
        const int row0 = u.pm * BM + wr * 64 + fr, col0 = u.pn * BM + wc * 32 + 8 * fq;
#pragma unroll
        for (int ai = 0; ai < 2; ++ai)
#pragma unroll
            for (int m = 0; m < 4; ++m) { const int row = row0 + ai * HALF + m * 16; bf16_t* xp = XB + (size_t)row * DM + col0;
                float ss = 0.f;
#pragma unroll
                for (int bj = 0; bj < 2; ++bj) { const u32x4 bw = *(const u32x4*)(xp + bj * HALF);
                    const f32x4 x0 = (f32x4){bflo(bw.x), bfhi(bw.x), bflo(bw.y), bfhi(bw.y)} + acc[ai][bj][m][0], x1 = (f32x4){bflo(bw.z), bfhi(bw.z), bflo(bw.w), bfhi(bw.w)} + acc[ai][bj][m][1];
                    const u32x4 ow = pack8(x0, x1); *(u32x4*)(xp + bj * HALF) = ow;
                    if (WB) { const float r0 = bflo(ow.x), r1 = bfhi(ow.x), r2 = bflo(ow.y), r3 = bfhi(ow.y), r4 = bflo(ow.z), r5 = bfhi(ow.z), r6 = bflo(ow.w), r7 = bfhi(ow.w);
                        ss += ((r0 * r0 + r1 * r1) + (r2 * r2 + r3 * r3)) + ((r4 * r4 + r5 * r5) + (r6 * r6 + r7 * r7)); } }
                if (WB) { ss += __shfl_xor(ss, 16); ss += __shfl_xor(ss, 32); if (fq == 0) ssq[(size_t)row * 16 + u.pn * 4 + wc] = ss; } }
    }
};
struct EpiConvIn {
    static constexpr bool PERM = true, AFTER_DRAIN = false;
    bf16_t* BG; bf16_t* U; const float* ssq; float* cvP; float* cvS; const LAS float* RS; mutable int ord;
    __device__ __forceinline__ void operator()(const f32x4 (&acc)[2][2][4][2], const Unit& u, int wr, int wc, int fr, int fq) const {
        const int row0 = u.pm * BM + wr * 64 + fr;
        if (u.pn < 4) {
            const int col0 = u.pn * BM + wc * 32 + 8 * fq;
#pragma unroll
            for (int ai = 0; ai < 2; ++ai)
#pragma unroll
                for (int m = 0; m < 4; ++m) { const int row = row0 + ai * HALF + m * 16; const float r = RS[ord * 256 + (row & 255)]; bf16_t* rowp = BG + (size_t)row * DM + col0;
#pragma unroll
                    for (int bj = 0; bj < 2; ++bj) *(u32x4*)(rowp + bj * HALF) = pack8(acc[ai][bj][m][0] * r, acc[ai][bj][m][1] * r); }
        } else {
            const int col0 = (u.pn - 4) * HALF + wc * 32 + 8 * fq;
#pragma unroll
            for (int ai = 0; ai < 2; ++ai)
#pragma unroll
                for (int m = 0; m < 4; ++m) { const int row = row0 + ai * HALF + m * 16; const float r = RS[ord * 256 + (row & 255)];
                    const f32x4 p0 = (acc[ai][0][m][0] * r) * (acc[ai][1][m][0] * r), p1 = (acc[ai][0][m][1] * r) * (acc[ai][1][m][1] * r);
                    *(u32x4*)(U + (size_t)row * DM + col0) = pack8(p0, p1);
                    float* sp = nullptr;
                    if (row < MP) { const int t = row & (S_P - 1), b = row >> 11; if (t >= S_P - 2) sp = cvP + (size_t)(b * 2 + (t - (S_P - 2))) * DM + col0; }
                    else { const int rs = row - MP, t = rs & (S_S - 1), b = rs >> 3; if (t >= S_S - 2) sp = cvS + (size_t)(b * 2 + (t - (S_S - 2))) * DM + col0; }
                    if (sp) { *(f32x4*)sp = p0; *(f32x4*)(sp + 4) = p1; } }
        }
        ++ord;
    }
};
}

template <class Epi, class Sched>
__device__ __forceinline__ void gemm_phase_slow(const pg8::Gemm g, const Sched& S, const Epi& E) {
    const int tid = threadIdx.x, wid = __builtin_amdgcn_readfirstlane(tid >> 6), lane = tid & 63, wr = wid >> 2, wc = wid & 3, fr = lane & 15, fq = lane >> 4;
    const int K = g.K;
    pg8::Unit u;
    for (int i = 0; S.next(i, u); ++i) {
        f32x4 acc[2][2][4][2];
#pragma unroll
        for (int a = 0; a < 2; ++a)
#pragma unroll
            for (int b = 0; b < 2; ++b)
#pragma unroll
                for (int m = 0; m < 4; ++m)
#pragma unroll
                    for (int n = 0; n < 2; ++n) acc[a][b][m][n] = (f32x4){0.f, 0.f, 0.f, 0.f};
        const unsigned offA = (unsigned)(wr * 64 + fr) * (unsigned)K * 2u, offB = (unsigned)(wc * 32 + (Epi::PERM ? 8 * fq : 4 * fq)) * (unsigned)K * 2u;
        const char* Au = (const char*)g.A + (size_t)u.pm * 256 * K * 2; const char* Bu = (const char*)g.Bt + (size_t)u.pn * 256 * K * 2;
#pragma unroll
        for (int ai = 0; ai < 2; ++ai) {
#pragma unroll 1
        for (int k0 = 0; k0 < K; k0 += 2) {
            float af[4][2];
#pragma unroll
            for (int m = 0; m < 4; ++m) { const unsigned w = *(const unsigned*)(Au + ((size_t)(ai * 128 + m * 16) * K + k0) * 2 + offA); af[m][0] = bflo(w); af[m][1] = bfhi(w); }
#pragma unroll
            for (int bj = 0; bj < 2; ++bj)
#pragma unroll
                for (int n = 0; n < 2; ++n)
#pragma unroll
                    for (int j = 0; j < 4; ++j) { const unsigned w = *(const unsigned*)(Bu + ((size_t)(bj * 128 + (Epi::PERM ? 4 * n : 16 * n) + j) * K + k0) * 2 + offB);
                        const float b0 = bflo(w), b1 = bfhi(w);
#pragma unroll
                        for (int m = 0; m < 4; ++m) acc[ai][bj][m][n][j] += af[m][0] * b0 + af[m][1] * b1; }
        }
        }
        E(acc, u, wr, wc, fr, fq);
    }
}
#ifndef USE_SLOW_GEMM
#define USE_SLOW_GEMM 0
#endif
template <class Epi, bool ALIGN, bool SP2>
__device__ __forceinline__ void run_gemm(Frame& F, const pg8::Gemm g, const Epi& E) {
    pg8::StaticOrder S; S.init(g.M, g.N, F.G, (int)blockIdx.x);
#if USE_SLOW_GEMM
    gemm_phase_slow<Epi, pg8::StaticOrder>(g, S, E);
#else
    pg8::gemm_phase<Epi, pg8::StaticOrder, ALIGN, SP2>(F.lds + RING_OFF, g, S, E);
#endif
}
constexpr int RS_MAX_UNITS = 7;
template <class Epi, bool ALIGN, bool SP2>
__device__ __forceinline__ void run_gemm_rs(Frame& F, const pg8::Gemm g, Epi& E) {
    pg8::StaticOrder S; S.init(g.M, g.N, F.G, (int)blockIdx.x);
    LAS float* RS = (LAS float*)(F.lds + SCR_OFF);
    __syncthreads();
    { pg8::Unit u; for (int i = 0; i < RS_MAX_UNITS && S.next(i, u); ++i) if (F.tid < 256) RS[i * 256 + F.tid] = ep::row_rs(E.ssq, u.pm * 256 + F.tid); }
    __syncthreads();
    E.RS = RS; E.ord = 0;
    pg8::gemm_phase<Epi, pg8::StaticOrder, ALIGN, SP2>(F.lds + RING_OFF, g, S, E);
}

#ifndef TS_PROBE
#define TS_PROBE -1
#endif
#if TS_PROBE >= 0
#define P0STAMP(i) do { if (blockIdx.x == 0 && F.tid == 0) ((unsigned long long*)(F.ctl + 2048))[(i)] = __builtin_amdgcn_s_memrealtime(); } while (0)
#else
#define P0STAMP(i) do { } while (0)
#endif
__device__ __forceinline__ int map_row(int kind, int n0) {
    if (kind == 2) { if (n0 < DFF) return 256 * (n0 >> 7) + (n0 & 127); const int j = n0 - DFF; return 256 * (j >> 7) + 128 + (j & 127); }
    if (kind == 3) { if (n0 < DM) return n0; if (n0 < 2 * DM) { const int j = n0 - DM; return DM + 256 * (j >> 7) + (j & 127); } const int j = n0 - 2 * DM; return DM + 256 * (j >> 7) + 128 + (j & 127); }
    return n0;
}
__device__ __forceinline__ void p0_transpose_item(const float* __restrict__ W, int K, int N, int ldw, bf16* __restrict__ WT, int kind, const float* __restrict__ kscale, int item, int lane) {
    const int nblk = N / 64, kb = item / nblk, nb = item % nblk, k0 = 64 * kb, n0 = 64 * nb;
    const float ns = (kind == 1 && n0 < 1024) ? 0.0625f : 1.f;
    const float* src = W + (size_t)k0 * ldw + n0 + lane;
    float v[64];
#pragma unroll
    for (int i = 0; i < 64; ++i) v[i] = src[(size_t)i * ldw];
    bf16* dst = WT + (size_t)(map_row(kind, n0 & ~127) + (n0 & 127) + lane) * K + k0;
#pragma unroll
    for (int c = 0; c < 8; ++c) {
        float s[8];
#pragma unroll
        for (int e = 0; e < 8; ++e) s[e] = v[8 * c + e] * (kscale ? kscale[k0 + 8 * c + e] * ns : ns);
        v4u o; o.x = pk2(s[0], s[1]); o.y = pk2(s[2], s[3]); o.z = pk2(s[4], s[5]); o.w = pk2(s[6], s[7]);
        *(GAS v4u*)(dst + 8 * c) = o;
    }
}
__device__ __forceinline__ void p0_prologue(Frame& F) {
    const int gw = F.vcu * NWAVES + F.wave, NGW = F.G * NWAVES;
    float wgv[16];
#pragma unroll
    for (int i = 0; i < 16; ++i) { const int idx = F.tid + i * NWAVES * 64, k = idx >> 3, jg = idx & 7; wgv[i] = F.w_in[(size_t)k * NIN_SRC + NIN + jg] * F.norm_mix[k]; }
    constexpr int I0 = 16 * 64, I1 = 16 * 16, I2 = 16 * 88, I3 = 44 * 16, I4 = 16 * 48, I5 = 16 * 16, I6 = I2, I7 = I3;
    constexpr int NITEMS = I0 + I1 + I2 + I3 + I4 + I5 + I6 + I7;
    for (int it = gw; it < NITEMS; it += NGW) {
        int r = it;
        if (r < I0) { p0_transpose_item(F.w_in, DM, NIN, NIN_SRC, WSP(bf16, WS_W_IN), 1, F.norm_mix, r, F.lane); continue; } r -= I0;
        if (r < I1) { p0_transpose_item(F.w_out, DM, DM, DM, WSP(bf16, WS_W_OUT), 0, nullptr, r, F.lane); continue; } r -= I1;
        if (r < I2) { p0_transpose_item(F.w_gu, DM, NGU, NGU, WSP(bf16, WS_W_GU0), 2, F.norm_ffn, r, F.lane); continue; } r -= I2;
        if (r < I3) { p0_transpose_item(F.w_dn, DFF, DM, DM, WSP(bf16, WS_W_DN0), 0, nullptr, r, F.lane); continue; } r -= I3;
        if (r < I4) { p0_transpose_item(F.w_cin, DM, NCIN, NCIN, WSP(bf16, WS_W_CIN), 3, F.norm_mix + DM, r, F.lane); continue; } r -= I4;
        if (r < I5) { p0_transpose_item(F.w_cout, DM, DM, DM, WSP(bf16, WS_W_COUT), 0, nullptr, r, F.lane); continue; } r -= I5;
        if (r < I6) { p0_transpose_item(F.w_gu + (size_t)DM * NGU, DM, NGU, NGU, WSP(bf16, WS_W_GU1), 2, F.norm_ffn + DM, r, F.lane); continue; } r -= I6;
        p0_transpose_item(F.w_dn + (size_t)DFF * DM, DFF, DM, DM, WSP(bf16, WS_W_DN1), 0, nullptr, r, F.lane);
    }
    P0STAMP(20);
    __syncthreads();
    LAS float* WG = (LAS float*)(F.lds + RING_OFF);
#pragma unroll
    for (int i = 0; i < 16; ++i) { const int idx = F.tid + i * NWAVES * 64, k = idx >> 3, jg = idx & 7; WG[(((k >> 8) * 4 + (k & 3)) * 64 + ((k & 255) >> 2)) * 8 + jg] = wgv[i]; }
    __syncthreads();
    P0STAMP(21);
    { float* z = WSP(float, WS_SSQ) + (size_t)MT * 16;
      for (int i = F.vcu * NWAVES * 64 + F.tid; i < 3 * MS * 16; i += F.G * NWAVES * 64) { const int s = i / (MS * 16), o = i % (MS * 16); z[(size_t)s * MT * 16 + (size_t)MP * 16 + o] = 0.f; } }
    bf16* XB = WSP(bf16, WS_XB); float* SSQ0 = WSP(float, WS_SSQ); float* GATES = WSP(float, WS_GATES);
    const int lane = F.lane, gidx = 4 * ((lane >> 5) & 1) + 2 * ((lane >> 4) & 1) + ((lane >> 3) & 1);
    const float bg_l = F.b_gate[gidx];
    for (int row0 = gw; row0 < MT; row0 += 4 * NGW) {
        f32x4 v[4][4]; float s[4] = {0.f, 0.f, 0.f, 0.f};
#pragma unroll
        for (int rr = 0; rr < 4; ++rr) { const int row = row0 + rr * NGW; if (row < MT) { const float* xrow = row < MP ? F.xp + (size_t)row * DM : F.xs + (size_t)(row - MP) * DM; const GAS f32x4* xr = (const GAS f32x4*)xrow + lane;
#pragma unroll
                for (int j = 0; j < 4; ++j) v[rr][j] = xr[64 * j]; } else {
#pragma unroll
                for (int j = 0; j < 4; ++j) v[rr][j] = (f32x4){0.f, 0.f, 0.f, 0.f}; } }
#pragma unroll
        for (int rr = 0; rr < 4; ++rr) {
            const int row = row0 + rr * NGW; if (row >= MT) continue;
#pragma unroll
            for (int j = 0; j < 4; ++j) s[rr] += (v[rr][j].x * v[rr][j].x + v[rr][j].y * v[rr][j].y) + (v[rr][j].z * v[rr][j].z + v[rr][j].w * v[rr][j].w);
            const float ssq = wave_sum(s[rr]), r = rsqrtf(ssq * (1.f / 1024.f) + EPS);
            GAS unsigned long long* o8 = (GAS unsigned long long*)(XB + (size_t)row * DM) + lane;
#pragma unroll
            for (int j = 0; j < 4; ++j) o8[64 * j] = (unsigned long long)pk2(v[rr][j].x, v[rr][j].y) | ((unsigned long long)pk2(v[rr][j].z, v[rr][j].w) << 32);
            if (lane < 16) SSQ0[(size_t)row * 16 + lane] = lane == 0 ? ssq : 0.f;
            f32x4 ga = (f32x4){0.f, 0.f, 0.f, 0.f}, gb = ga;
#pragma unroll
            for (int j = 0; j < 4; ++j)
#pragma unroll
                for (int e = 0; e < 4; ++e) { const LAS float* wp = WG + ((j * 4 + e) * 64 + lane) * 8; const f32x4 w0 = *(const LAS f32x4*)wp, w1 = *(const LAS f32x4*)(wp + 4); ga += w0 * v[rr][j][e]; gb += w1 * v[rr][j][e]; }
            float t4[4], t2[2], t1;
#pragma unroll
            for (int i = 0; i < 4; ++i) { const float snd = (lane & 32) ? ga[i] : gb[i], kp = (lane & 32) ? gb[i] : ga[i]; t4[i] = kp + __shfl_xor(snd, 32); }
#pragma unroll
            for (int i = 0; i < 2; ++i) { const float snd = (lane & 16) ? t4[i] : t4[2 + i], kp = (lane & 16) ? t4[2 + i] : t4[i]; t2[i] = kp + __shfl_xor(snd, 16); }
            { const float snd = (lane & 8) ? t2[0] : t2[1], kp = (lane & 8) ? t2[1] : t2[0]; t1 = kp + __shfl_xor(snd, 8); }
            t1 += __shfl_xor(t1, 1); t1 += __shfl_xor(t1, 2); t1 += __shfl_xor(t1, 4);
            const float gate = t1 * r + bg_l;
            if ((lane & 7) == 0) GATES[(size_t)row * 8 + gidx] = gidx < 4 ? gate : logsigmoidf_(gate);
        }
    }
}

__device__ __forceinline__ void scan_oracle(Frame& F, const bool do_p, const bool do_s, const bool wr_p) {
    const bf16* QKVO = WSP(bf16, WS_QKVO); const float* GATES = WSP(float, WS_GATES); float* HBUF = WSP(float, WS_HBUF);
    constexpr int NU_P = NB_P * NH * 32, NU_S = NB_S * NH * 32;
    for (int un = F.vcu + (do_p ? 0 : NU_P); un < (do_s ? NU_P + NU_S : NU_P); un += F.G) {
        const bool smp = un >= NU_P; const int uu = smp ? un - NU_P : un; const int vg = uu & 31, h = (uu >> 5) & 3, b = uu >> 7;
        const int S = smp ? S_S : S_P, rowbase = smp ? MP + b * S_S : b * S_P;
        const int v = 8 * vg + F.wave, d0 = 4 * F.lane;
        f32x4 C = (f32x4){0.f, 0.f, 0.f, 0.f}, n = C; float m = 0.f;
        if (smp) { C = *(const f32x4*)(F.stC + ((size_t)(b * NH + h) * DV + v) * DK + d0); n = *(const f32x4*)(F.stN + (size_t)(b * NH + h) * DK + d0); m = F.stM[b * NH + h]; }
        for (int t0 = 0; t0 < S; t0 += 8) {
            v2u qw[8], kw[8]; unsigned short vw[8]; float li[8], lf[8];
#pragma unroll
            for (int i = 0; i < 8; ++i) { const size_t row = (size_t)(rowbase + t0 + i); const bf16* bp = QKVO + row * NIN + 256 * h;
                qw[i] = *(const v2u*)(bp + d0); kw[i] = *(const v2u*)(bp + 1024 + d0); vw[i] = bp[2048 + v]; li[i] = GATES[row * 8 + h]; lf[i] = GATES[row * 8 + 4 + h]; }
#pragma unroll
            for (int i = 0; i < 8; ++i) {
                const float mn = fmaxf(lf[i] + m, li[i]), a = expf(lf[i] + m - mn), wi = expf(li[i] - mn), vf = bf2f(vw[i]) * wi;
                const f32x4 kf = (f32x4){bflo(kw[i].x), bfhi(kw[i].x), bflo(kw[i].y), bfhi(kw[i].y)}, qf = (f32x4){bflo(qw[i].x), bfhi(qw[i].x), bflo(qw[i].y), bfhi(qw[i].y)};
                C = C * a + kf * vf; n = n * a + kf * wi;
                float num = (C.x * qf.x + C.y * qf.y) + (C.z * qf.z + C.w * qf.w), den = (n.x * qf.x + n.y * qf.y) + (n.z * qf.z + n.w * qf.w);
                num = wave_sum(num); den = wave_sum(den);
                const float hv = num / fmaxf(fabsf(den), expf(-mn));
                if (F.lane == 0) HBUF[(size_t)(rowbase + t0 + i) * DM + 256 * h + v] = hv;
                m = mn;
            }
        }
        if (!smp && !wr_p) continue;
        float* Co = F.out + (smp ? O_CS : O_CP) + ((size_t)(b * NH + h) * DV + v) * DK + d0; *(f32x4*)Co = C;
        if (vg == 0 && F.wave == 0) { *(f32x4*)(F.out + (smp ? O_NS : O_NP) + (size_t)(b * NH + h) * DK + d0) = n; if (F.lane == 0) F.out[(smp ? O_MS : O_MP) + b * NH + h] = m; }
    }
}
__device__ __forceinline__ void gate_pass(Frame& F, const int row_lo, const int row_hi) {
    const bf16* QKVO = WSP(bf16, WS_QKVO); const float* HBUF = WSP(float, WS_HBUF); bf16* A2 = WSP(bf16, WS_A2);
    const int gw = F.vcu * NWAVES + F.wave, NGW = F.G * NWAVES;
    for (int row = row_lo + gw; row < row_hi; row += NGW) {
        const f32x4* hr = (const f32x4*)(HBUF + (size_t)row * DM) + F.lane; const v2u* orow = (const v2u*)(QKVO + (size_t)row * NIN + 3072) + F.lane; const f32x4* gr = (const f32x4*)F.head_norm + F.lane;
        v2u* o8 = (v2u*)(A2 + (size_t)row * DM) + F.lane;
#pragma unroll
        for (int j = 0; j < 4; ++j) { const f32x4 hv = hr[64 * j], g = gr[64 * j]; const v2u ow = orow[64 * j];
            const float ss = wave_sum((hv.x * hv.x + hv.y * hv.y) + (hv.z * hv.z + hv.w * hv.w)), rn = rsqrtf(ss * (1.f / 256.f) + EPS);
            v2u w; w.x = pk2(hv.x * rn * g.x * sigmoidf_(bflo(ow.x)), hv.y * rn * g.y * sigmoidf_(bfhi(ow.x))); w.y = pk2(hv.z * rn * g.z * sigmoidf_(bflo(ow.y)), hv.w * rn * g.w * sigmoidf_(bfhi(ow.y)));
            o8[64 * j] = w; }
    }
}
__device__ __forceinline__ void unpack8(const v4u w, float (&f)[8]) { f[0] = bflo(w.x); f[1] = bfhi(w.x); f[2] = bflo(w.y); f[3] = bfhi(w.y); f[4] = bflo(w.z); f[5] = bfhi(w.z); f[6] = bflo(w.w); f[7] = bfhi(w.w); }
__device__ __forceinline__ void conv_pass(Frame& F) {
    const bf16* __restrict__ BG = WSP(bf16, WS_BG); const bf16* __restrict__ U = WSP(bf16, WS_U); bf16* __restrict__ A2 = WSP(bf16, WS_A2);
    const int gw = F.vcu * NWAVES + F.wave, NGW = F.G * NWAVES;
    float tw[3][2][8];
#pragma unroll
    for (int k = 0; k < 3; ++k)
#pragma unroll
        for (int j = 0; j < 2; ++j) { const f32x4 a = *(const f32x4*)(F.w_taps + k * DM + 8 * F.lane + 512 * j), c = *(const f32x4*)(F.w_taps + k * DM + 8 * F.lane + 512 * j + 4);
            tw[k][j][0] = a.x; tw[k][j][1] = a.y; tw[k][j][2] = a.z; tw[k][j][3] = a.w; tw[k][j][4] = c.x; tw[k][j][5] = c.y; tw[k][j][6] = c.z; tw[k][j][7] = c.w; }
    for (int blk = gw; blk < MT / 4; blk += NGW) {
        const int r0 = 4 * blk; const bool smp = r0 >= MP; const int t0 = smp ? (r0 - MP) & (S_S - 1) : r0 & (S_P - 1), bq = smp ? (r0 - MP) >> 3 : r0 >> 11;
        float p2[2][8], p1[2][8];
        v4u uc[4][2], bgw[4][2];
#pragma unroll
        for (int i = 0; i < 4; ++i)
#pragma unroll
            for (int j = 0; j < 2; ++j) { uc[i][j] = *(const v4u*)(U + (size_t)(r0 + i) * DM + 8 * F.lane + 512 * j); bgw[i][j] = *(const v4u*)(BG + (size_t)(r0 + i) * DM + 8 * F.lane + 512 * j); }
#pragma unroll
        for (int j = 0; j < 2; ++j) {
            if (t0 >= 2) { unpack8(*(const v4u*)(U + (size_t)(r0 - 2) * DM + 8 * F.lane + 512 * j), p2[j]); unpack8(*(const v4u*)(U + (size_t)(r0 - 1) * DM + 8 * F.lane + 512 * j), p1[j]); }
            else if (smp) { const float* sb = F.stConv + (size_t)bq * 2 * DM + 8 * F.lane + 512 * j; const f32x4 a0 = *(const f32x4*)sb, a1 = *(const f32x4*)(sb + 4), c0 = *(const f32x4*)(sb + DM), c1 = *(const f32x4*)(sb + DM + 4);
                p2[j][0] = a0.x; p2[j][1] = a0.y; p2[j][2] = a0.z; p2[j][3] = a0.w; p2[j][4] = a1.x; p2[j][5] = a1.y; p2[j][6] = a1.z; p2[j][7] = a1.w;
                p1[j][0] = c0.x; p1[j][1] = c0.y; p1[j][2] = c0.z; p1[j][3] = c0.w; p1[j][4] = c1.x; p1[j][5] = c1.y; p1[j][6] = c1.z; p1[j][7] = c1.w; }
            else {
#pragma unroll
                for (int e = 0; e < 8; ++e) { p2[j][e] = 0.f; p1[j][e] = 0.f; } }
        }
#pragma unroll
        for (int i = 0; i < 4; ++i)
#pragma unroll
            for (int j = 0; j < 2; ++j) { float cur[8], bg[8], y[8]; unpack8(uc[i][j], cur); unpack8(bgw[i][j], bg);
#pragma unroll
                for (int e = 0; e < 8; ++e) { y[e] = bg[e] * (tw[0][j][e] * p2[j][e] + tw[1][j][e] * p1[j][e] + tw[2][j][e] * cur[e]); p2[j][e] = p1[j][e]; p1[j][e] = cur[e]; }
                v4u o; o.x = pk2(y[0], y[1]); o.y = pk2(y[2], y[3]); o.z = pk2(y[4], y[5]); o.w = pk2(y[6], y[7]);
                *(v4u*)(A2 + (size_t)(r0 + i) * DM + 8 * F.lane + 512 * j) = o; }
    }
}
__device__ __forceinline__ void final_norm(Frame& F) {
    const bf16* __restrict__ XB = WSP(bf16, WS_XB);
    const int gw = F.vcu * NWAVES + F.wave, NGW = F.G * NWAVES;
    for (int row0 = gw; row0 < MT; row0 += 2 * NGW) {
        v2u xw[2][4];
#pragma unroll
        for (int rr = 0; rr < 2; ++rr) { const int row = row0 + rr * NGW < MT ? row0 + rr * NGW : row0;
#pragma unroll
            for (int j = 0; j < 4; ++j) xw[rr][j] = ((const v2u*)(XB + (size_t)row * DM) + F.lane)[64 * j]; }
#pragma unroll
        for (int rr = 0; rr < 2; ++rr) { const int row = row0 + rr * NGW; if (row >= MT) continue;
            f32x4 v[4]; float s = 0.f;
#pragma unroll
            for (int j = 0; j < 4; ++j) { v[j] = (f32x4){bflo(xw[rr][j].x), bfhi(xw[rr][j].x), bflo(xw[rr][j].y), bfhi(xw[rr][j].y)}; s += (v[j].x * v[j].x + v[j].y * v[j].y) + (v[j].z * v[j].z + v[j].w * v[j].w); }
            const float r = rsqrtf(wave_sum(s) * (1.f / 1024.f) + EPS);
            GAS f32x4* xo = (GAS f32x4*)(F.out + O_Y + (size_t)row * DM) + F.lane; const f32x4* gr = (const f32x4*)F.norm_final + F.lane;
#pragma unroll
            for (int j = 0; j < 4; ++j) xo[64 * j] = v[j] * r * gr[64 * j]; }
    }
}

typedef float f32x4v __attribute__((ext_vector_type(4)));
#define MFMA16(a, b, c) __builtin_amdgcn_mfma_f32_16x16x32_bf16((a), (b), (c), 0, 0, 0)
__device__ __forceinline__ float scan_sum(float v, int lane) {
#pragma unroll
    for (int o = 1; o < 64; o <<= 1) { const float t = __shfl_up(v, o); if (lane >= o) v += t; }
    return v;
}
__device__ __forceinline__ float scan_max(float v, int lane) {
#pragma unroll
    for (int o = 1; o < 64; o <<= 1) { const float t = __shfl_up(v, o); if (lane >= o) v = fmaxf(v, t); }
    return v;
}
__device__ __forceinline__ float wave_max(float v) {
#pragma unroll
    for (int o = 1; o < 64; o <<= 1) v = fmaxf(v, __shfl_xor(v, o));
    return v;
}
__device__ __forceinline__ unsigned img_off(unsigned row, unsigned ch) { return row * 512u + ((ch ^ (row & 15u)) << 4); }
__device__ __forceinline__ void dma_tile128(LAS unsigned char* buf, const bf16* gsrc, size_t ld, int wave, int lane) {
#pragma unroll
    for (int i = 0; i < 8; ++i) { const int p = wave * 8 + i, row = 2 * p + (lane >> 5), ch = (lane & 31) ^ (row & 15);
        __builtin_amdgcn_global_load_lds((const unsigned*)(gsrc + (size_t)row * ld + ch * 8), (LAS unsigned*)(buf + p * 1024), 16, 0, 0); }
}
__device__ __forceinline__ bf16x8 tr_frag(unsigned a0, unsigned a1) {
    v2u lo, hi;
    asm volatile("ds_read_b64_tr_b16 %0, %2\n\tds_read_b64_tr_b16 %1, %3\n\ts_waitcnt lgkmcnt(0)" : "=&v"(lo), "=&v"(hi) : "v"(a0), "v"(a1) : "memory");
    v4u r; r.x = lo.x; r.y = lo.y; r.z = hi.x; r.w = hi.y; return __builtin_bit_cast(bf16x8, r);
}
__device__ __forceinline__ bf16x8 pack_f8(const f32x4 a, const f32x4 b) { v4u r; r.x = pk2(a.x, a.y); r.y = pk2(a.z, a.w); r.z = pk2(b.x, b.y); r.w = pk2(b.z, b.w); return __builtin_bit_cast(bf16x8, r); }
__device__ __forceinline__ f32x4 bf4_to_f(const v2u w) { return (f32x4){bflo(w.x), bfhi(w.x), bflo(w.y), bfhi(w.y)}; }

__device__ __forceinline__ void s1_state_pass(Frame& F) {
    const bf16* QKVO = WSP(bf16, WS_QKVO); const float* GATES = WSP(float, WS_GATES);
    bf16* CST = WSP(bf16, WS_CST); float* NST = WSP(float, WS_NST); float* MST = WSP(float, WS_MST);
    LAS unsigned char* VP = F.lds + SCR_OFF;
    LAS float* WGS = (LAS float*)(F.lds + SCR_OFF + 8192);
    LAS float* SC = (LAS float*)(F.lds + SCR_OFF + 8192 + 1024);
    const int lane = F.lane, wave = F.wave, g = lane >> 4, q = (lane & 15) >> 2, p = lane & 3;
    const unsigned ldsK = (unsigned)(size_t)F.lds, ldsV = (unsigned)(size_t)VP;
    for (int un = F.vcu; un < NB_P * NH * 8; un += F.G) {
        const int vs = un & 7, h = (un >> 3) & 3, b = un >> 5, bh = b * NH + h;
        f32x4 acc[2][2], nacc[2];
#pragma unroll
        for (int i = 0; i < 2; ++i) { nacc[i] = (f32x4){0.f, 0.f, 0.f, 0.f};
#pragma unroll
            for (int j = 0; j < 2; ++j) acc[i][j] = (f32x4){0.f, 0.f, 0.f, 0.f}; }
        float m_run = 0.f;
        __syncthreads();
        dma_tile128(F.lds, QKVO + (size_t)(b * S_P) * NIN + 1024 + 256 * h, NIN, wave, lane);
        for (int c = 0; c < 16; ++c) {
            const int r0 = b * S_P + 128 * c, par = c & 1;
            if (wave == 0) {
                const float li0 = GATES[(size_t)(r0 + lane) * 8 + h], li1 = GATES[(size_t)(r0 + 64 + lane) * 8 + h], lf0 = GATES[(size_t)(r0 + lane) * 8 + 4 + h], lf1 = GATES[(size_t)(r0 + 64 + lane) * 8 + 4 + h];
                const float b0 = scan_sum(lf0, lane), b1 = scan_sum(lf1, lane) + __shfl(b0, 63), bL = __shfl(b1, 63);
                const float g0 = bL - b0 + li0, g1 = bL - b1 + li1, mx = wave_max(fmaxf(g0, g1));
                const float m_new = fmaxf(bL + m_run, mx), a = expf(bL + m_run - m_new);
                WGS[par * 128 + lane] = expf(g0 - m_new); WGS[par * 128 + 64 + lane] = expf(g1 - m_new);
                if (lane == 0) { SC[par * 4] = a; SC[par * 4 + 1] = m_new; if (vs == 0) MST[bh * 16 + c] = m_run; }
                m_run = m_new;
            }
            const int vl = F.tid >> 2, vp = F.tid & 3;
            const v4u vraw = *(const v4u*)(QKVO + (size_t)(r0 + vl) * NIN + 2048 + 256 * h + 32 * vs + 8 * vp);
            VM_WAIT(); __syncthreads();
            { const float wg = WGS[par * 128 + vl];
              v4u o; o.x = pk2(bflo(vraw.x) * wg, bfhi(vraw.x) * wg); o.y = pk2(bflo(vraw.y) * wg, bfhi(vraw.y) * wg); o.z = pk2(bflo(vraw.z) * wg, bfhi(vraw.z) * wg); o.w = pk2(bflo(vraw.w) * wg, bfhi(vraw.w) * wg);
              *(LAS v4u*)(VP + vl * 64 + vp * 16) = o; }
            if (c >= 1) {
                bf16* cp = CST + ((size_t)(bh * 16 + c) * DV + 32 * vs + (lane & 15)) * DK + 32 * wave + 4 * g;
#pragma unroll
                for (int dt = 0; dt < 2; ++dt)
#pragma unroll
                    for (int vt = 0; vt < 2; ++vt) { v2u w; w.x = pk2(acc[dt][vt].x, acc[dt][vt].y); w.y = pk2(acc[dt][vt].z, acc[dt][vt].w); *(v2u*)(cp + (size_t)(16 * vt) * DK + 16 * dt) = w; }
                if (vs == 0 && (lane & 15) == 0) {
#pragma unroll
                    for (int dt = 0; dt < 2; ++dt) *(f32x4*)(NST + (size_t)(bh * 16 + c) * DK + 32 * wave + 16 * dt + 4 * g) = nacc[dt]; }
            }
            __syncthreads();
            if (c + 1 < 16) dma_tile128(F.lds + ((c + 1) & 1) * 65536, QKVO + (size_t)(r0 + 128) * NIN + 1024 + 256 * h, NIN, wave, lane);
            const float a = SC[par * 4];
#pragma unroll
            for (int i = 0; i < 2; ++i) { nacc[i] = nacc[i] * a;
#pragma unroll
                for (int j = 0; j < 2; ++j) acc[i][j] = acc[i][j] * a; }
            const unsigned kb = ldsK + par * 65536;
#pragma unroll
            for (int kl = 0; kl < 4; ++kl) {
                const unsigned ra = 32 * kl + 8 * g + q, rb = ra + 4;
                bf16x8 Af[2], Bf[2];
#pragma unroll
                for (int dt = 0; dt < 2; ++dt) Af[dt] = tr_frag(kb + img_off(ra, 4 * wave + 2 * dt + (p >> 1)) + 8 * (p & 1), kb + img_off(rb, 4 * wave + 2 * dt + (p >> 1)) + 8 * (p & 1));
#pragma unroll
                for (int vt = 0; vt < 2; ++vt) Bf[vt] = tr_frag(ldsV + ra * 64 + (16 * vt + 4 * p) * 2, ldsV + rb * 64 + (16 * vt + 4 * p) * 2);
#pragma unroll
                for (int dt = 0; dt < 2; ++dt)
#pragma unroll
                    for (int vt = 0; vt < 2; ++vt) acc[dt][vt] = MFMA16(Af[dt], Bf[vt], acc[dt][vt]);
                if (vs == 0) {
                    const f32x4 w0 = *(const LAS f32x4*)(WGS + par * 128 + 32 * kl + 8 * g), w1 = *(const LAS f32x4*)(WGS + par * 128 + 32 * kl + 8 * g + 4);
                    bf16x8 b2 = pack_f8(w0, w1); if ((lane & 15) != 0) b2 = (bf16x8){0, 0, 0, 0, 0, 0, 0, 0};
#pragma unroll
                    for (int dt = 0; dt < 2; ++dt) nacc[dt] = MFMA16(Af[dt], b2, nacc[dt]);
                }
            }
        }
        float* co = F.out + O_CP + ((size_t)bh * DV + 32 * vs + (lane & 15)) * DK + 32 * wave + 4 * g;
#pragma unroll
        for (int dt = 0; dt < 2; ++dt)
#pragma unroll
            for (int vt = 0; vt < 2; ++vt) *(f32x4*)(co + (size_t)(16 * vt) * DK + 16 * dt) = acc[dt][vt];
        if (vs == 0) {
            if ((lane & 15) == 0) {
#pragma unroll
                for (int dt = 0; dt < 2; ++dt) *(f32x4*)(F.out + O_NP + (size_t)bh * DK + 32 * wave + 16 * dt + 4 * g) = nacc[dt]; }
            if (wave == 0 && lane == 0) F.out[O_MP + bh] = m_run;
        }
    }
}

template <int VT>
__device__ __forceinline__ void s2_h_step(f32x4& acc, const unsigned base, const bf16x8 (&Sf)[4]) {
    constexpr int HI = (VT >> 3) * 256;
    v2u r0, r1, r2, r3, r4, r5, r6, r7;
    asm volatile("ds_read_b64_tr_b16 %0, %8 offset:%9\n\tds_read_b64_tr_b16 %1, %8 offset:%10\n\tds_read_b64_tr_b16 %2, %8 offset:%11\n\tds_read_b64_tr_b16 %3, %8 offset:%12\n\t"
                 "ds_read_b64_tr_b16 %4, %8 offset:%13\n\tds_read_b64_tr_b16 %5, %8 offset:%14\n\tds_read_b64_tr_b16 %6, %8 offset:%15\n\tds_read_b64_tr_b16 %7, %8 offset:%16\n\ts_waitcnt lgkmcnt(0)"
                 : "=&v"(r0), "=&v"(r1), "=&v"(r2), "=&v"(r3), "=&v"(r4), "=&v"(r5), "=&v"(r6), "=&v"(r7)
                 : "v"(base), "i"(HI), "i"(HI + 8192), "i"(HI + 16384), "i"(HI + 24576), "i"(HI + 32768), "i"(HI + 40960), "i"(HI + 49152), "i"(HI + 57344) : "memory");
    v4u f;
    f.x = r0.x; f.y = r0.y; f.z = r1.x; f.w = r1.y; acc = MFMA16(__builtin_bit_cast(bf16x8, f), Sf[0], acc);
    f.x = r2.x; f.y = r2.y; f.z = r3.x; f.w = r3.y; acc = MFMA16(__builtin_bit_cast(bf16x8, f), Sf[1], acc);
    f.x = r4.x; f.y = r4.y; f.z = r5.x; f.w = r5.y; acc = MFMA16(__builtin_bit_cast(bf16x8, f), Sf[2], acc);
    f.x = r6.x; f.y = r6.y; f.z = r7.x; f.w = r7.y; acc = MFMA16(__builtin_bit_cast(bf16x8, f), Sf[3], acc);
}

#if TS_PROBE >= 0
#define S2STAMP(i) do { if (blockIdx.x == 8 && F.tid == 0 && un == F.vcu) ((unsigned long long*)(F.ctl + 2048))[(i)] = __builtin_amdgcn_s_memrealtime(); } while (0)
#else
#define S2STAMP(i) do { } while (0)
#endif
__device__ __forceinline__ void s2_output_pass(Frame& F) {
    const bf16* QKVO = WSP(bf16, WS_QKVO); const float* GATES = WSP(float, WS_GATES);
    const bf16* CST = WSP(bf16, WS_CST); const float* NST = WSP(float, WS_NST); const float* MST = WSP(float, WS_MST); bf16* A2 = WSP(bf16, WS_A2);
    LAS float* ZS = (LAS float*)(F.lds + SCR_OFF); LAS float* LM = ZS + 128; LAS float* LW = ZS + 256; LAS float* LE = ZS + 384; LAS float* NS = ZS + 512; LAS float* HN = ZS + 768;
    LAS unsigned char* bufA = F.lds; LAS unsigned char* bufB = F.lds + 65536;
    const int wave = F.wave;
    const unsigned ldsB = (unsigned)(size_t)bufB;
    for (int un = F.vcu; un < NB_P * NH * 16; un += F.G) {
        int lane = F.lane; asm volatile("" : "+v"(lane));
        const int g = lane >> 4, q = (lane & 15) >> 2, p = lane & 3, li_ = lane & 15;
        const int c = un & 15, h = (un >> 4) & 3, b = un >> 6, bh = b * NH + h, r0 = b * S_P + 128 * c;
        const bf16* Kg = QKVO + (size_t)r0 * NIN + 1024 + 256 * h; const bf16* Vg = QKVO + (size_t)r0 * NIN + 2048 + 256 * h;
        __syncthreads();
        S2STAMP(29);
        if (c) { const bf16* Cg = CST + (size_t)(bh * 16 + c) * DV * DK; dma_tile128(bufA, Cg, DK, wave, lane); dma_tile128(bufB, Cg + (size_t)128 * DK, DK, wave, lane); }
        else { dma_tile128(bufA, Kg, NIN, wave, lane); dma_tile128(bufB, Vg, NIN, wave, lane); }
        if (F.tid < 128) { const f32x4 gv = WSP(f32x4, WS_GV)[(size_t)(r0 + F.tid) * 4 + h]; ZS[F.tid] = gv.x; LM[F.tid] = gv.y; LW[F.tid] = gv.z; LE[F.tid] = gv.w; }
        if (F.tid >= 128 && F.tid < 192) *(LAS f32x4*)(HN + 4 * (F.tid - 128)) = *(const f32x4*)(F.head_norm + 256 * h + 4 * (F.tid - 128));
        if (F.tid < 64) *(LAS f32x4*)(NS + 4 * F.tid) = c ? *(const f32x4*)(NST + (size_t)(bh * 16 + c) * DK + 4 * F.tid) : (f32x4){0.f, 0.f, 0.f, 0.f};
        int lrow = 16 * wave + li_; asm volatile("" : "+v"(lrow));
        const size_t row = (size_t)(r0 + lrow);
        bf16x8 Qf[8];
#pragma unroll
        for (int kd = 0; kd < 8; ++kd) Qf[kd] = *(const bf16x8*)(QKVO + row * NIN + 256 * h + 32 * kd + 8 * g);
        f32x4 acc[16];
#pragma unroll
        for (int vt = 0; vt < 16; ++vt) acc[vt] = (f32x4){0.f, 0.f, 0.f, 0.f};
        VM_WAIT(); __syncthreads();
        S2STAMP(30);
        if (c) {
#pragma unroll
            for (int vt = 0; vt < 8; ++vt) {
#pragma unroll
                for (int kd = 0; kd < 8; ++kd) acc[vt] = MFMA16(*(const LAS bf16x8*)(bufA + img_off(16 * vt + li_, 4 * kd + g)), Qf[kd], acc[vt]);
                __builtin_amdgcn_sched_barrier(0); }
#pragma unroll
            for (int vt = 0; vt < 8; ++vt) {
#pragma unroll
                for (int kd = 0; kd < 8; ++kd) acc[8 + vt] = MFMA16(*(const LAS bf16x8*)(bufB + img_off(16 * vt + li_, 4 * kd + g)), Qf[kd], acc[8 + vt]);
                __builtin_amdgcn_sched_barrier(0); }
            __syncthreads();
            S2STAMP(31);
            dma_tile128(bufA, Kg, NIN, wave, lane); dma_tile128(bufB, Vg, NIN, wave, lane);
            const float wl = LW[lrow];
#pragma unroll
            for (int vt = 0; vt < 16; ++vt) acc[vt] = acc[vt] * wl;
            VM_WAIT(); __syncthreads();
            S2STAMP(32);
        }
        float gn = 0.f;
#pragma unroll
        for (int kd = 0; kd < 8; ++kd) { const v4u qw = __builtin_bit_cast(v4u, Qf[kd]); const f32x4 n0 = *(const LAS f32x4*)(NS + 32 * kd + 8 * g), n1 = *(const LAS f32x4*)(NS + 32 * kd + 8 * g + 4);
            gn += (bflo(qw.x) * n0.x + bfhi(qw.x) * n0.y) + (bflo(qw.y) * n0.z + bfhi(qw.y) * n0.w) + (bflo(qw.z) * n1.x + bfhi(qw.z) * n1.y) + (bflo(qw.w) * n1.z + bfhi(qw.w) * n1.w); }
        gn += __shfl_xor(gn, 16); gn += __shfl_xor(gn, 32);
        v2u ovr[16];
        { const bf16* ob = QKVO + row * NIN + 3072 + 256 * h + 4 * g;
#pragma unroll
          for (int vt = 0; vt < 16; ++vt) ovr[vt] = *(const v2u*)(ob + 16 * vt); }
        const float Ml = LM[lrow]; float dsum = 0.f;
        bf16x8 Sf[4];
#pragma unroll
        for (int ks = 0; ks < 4; ++ks) {
            f32x4 sa = (f32x4){0.f, 0.f, 0.f, 0.f}, sb = sa;
#pragma unroll
            for (int kd = 0; kd < 8; ++kd) { sa = MFMA16(*(const LAS bf16x8*)(bufA + img_off(32 * ks + li_, 4 * kd + g)), Qf[kd], sa); sb = MFMA16(*(const LAS bf16x8*)(bufA + img_off(32 * ks + 16 + li_, 4 * kd + g)), Qf[kd], sb);
                if (kd & 1) __builtin_amdgcn_sched_barrier(0); }
            const f32x4 za = *(const LAS f32x4*)(ZS + 32 * ks + 4 * g), zb = *(const LAS f32x4*)(ZS + 32 * ks + 16 + 4 * g);
#pragma unroll
            for (int r = 0; r < 4; ++r) { const int da = lrow - (32 * ks + 4 * g + r);
                sa[r] = __builtin_bit_cast(float, __builtin_bit_cast(unsigned, sa[r] * __expf(za[r] - Ml)) & ~(unsigned)(da >> 31));
                sb[r] = __builtin_bit_cast(float, __builtin_bit_cast(unsigned, sb[r] * __expf(zb[r] - Ml)) & ~(unsigned)((da - 16) >> 31)); dsum += sa[r] + sb[r]; }
            Sf[ks] = pack_f8(sa, sb);
            __builtin_amdgcn_sched_barrier(0);
        }
        dsum += __shfl_xor(dsum, 16); dsum += __shfl_xor(dsum, 32);
        {
            unsigned hb[8];
#pragma unroll
            for (int j = 0; j < 8; ++j) hb[j] = ldsB + img_off(4 * g + q, 2 * j + (p >> 1)) + 8 * (p & 1);
            s2_h_step<0>(acc[0], hb[0], Sf); s2_h_step<1>(acc[1], hb[1], Sf); s2_h_step<2>(acc[2], hb[2], Sf); s2_h_step<3>(acc[3], hb[3], Sf);
            s2_h_step<4>(acc[4], hb[4], Sf); s2_h_step<5>(acc[5], hb[5], Sf); s2_h_step<6>(acc[6], hb[6], Sf); s2_h_step<7>(acc[7], hb[7], Sf);
            s2_h_step<8>(acc[8], hb[0], Sf); s2_h_step<9>(acc[9], hb[1], Sf); s2_h_step<10>(acc[10], hb[2], Sf); s2_h_step<11>(acc[11], hb[3], Sf);
            s2_h_step<12>(acc[12], hb[4], Sf); s2_h_step<13>(acc[13], hb[5], Sf); s2_h_step<14>(acc[14], hb[6], Sf); s2_h_step<15>(acc[15], hb[7], Sf);
        }
        S2STAMP(33);
        __builtin_amdgcn_sched_barrier(0);
        const float den = LW[lrow] * gn + dsum, inv = __builtin_amdgcn_rcpf(fmaxf(fabsf(den), LE[lrow]));
        float ssq = 0.f;
#pragma unroll
        for (int vt = 0; vt < 16; ++vt) { acc[vt] = acc[vt] * inv; ssq += (acc[vt].x * acc[vt].x + acc[vt].y * acc[vt].y) + (acc[vt].z * acc[vt].z + acc[vt].w * acc[vt].w); }
        ssq += __shfl_xor(ssq, 16); ssq += __shfl_xor(ssq, 32);
        const float rn = rsqrtf(ssq * (1.f / 256.f) + EPS);
        { bf16* ab = A2 + row * DM + 256 * h + 4 * g;
#pragma unroll
        for (int vt = 0; vt < 16; ++vt) {
            const f32x4 ov = bf4_to_f(ovr[vt]), gh = *(const LAS f32x4*)(HN + 16 * vt + 4 * g) * rn;
            const f32x4 sg = (f32x4){__builtin_amdgcn_rcpf(1.f + __expf(-ov.x)), __builtin_amdgcn_rcpf(1.f + __expf(-ov.y)), __builtin_amdgcn_rcpf(1.f + __expf(-ov.z)), __builtin_amdgcn_rcpf(1.f + __expf(-ov.w))};
            const f32x4 o = acc[vt] * gh * sg;
            v2u w; w.x = pk2(o.x, o.y); w.y = pk2(o.z, o.w);
            *(v2u*)(ab + 16 * vt) = w;
            if ((vt & 3) == 3) __builtin_amdgcn_sched_barrier(0); } }
        S2STAMP(34);
    }
}

__device__ __forceinline__ void s3_sample_pass(Frame& F, const int u_first, const int u_step) {
    const bf16* QKVO = WSP(bf16, WS_QKVO); const float* GATES = WSP(float, WS_GATES); bf16* A2 = WSP(bf16, WS_A2);
    LAS float* GP = (LAS float*)F.lds;
    LAS float* VW = (LAS float*)(F.lds + 65536);
    LAS float* SCS = (LAS float*)(F.lds + SCR_OFF);
    const int lane = F.lane, wave = F.wave, g = lane >> 4, li_ = lane & 15;
    for (int un = u_first; un < NB_S * NH; un += u_step) {
        const int h = un & 3, b = un >> 2, bh = b * NH + h, r0 = MP + S_S * b;
        __syncthreads();
        if (wave == 0) {
            const bool ok = lane < S_S; const int rr = r0 + (lane & 7);
            const float li = GATES[(size_t)rr * 8 + h], lf = ok ? GATES[(size_t)rr * 8 + 4 + h] : 0.f, m0 = F.stM[bh];
            const float bc = scan_sum(lf, lane), z = ok ? li - bc : -INFINITY, pm = scan_max(z, lane), M = fmaxf(m0, pm), bL = __shfl(bc, S_S - 1);
            const float gq = ok ? bL - bc + li : -INFINITY, mx = wave_max(gq), m_new = fmaxf(bL + m0, mx), a = expf(bL + m0 - m_new);
            if (ok) { SCS[lane] = z; SCS[8 + lane] = M; SCS[16 + lane] = expf(m0 - M); SCS[24 + lane] = expf(-(bc + M)); SCS[32 + lane] = expf(gq - m_new); }
            if (lane == 0) { SCS[40] = a; SCS[41] = m_new; F.out[O_MS + bh] = m_new; }
        }
        __syncthreads();
        { const int l = F.tid >> 6, v0 = 4 * (F.tid & 63); const float wg = SCS[32 + l];
          const f32x4 vv = bf4_to_f(*(const v2u*)(QKVO + (size_t)(r0 + l) * NIN + 2048 + 256 * h + v0)); *(LAS f32x4*)(VW + l * 256 + v0) = vv * wg; }
        float kk[8][8];
#pragma unroll
        for (int l = 0; l < 8; ++l) { const v4u w = *(const v4u*)(QKVO + (size_t)(r0 + l) * NIN + 1024 + 256 * h + 32 * wave + 8 * g);
            kk[l][0] = bflo(w.x); kk[l][1] = bfhi(w.x); kk[l][2] = bflo(w.y); kk[l][3] = bfhi(w.y); kk[l][4] = bflo(w.z); kk[l][5] = bfhi(w.z); kk[l][6] = bflo(w.w); kk[l][7] = bfhi(w.w); }
        bf16x8 Qa = (bf16x8){0, 0, 0, 0, 0, 0, 0, 0};
        if (li_ < 8) Qa = *(const bf16x8*)(QKVO + (size_t)(r0 + li_) * NIN + 256 * h + 32 * wave + 8 * g);
        __syncthreads();
        const float a = SCS[40];
        const float* cin = F.stC + ((size_t)bh * DV + li_) * DK + 32 * wave + 8 * g; float* cout = F.out + O_CS + ((size_t)bh * DV + li_) * DK + 32 * wave + 8 * g;
#pragma unroll 8
        for (int vb = 0; vb < 16; ++vb) {
            const f32x4 c0 = *(const f32x4*)(cin + (size_t)(16 * vb) * DK), c1 = *(const f32x4*)(cin + (size_t)(16 * vb) * DK + 4);
            const f32x4 gp = MFMA16(Qa, pack_f8(c0, c1), ((f32x4){0.f, 0.f, 0.f, 0.f}));
            if (g < 2) {
#pragma unroll
                for (int r = 0; r < 4; ++r) GP[(wave * 8 + 4 * g + r) * 256 + 16 * vb + li_] = gp[r]; }
            f32x4 n0 = c0 * a, n1 = c1 * a;
#pragma unroll
            for (int l = 0; l < 8; ++l) { const float vw = VW[l * 256 + 16 * vb + li_];
                n0.x += vw * kk[l][0]; n0.y += vw * kk[l][1]; n0.z += vw * kk[l][2]; n0.w += vw * kk[l][3]; n1.x += vw * kk[l][4]; n1.y += vw * kk[l][5]; n1.z += vw * kk[l][6]; n1.w += vw * kk[l][7]; }
            *(f32x4*)(cout + (size_t)(16 * vb) * DK) = n0; *(f32x4*)(cout + (size_t)(16 * vb) * DK + 4) = n1;
        }
        __syncthreads();
        {
            const int l = wave; const size_t row = (size_t)(r0 + l);
            f32x4 G = (f32x4){0.f, 0.f, 0.f, 0.f};
#pragma unroll
            for (int w2 = 0; w2 < 8; ++w2) G += *(const LAS f32x4*)(GP + (w2 * 8 + l) * 256 + 4 * lane);
            const f32x4 qv = bf4_to_f(*(const v2u*)(QKVO + row * NIN + 256 * h + 4 * lane));
            const f32x4 n0v = *(const f32x4*)(F.stN + (size_t)bh * DK + 4 * lane);
            const float gn = wave_sum((n0v.x * qv.x + n0v.y * qv.y) + (n0v.z * qv.z + n0v.w * qv.w));
            const float Ml = SCS[8 + l], wl = SCS[16 + l], el = SCS[24 + l];
            f32x4 num = G * wl; float dsum = 0.f;
#pragma unroll
            for (int s = 0; s < 8; ++s) { const f32x4 kv = bf4_to_f(*(const v2u*)(QKVO + (size_t)(r0 + s) * NIN + 1024 + 256 * h + 4 * lane));
                const float qk = wave_sum((kv.x * qv.x + kv.y * qv.y) + (kv.z * qv.z + kv.w * qv.w));
                const float sd = (s <= l) ? qk * __expf(SCS[s] - Ml) : 0.f;
                const f32x4 vv = bf4_to_f(*(const v2u*)(QKVO + (size_t)(r0 + s) * NIN + 2048 + 256 * h + 4 * lane));
                num += vv * sd; dsum += sd; }
            const float den = wl * gn + dsum, inv = 1.f / fmaxf(fabsf(den), el);
            const f32x4 hv = num * inv;
            const float rn = rsqrtf(wave_sum((hv.x * hv.x + hv.y * hv.y) + (hv.z * hv.z + hv.w * hv.w)) * (1.f / 256.f) + EPS);
            const int v0 = 256 * h + 4 * lane;
            const f32x4 ov = bf4_to_f(*(const v2u*)(QKVO + row * NIN + 3072 + v0)), gh = *(const f32x4*)(F.head_norm + v0);
            v2u w; w.x = pk2(hv.x * rn * gh.x * sigmoidf_(ov.x), hv.y * rn * gh.y * sigmoidf_(ov.y)); w.y = pk2(hv.z * rn * gh.z * sigmoidf_(ov.z), hv.w * rn * gh.w * sigmoidf_(ov.w));
            *(v2u*)(A2 + row * DM + v0) = w;
            if (wave == 0) {
                f32x4 nn = n0v * a;
#pragma unroll
                for (int s = 0; s < 8; ++s) { const f32x4 kv = bf4_to_f(*(const v2u*)(QKVO + (size_t)(r0 + s) * NIN + 1024 + 256 * h + 4 * lane)); nn += kv * SCS[32 + s]; }
                *(f32x4*)(F.out + O_NS + (size_t)bh * DK + 4 * lane) = nn;
            }
        }
    }
}
template <int KL>
__device__ __forceinline__ void s1b_kstep(f32x4 (&acc)[2][4], f32x4 (&nacc)[2], const unsigned k00, const unsigned k01, const unsigned k10, const unsigned k11, const unsigned vb, const bf16x8 b2, const bool do_n) {
    v2u a00, a01, a10, a11;
    asm volatile("ds_read_b64_tr_b16 %0, %4 offset:%8\n\tds_read_b64_tr_b16 %1, %5 offset:%8\n\tds_read_b64_tr_b16 %2, %6 offset:%8\n\tds_read_b64_tr_b16 %3, %7 offset:%8\n\ts_waitcnt lgkmcnt(0)"
                 : "=&v"(a00), "=&v"(a01), "=&v"(a10), "=&v"(a11) : "v"(k00), "v"(k01), "v"(k10), "v"(k11), "i"(KL * 16384) : "memory");
    v2u b0l, b0h, b1l, b1h, b2l, b2h, b3l, b3h;
    asm volatile("ds_read_b64_tr_b16 %0, %8 offset:%9\n\tds_read_b64_tr_b16 %1, %8 offset:%10\n\tds_read_b64_tr_b16 %2, %8 offset:%11\n\tds_read_b64_tr_b16 %3, %8 offset:%12\n\t"
                 "ds_read_b64_tr_b16 %4, %8 offset:%13\n\tds_read_b64_tr_b16 %5, %8 offset:%14\n\tds_read_b64_tr_b16 %6, %8 offset:%15\n\tds_read_b64_tr_b16 %7, %8 offset:%16\n\ts_waitcnt lgkmcnt(0)"
                 : "=&v"(b0l), "=&v"(b0h), "=&v"(b1l), "=&v"(b1h), "=&v"(b2l), "=&v"(b2h), "=&v"(b3l), "=&v"(b3h)
                 : "v"(vb), "i"(KL * 4096), "i"(KL * 4096 + 512), "i"(KL * 4096 + 32), "i"(KL * 4096 + 32 + 512), "i"(KL * 4096 + 64), "i"(KL * 4096 + 64 + 512), "i"(KL * 4096 + 96), "i"(KL * 4096 + 96 + 512) : "memory");
    v4u t;
    t.x = a00.x; t.y = a00.y; t.z = a10.x; t.w = a10.y; const bf16x8 A0 = __builtin_bit_cast(bf16x8, t);
    t.x = a01.x; t.y = a01.y; t.z = a11.x; t.w = a11.y; const bf16x8 A1 = __builtin_bit_cast(bf16x8, t);
    t.x = b0l.x; t.y = b0l.y; t.z = b0h.x; t.w = b0h.y; const bf16x8 B0 = __builtin_bit_cast(bf16x8, t);
    t.x = b1l.x; t.y = b1l.y; t.z = b1h.x; t.w = b1h.y; const bf16x8 B1 = __builtin_bit_cast(bf16x8, t);
    t.x = b2l.x; t.y = b2l.y; t.z = b2h.x; t.w = b2h.y; const bf16x8 B2 = __builtin_bit_cast(bf16x8, t);
    t.x = b3l.x; t.y = b3l.y; t.z = b3h.x; t.w = b3h.y; const bf16x8 B3 = __builtin_bit_cast(bf16x8, t);
    acc[0][0] = MFMA16(A0, B0, acc[0][0]); acc[0][1] = MFMA16(A0, B1, acc[0][1]); acc[0][2] = MFMA16(A0, B2, acc[0][2]); acc[0][3] = MFMA16(A0, B3, acc[0][3]);
    acc[1][0] = MFMA16(A1, B0, acc[1][0]); acc[1][1] = MFMA16(A1, B1, acc[1][1]); acc[1][2] = MFMA16(A1, B2, acc[1][2]); acc[1][3] = MFMA16(A1, B3, acc[1][3]);
    if (do_n) { nacc[0] = MFMA16(A0, b2, nacc[0]); nacc[1] = MFMA16(A1, b2, nacc[1]); }
}
__device__ __forceinline__ void s1b_state_pass(Frame& F, const int u_first, const int u_step) {
    const bf16* QKVO = WSP(bf16, WS_QKVO); const float* GATES = WSP(float, WS_GATES);
    bf16* CST = WSP(bf16, WS_CST); float* NST = WSP(float, WS_NST); f32x4* GV = WSP(f32x4, WS_GV);
    LAS unsigned char* VP = F.lds + SCR_OFF;
    LAS float* WGA = (LAS float*)(F.lds + SCR_OFF + 16384);
    LAS float* ACH = (LAS float*)(F.lds + SCR_OFF + 16384 + 8192);
    const int wave = F.wave;
    const unsigned ldsK = (unsigned)(size_t)F.lds, ldsV = (unsigned)(size_t)VP;
    for (int un = u_first; un < NB_P * NH * 4; un += u_step) {
        int lane = F.lane; asm volatile("" : "+v"(lane));
        const int g = lane >> 4, q = (lane & 15) >> 2, p = lane & 3;
        const int vq = un & 3, h = (un >> 2) & 3, b = un >> 4, bh = b * NH + h;
        __syncthreads();
        dma_tile128(F.lds, QKVO + (size_t)(b * S_P) * NIN + 1024 + 256 * h, NIN, wave, lane);
        if (wave == 0) {
            float li[16][2], lf[16][2];
#pragma unroll
            for (int c = 0; c < 16; ++c)
#pragma unroll
                for (int k = 0; k < 2; ++k) { const size_t row = (size_t)(b * S_P + 128 * c + 64 * k + lane); li[c][k] = GATES[row * 8 + h]; lf[c][k] = GATES[row * 8 + 4 + h]; }
            float m_run = 0.f;
#pragma unroll
            for (int c = 0; c < 16; ++c) {
                const float b0 = scan_sum(lf[c][0], lane), b1 = scan_sum(lf[c][1], lane) + __shfl(b0, 63), bL = __shfl(b1, 63);
                const float g0 = bL - b0 + li[c][0], g1 = bL - b1 + li[c][1], mx = wave_max(fmaxf(g0, g1));
                const float m_new = fmaxf(bL + m_run, mx);
                WGA[128 * c + lane] = expf(g0 - m_new); WGA[128 * c + 64 + lane] = expf(g1 - m_new);
                if (lane == 0) ACH[c] = expf(bL + m_run - m_new);
                if (vq == 0) {
                    const float z0 = li[c][0] - b0, z1 = li[c][1] - b1, p0 = scan_max(z0, lane), p1 = fmaxf(scan_max(z1, lane), __shfl(p0, 63));
                    const float M0 = fmaxf(m_run, p0), M1 = fmaxf(m_run, p1);
                    const size_t row = (size_t)(b * S_P + 128 * c + lane);
                    GV[row * 4 + h] = (f32x4){z0, M0, expf(m_run - M0), expf(-(b0 + M0))}; GV[(row + 64) * 4 + h] = (f32x4){z1, M1, expf(m_run - M1), expf(-(b1 + M1))};
                }
                m_run = m_new;
            }
            if (vq == 0 && lane == 0) F.out[O_MP + bh] = m_run;
        }
        const int vl = F.tid >> 2, vp = F.tid & 3;
        const bf16* vsrc = QKVO + (size_t)(b * S_P + vl) * NIN + 2048 + 256 * h + 64 * vq + 16 * vp;
        v4u v0 = *(const v4u*)vsrc, v1 = *(const v4u*)(vsrc + 8);
        f32x4 acc[2][4], nacc[2];
#pragma unroll
        for (int i = 0; i < 2; ++i) { nacc[i] = (f32x4){0.f, 0.f, 0.f, 0.f};
#pragma unroll
            for (int j = 0; j < 4; ++j) acc[i][j] = (f32x4){0.f, 0.f, 0.f, 0.f}; }
        for (int c = 0; c < 16; ++c) {
            const int par = c & 1;
            VM_WAIT(); __syncthreads();
            { const float wg = WGA[128 * c + vl];
              v4u o; o.x = pk2(bflo(v0.x) * wg, bfhi(v0.x) * wg); o.y = pk2(bflo(v0.y) * wg, bfhi(v0.y) * wg); o.z = pk2(bflo(v0.z) * wg, bfhi(v0.z) * wg); o.w = pk2(bflo(v0.w) * wg, bfhi(v0.w) * wg);
              *(LAS v4u*)(VP + vl * 128 + vp * 32) = o;
              o.x = pk2(bflo(v1.x) * wg, bfhi(v1.x) * wg); o.y = pk2(bflo(v1.y) * wg, bfhi(v1.y) * wg); o.z = pk2(bflo(v1.z) * wg, bfhi(v1.z) * wg); o.w = pk2(bflo(v1.w) * wg, bfhi(v1.w) * wg);
              *(LAS v4u*)(VP + vl * 128 + vp * 32 + 16) = o; }
            if (c >= 1) {
                bf16* cp = CST + ((size_t)(bh * 16 + c) * DV + 64 * vq + (lane & 15)) * DK + 32 * wave + 4 * g;
#pragma unroll
                for (int dt = 0; dt < 2; ++dt)
#pragma unroll
                    for (int vt = 0; vt < 4; ++vt) { v2u w; w.x = pk2(acc[dt][vt].x, acc[dt][vt].y); w.y = pk2(acc[dt][vt].z, acc[dt][vt].w); *(v2u*)(cp + (size_t)(16 * vt) * DK + 16 * dt) = w; }
                if (vq == 0 && (lane & 15) == 0) {
#pragma unroll
                    for (int dt = 0; dt < 2; ++dt) *(f32x4*)(NST + (size_t)(bh * 16 + c) * DK + 32 * wave + 16 * dt + 4 * g) = nacc[dt]; }
            }
            __syncthreads();
            if (c + 1 < 16) { dma_tile128(F.lds + ((c + 1) & 1) * 65536, QKVO + (size_t)(b * S_P + 128 * (c + 1)) * NIN + 1024 + 256 * h, NIN, wave, lane);
                              v0 = *(const v4u*)(vsrc + (size_t)(128 * (c + 1)) * NIN); v1 = *(const v4u*)(vsrc + (size_t)(128 * (c + 1)) * NIN + 8); }
            const float a = ACH[c];
#pragma unroll
            for (int i = 0; i < 2; ++i) { nacc[i] = nacc[i] * a;
#pragma unroll
                for (int j = 0; j < 4; ++j) acc[i][j] = acc[i][j] * a; }
            const unsigned kb = ldsK + par * 65536;
            const unsigned k00 = kb + img_off(8 * g + q, 4 * wave + (p >> 1)) + 8 * (p & 1), k01 = kb + img_off(8 * g + q, 4 * wave + 2 + (p >> 1)) + 8 * (p & 1);
            const unsigned k10 = kb + img_off(8 * g + q + 4, 4 * wave + (p >> 1)) + 8 * (p & 1), k11 = kb + img_off(8 * g + q + 4, 4 * wave + 2 + (p >> 1)) + 8 * (p & 1);
            const unsigned vb = ldsV + (8 * g + q) * 128 + 8 * p;
            const bool do_n = (vq == 0);
            bf16x8 b2[4];
#pragma unroll
            for (int kl = 0; kl < 4; ++kl) { b2[kl] = (bf16x8){0, 0, 0, 0, 0, 0, 0, 0};
                if (do_n && (lane & 15) == 0) b2[kl] = pack_f8(*(const LAS f32x4*)(WGA + 128 * c + 32 * kl + 8 * g), *(const LAS f32x4*)(WGA + 128 * c + 32 * kl + 8 * g + 4)); }
            s1b_kstep<0>(acc, nacc, k00, k01, k10, k11, vb, b2[0], do_n); s1b_kstep<1>(acc, nacc, k00, k01, k10, k11, vb, b2[1], do_n);
            s1b_kstep<2>(acc, nacc, k00, k01, k10, k11, vb, b2[2], do_n); s1b_kstep<3>(acc, nacc, k00, k01, k10, k11, vb, b2[3], do_n);
        }
        float* co = F.out + O_CP + ((size_t)bh * DV + 64 * vq + (lane & 15)) * DK + 32 * wave + 4 * g;
#pragma unroll
        for (int dt = 0; dt < 2; ++dt)
#pragma unroll
            for (int vt = 0; vt < 4; ++vt) *(f32x4*)(co + (size_t)(16 * vt) * DK + 16 * dt) = acc[dt][vt];
        if (vq == 0 && (lane & 15) == 0) {
#pragma unroll
            for (int dt = 0; dt < 2; ++dt) *(f32x4*)(F.out + O_NP + (size_t)bh * DK + 32 * wave + 16 * dt + 4 * g) = nacc[dt]; }
    }
}
__device__ __forceinline__ void s3b_sample_pass(Frame& F, const int u_first, const int u_step) {
    const bf16* QKVO = WSP(bf16, WS_QKVO); const float* GATES = WSP(float, WS_GATES); bf16* A2 = WSP(bf16, WS_A2);
    LAS float* GP = (LAS float*)F.lds;
    LAS unsigned char* VWB = F.lds + 65536;
    LAS float* SCS = (LAS float*)(F.lds + SCR_OFF);
    const int wave = F.wave;
    for (int un = u_first; un < NB_S * NH; un += u_step) {
        int lane = F.lane; asm volatile("" : "+v"(lane));
        const int g = lane >> 4, li_ = lane & 15;
        const int h = un & 3, b = un >> 2, bh = b * NH + h, r0 = MP + S_S * b;
        const float* __restrict__ cin = F.stC + ((size_t)bh * DV + li_) * DK + 32 * wave + 4 * g; float* __restrict__ cout = F.out + O_CS + ((size_t)bh * DV + li_) * DK + 32 * wave + 4 * g;
        f32x4 cr[16][2];
#pragma unroll
        for (int vb = 0; vb < 16; ++vb) { cr[vb][0] = __builtin_nontemporal_load((const f32x4*)(cin + (size_t)(16 * vb) * DK)); cr[vb][1] = __builtin_nontemporal_load((const f32x4*)(cin + (size_t)(16 * vb) * DK + 16)); }
        const bool ok = lane < S_S; const int rr = r0 + (lane & 7);
        float gli = 0.f, glf = 0.f, gm0 = 0.f;
        if (wave == 0) { gli = GATES[(size_t)rr * 8 + h]; glf = ok ? GATES[(size_t)rr * 8 + 4 + h] : 0.f; gm0 = F.stM[bh]; }
        bf16x8 Qa = (bf16x8){0, 0, 0, 0, 0, 0, 0, 0};
        if (li_ < 8) { const bf16* qp = QKVO + (size_t)(r0 + li_) * NIN + 256 * h + 32 * wave + 4 * g; const v2u q0 = *(const v2u*)qp, q1 = *(const v2u*)(qp + 16); v4u t; t.x = q0.x; t.y = q0.y; t.z = q1.x; t.w = q1.y; Qa = __builtin_bit_cast(bf16x8, t); }
        bf16x8 Ak[2];
#pragma unroll
        for (int dt = 0; dt < 2; ++dt) { Ak[dt] = (bf16x8){0, 0, 0, 0, 0, 0, 0, 0};
            if (g == 0) { const bf16* kp = QKVO + (size_t)r0 * NIN + 1024 + 256 * h + 32 * wave + 16 * dt + li_;
#pragma unroll
                for (int l = 0; l < 8; ++l) Ak[dt][l] = (short)kp[(size_t)l * NIN]; } }
        const int vwv = F.tid >> 1, vwh = F.tid & 1; const bf16* vwp = QKVO + (size_t)(r0 + 4 * vwh) * NIN + 2048 + 256 * h + vwv;
        const unsigned short vw0 = vwp[0], vw1 = vwp[NIN], vw2 = vwp[2 * NIN], vw3 = vwp[3 * NIN];
        const size_t frow = (size_t)(r0 + wave);
        const v2u fq = *(const v2u*)(QKVO + frow * NIN + 256 * h + 4 * lane), fo = *(const v2u*)(QKVO + frow * NIN + 3072 + 256 * h + 4 * lane);
        const f32x4 n0v = *(const f32x4*)(F.stN + (size_t)bh * DK + 4 * lane);
        v2u fk[8], fv[8];
#pragma unroll
        for (int s2 = 0; s2 < 8; ++s2) { fk[s2] = *(const v2u*)(QKVO + (size_t)(r0 + s2) * NIN + 1024 + 256 * h + 4 * lane); fv[s2] = *(const v2u*)(QKVO + (size_t)(r0 + s2) * NIN + 2048 + 256 * h + 4 * lane); }
        __syncthreads();
        if (wave == 0) {
            const float li = gli, lf = glf, m0 = gm0;
            const float bc = scan_sum(lf, lane), z = ok ? li - bc : -INFINITY, pm = scan_max(z, lane), M = fmaxf(m0, pm), bL = __shfl(bc, S_S - 1);
            const float gq = ok ? bL - bc + li : -INFINITY, mx = wave_max(gq), m_new = fmaxf(bL + m0, mx), a = expf(bL + m0 - m_new);
            if (ok) { SCS[lane] = z; SCS[8 + lane] = M; SCS[16 + lane] = expf(m0 - M); SCS[24 + lane] = expf(-(bc + M)); SCS[32 + lane] = expf(gq - m_new); }
            if (lane == 0) { SCS[40] = a; SCS[41] = m_new; F.out[O_MS + bh] = m_new; }
        }
        __syncthreads();
        { v2u w; w.x = pk2(bf2f(vw0) * SCS[32 + 4 * vwh], bf2f(vw1) * SCS[33 + 4 * vwh]); w.y = pk2(bf2f(vw2) * SCS[34 + 4 * vwh], bf2f(vw3) * SCS[35 + 4 * vwh]);
          *(LAS v2u*)(VWB + vwv * 16 + vwh * 8) = w; }
        __syncthreads();
        const float a = SCS[40];
#pragma unroll
        for (int vb = 0; vb < 16; ++vb) {
            const f32x4 gp = MFMA16(Qa, pack_f8(cr[vb][0], cr[vb][1]), ((f32x4){0.f, 0.f, 0.f, 0.f}));
            if (g < 2) {
#pragma unroll
                for (int r = 0; r < 4; ++r) GP[(wave * 8 + 4 * g + r) * 256 + 16 * vb + li_] = gp[r]; }
            bf16x8 bvw = (bf16x8){0, 0, 0, 0, 0, 0, 0, 0};
            if (g == 0) bvw = *(const LAS bf16x8*)(VWB + (16 * vb + li_) * 16);
            const f32x4 n0 = MFMA16(Ak[0], bvw, cr[vb][0] * a), n1 = MFMA16(Ak[1], bvw, cr[vb][1] * a);
            __builtin_nontemporal_store(n0, (f32x4*)(cout + (size_t)(16 * vb) * DK)); __builtin_nontemporal_store(n1, (f32x4*)(cout + (size_t)(16 * vb) * DK + 16));
        }
        __syncthreads();
        {
            const int l = wave; const size_t row = (size_t)(r0 + l);
            f32x4 G = (f32x4){0.f, 0.f, 0.f, 0.f};
#pragma unroll
            for (int w2 = 0; w2 < 8; ++w2) G += *(const LAS f32x4*)(GP + (w2 * 8 + l) * 256 + 4 * lane);
            const f32x4 qv = bf4_to_f(fq);
            f32x4 kv[8], vv[8];
#pragma unroll
            for (int s2 = 0; s2 < 8; ++s2) { kv[s2] = bf4_to_f(fk[s2]); vv[s2] = bf4_to_f(fv[s2]); }
            const float gn = wave_sum((n0v.x * qv.x + n0v.y * qv.y) + (n0v.z * qv.z + n0v.w * qv.w));
            const float Ml = SCS[8 + l], wl = SCS[16 + l], el = SCS[24 + l];
            f32x4 num = G * wl; float dsum = 0.f;
#pragma unroll
            for (int s = 0; s < 8; ++s) { const float qk = wave_sum((kv[s].x * qv.x + kv[s].y * qv.y) + (kv[s].z * qv.z + kv[s].w * qv.w));
                const float sd = (s <= l) ? qk * __expf(SCS[s] - Ml) : 0.f; num += vv[s] * sd; dsum += sd; }
            const float den = wl * gn + dsum, inv = 1.f / fmaxf(fabsf(den), el);
            const f32x4 hv = num * inv;
            const float rn = rsqrtf(wave_sum((hv.x * hv.x + hv.y * hv.y) + (hv.z * hv.z + hv.w * hv.w)) * (1.f / 256.f) + EPS);
            const int v0 = 256 * h + 4 * lane;
            const f32x4 ov = bf4_to_f(fo), gh = *(const f32x4*)(F.head_norm + v0);
            v2u w; w.x = pk2(hv.x * rn * gh.x * sigmoidf_(ov.x), hv.y * rn * gh.y * sigmoidf_(ov.y)); w.y = pk2(hv.z * rn * gh.z * sigmoidf_(ov.z), hv.w * rn * gh.w * sigmoidf_(ov.w));
            *(v2u*)(A2 + row * DM + v0) = w;
            if (wave == 0) {
                f32x4 nn = n0v * a;
#pragma unroll
                for (int s = 0; s < 8; ++s) nn += kv[s] * SCS[32 + s];
                *(f32x4*)(F.out + O_NS + (size_t)bh * DK + 4 * lane) = nn;
            }
        }
    }
}
__device__ __forceinline__ bf16x8 scale_frag(const v2u lo, const v2u hi, const f32x4 w0, const f32x4 w1) {
    v4u r; r.x = pk2(bflo(lo.x) * w0.x, bfhi(lo.x) * w0.y); r.y = pk2(bflo(lo.y) * w0.z, bfhi(lo.y) * w0.w); r.z = pk2(bflo(hi.x) * w1.x, bfhi(hi.x) * w1.y); r.w = pk2(bflo(hi.y) * w1.z, bfhi(hi.y) * w1.w);
    return __builtin_bit_cast(bf16x8, r);
}
template <int KL>
__device__ __forceinline__ void s1c_kstep(f32x4 (&acc)[2][4], f32x4 (&nacc)[2], const unsigned k00, const unsigned k01, const unsigned k10, const unsigned k11, const unsigned vb, const LAS float* wgp, const bf16x8 ones, const bool do_n) {
    v2u a00, a01, a10, a11;
    asm volatile("ds_read_b64_tr_b16 %0, %4 offset:%8\n\tds_read_b64_tr_b16 %1, %5 offset:%8\n\tds_read_b64_tr_b16 %2, %6 offset:%8\n\tds_read_b64_tr_b16 %3, %7 offset:%8\n\ts_waitcnt lgkmcnt(0)"
                 : "=&v"(a00), "=&v"(a01), "=&v"(a10), "=&v"(a11) : "v"(k00), "v"(k01), "v"(k10), "v"(k11), "i"(KL * 16384) : "memory");
    v2u b0l, b0h, b1l, b1h, b2l, b2h, b3l, b3h;
    asm volatile("ds_read_b64_tr_b16 %0, %8 offset:%9\n\tds_read_b64_tr_b16 %1, %8 offset:%10\n\tds_read_b64_tr_b16 %2, %8 offset:%11\n\tds_read_b64_tr_b16 %3, %8 offset:%12\n\t"
                 "ds_read_b64_tr_b16 %4, %8 offset:%13\n\tds_read_b64_tr_b16 %5, %8 offset:%14\n\tds_read_b64_tr_b16 %6, %8 offset:%15\n\tds_read_b64_tr_b16 %7, %8 offset:%16\n\ts_waitcnt lgkmcnt(0)"
                 : "=&v"(b0l), "=&v"(b0h), "=&v"(b1l), "=&v"(b1h), "=&v"(b2l), "=&v"(b2h), "=&v"(b3l), "=&v"(b3h)
                 : "v"(vb), "i"(KL * 4096), "i"(KL * 4096 + 512), "i"(KL * 4096 + 32), "i"(KL * 4096 + 32 + 512), "i"(KL * 4096 + 64), "i"(KL * 4096 + 64 + 512), "i"(KL * 4096 + 96), "i"(KL * 4096 + 96 + 512) : "memory");
    const f32x4 w0 = *(const LAS f32x4*)(wgp + 32 * KL), w1 = *(const LAS f32x4*)(wgp + 32 * KL + 4);
    const bf16x8 A0 = scale_frag(a00, a10, w0, w1), A1 = scale_frag(a01, a11, w0, w1);
    v4u t;
    t.x = b0l.x; t.y = b0l.y; t.z = b0h.x; t.w = b0h.y; const bf16x8 B0 = __builtin_bit_cast(bf16x8, t);
    t.x = b1l.x; t.y = b1l.y; t.z = b1h.x; t.w = b1h.y; const bf16x8 B1 = __builtin_bit_cast(bf16x8, t);
    t.x = b2l.x; t.y = b2l.y; t.z = b2h.x; t.w = b2h.y; const bf16x8 B2 = __builtin_bit_cast(bf16x8, t);
    t.x = b3l.x; t.y = b3l.y; t.z = b3h.x; t.w = b3h.y; const bf16x8 B3 = __builtin_bit_cast(bf16x8, t);
    acc[0][0] = MFMA16(A0, B0, acc[0][0]); acc[0][1] = MFMA16(A0, B1, acc[0][1]); acc[0][2] = MFMA16(A0, B2, acc[0][2]); acc[0][3] = MFMA16(A0, B3, acc[0][3]);
    acc[1][0] = MFMA16(A1, B0, acc[1][0]); acc[1][1] = MFMA16(A1, B1, acc[1][1]); acc[1][2] = MFMA16(A1, B2, acc[1][2]); acc[1][3] = MFMA16(A1, B3, acc[1][3]);
    if (do_n) { nacc[0] = MFMA16(A0, ones, nacc[0]); nacc[1] = MFMA16(A1, ones, nacc[1]); }
}
constexpr int S1C_SLOT = 40960;
__device__ __forceinline__ void s1c_stage(LAS unsigned char* slot, const bf16* kg, const bf16* vg, int wave, int lane) {
#pragma unroll
    for (int i = 0; i < 4; ++i) { const int p = wave + 8 * i, row = 2 * p + (lane >> 5), ch = (lane & 31) ^ (row & 15);
        __builtin_amdgcn_global_load_lds((const unsigned*)(kg + (size_t)row * NIN + ch * 8), (LAS unsigned*)(slot + p * 1024), 16, 0, 0); }
    { const int row = 8 * wave + (lane >> 3); __builtin_amdgcn_global_load_lds((const unsigned*)(vg + (size_t)row * NIN + 8 * (lane & 7)), (LAS unsigned*)(slot + 32768 + wave * 1024), 16, 0, 0); }
}
__device__ __forceinline__ void s1c_state_pass(Frame& F, const int u_first, const int u_step) {
    const bf16* QKVO = WSP(bf16, WS_QKVO); const float* GATES = WSP(float, WS_GATES);
    bf16* CST = WSP(bf16, WS_CST); float* NST = WSP(float, WS_NST); f32x4* GV = WSP(f32x4, WS_GV);
    LAS float* WGA = (LAS float*)(F.lds + 3 * S1C_SLOT);
    LAS float* ACH = (LAS float*)(F.lds + SCR_OFF);
    const int wave = F.wave;
    const unsigned ldsK = (unsigned)(size_t)F.lds;
    for (int un = u_first; un < NB_P * NH * 4; un += u_step) {
        int lane = F.lane; asm volatile("" : "+v"(lane));
        const int g = lane >> 4, q = (lane & 15) >> 2, p = lane & 3;
        const int vq = un & 3, h = (un >> 2) & 3, b = un >> 4, bh = b * NH + h;
        const bf16* kg0 = QKVO + (size_t)(b * S_P) * NIN + 1024 + 256 * h; const bf16* vg0 = QKVO + (size_t)(b * S_P) * NIN + 2048 + 256 * h + 64 * vq;
        asm volatile("s_waitcnt vmcnt(0)" ::: "memory"); __syncthreads();
        s1c_stage(F.lds, kg0, vg0, wave, lane); s1c_stage(F.lds + S1C_SLOT, kg0 + (size_t)64 * NIN, vg0 + (size_t)64 * NIN, wave, lane);
        {
            LAS float* BLS = ACH + 16; LAS float* MXS = ACH + 32; LAS float* MSS = ACH + 48; LAS float* MNS = ACH + 64;
            float gq[2][2], zq[2][2], pq[2][2], bq[2][2];
#pragma unroll
            for (int cc = 0; cc < 2; ++cc) { const int c = 2 * wave + cc; const size_t row = (size_t)(b * S_P + 128 * c + lane);
                const float li0 = GATES[row * 8 + h], li1 = GATES[(row + 64) * 8 + h], lf0 = GATES[row * 8 + 4 + h], lf1 = GATES[(row + 64) * 8 + 4 + h];
                const float b0 = scan_sum(lf0, lane), b1 = scan_sum(lf1, lane) + __shfl(b0, 63), bL = __shfl(b1, 63);
                gq[cc][0] = bL - b0 + li0; gq[cc][1] = bL - b1 + li1; const float mx = wave_max(fmaxf(gq[cc][0], gq[cc][1]));
                if (lane == 0) { BLS[c] = bL; MXS[c] = mx; }
                zq[cc][0] = li0 - b0; zq[cc][1] = li1 - b1; bq[cc][0] = b0; bq[cc][1] = b1;
                pq[cc][0] = scan_max(zq[cc][0], lane); pq[cc][1] = fmaxf(scan_max(zq[cc][1], lane), __shfl(pq[cc][0], 63)); }
            asm volatile("s_waitcnt vmcnt(0)" ::: "memory");
            __syncthreads();
            if (wave == 0 && lane == 0) { float m_run = 0.f;
                for (int c = 0; c < 16; ++c) { const float m_new = fmaxf(BLS[c] + m_run, MXS[c]); MSS[c] = m_run; MNS[c] = m_new; ACH[c] = expf(BLS[c] + m_run - m_new); m_run = m_new; }
                if (vq == 0) F.out[O_MP + bh] = m_run; }
            __syncthreads();
#pragma unroll
            for (int cc = 0; cc < 2; ++cc) { const int c = 2 * wave + cc; const float m_new = MNS[c], m_st = MSS[c];
                WGA[128 * c + lane] = expf(gq[cc][0] - m_new); WGA[128 * c + 64 + lane] = expf(gq[cc][1] - m_new);
                if (vq == 0) { const float M0 = fmaxf(m_st, pq[cc][0]), M1 = fmaxf(m_st, pq[cc][1]); const size_t row = (size_t)(b * S_P + 128 * c + lane);
                    GV[row * 4 + h] = (f32x4){zq[cc][0], M0, expf(m_st - M0), expf(-(bq[cc][0] + M0))}; GV[(row + 64) * 4 + h] = (f32x4){zq[cc][1], M1, expf(m_st - M1), expf(-(bq[cc][1] + M1))}; } }
            P0STAMP(23);
        }
        f32x4 acc[2][4], nacc[2];
#pragma unroll
        for (int i = 0; i < 2; ++i) { nacc[i] = (f32x4){0.f, 0.f, 0.f, 0.f};
#pragma unroll
            for (int j = 0; j < 4; ++j) acc[i][j] = (f32x4){0.f, 0.f, 0.f, 0.f}; }
        v4u ot; ot.x = ot.y = ot.z = ot.w = ((lane & 15) == 0) ? 0x3F803F80u : 0u; const bf16x8 ones = __builtin_bit_cast(bf16x8, ot);
        const bool do_n = (vq == 0);
        for (int sc = 0; sc < 32; ++sc) {
            const int c = sc >> 1;
            if (sc + 1 < 32) asm volatile("s_waitcnt vmcnt(5)" ::: "memory"); else asm volatile("s_waitcnt vmcnt(0)" ::: "memory");
            __builtin_amdgcn_s_barrier(); asm volatile("" ::: "memory");
            if ((sc & 1) == 0) {
                if (c >= 1) {
                    bf16* cp = CST + ((size_t)(bh * 16 + c) * DV + 64 * vq + (lane & 15)) * DK + 32 * wave + 4 * g;
#pragma unroll
                    for (int dt = 0; dt < 2; ++dt)
#pragma unroll
                        for (int vt = 0; vt < 4; ++vt) { v2u w; w.x = pk2(acc[dt][vt].x, acc[dt][vt].y); w.y = pk2(acc[dt][vt].z, acc[dt][vt].w); *(v2u*)(cp + (size_t)(16 * vt) * DK + 16 * dt) = w; }
                    if (do_n && (lane & 15) == 0) {
#pragma unroll
                        for (int dt = 0; dt < 2; ++dt) *(f32x4*)(NST + (size_t)(bh * 16 + c) * DK + 32 * wave + 16 * dt + 4 * g) = nacc[dt]; }
                }
            }
            if (sc + 2 < 32) s1c_stage(F.lds + ((sc + 2) % 3) * S1C_SLOT, kg0 + (size_t)(64 * (sc + 2)) * NIN, vg0 + (size_t)(64 * (sc + 2)) * NIN, wave, lane);
            if ((sc & 1) == 0) { const float a = ACH[c];
#pragma unroll
                for (int i = 0; i < 2; ++i) { nacc[i] = nacc[i] * a;
#pragma unroll
                    for (int j = 0; j < 4; ++j) acc[i][j] = acc[i][j] * a; } }
            const unsigned kb = ldsK + (sc % 3) * S1C_SLOT;
            const unsigned k00 = kb + img_off(8 * g + q, 4 * wave + (p >> 1)) + 8 * (p & 1), k01 = kb + img_off(8 * g + q, 4 * wave + 2 + (p >> 1)) + 8 * (p & 1);
            const unsigned k10 = kb + img_off(8 * g + q + 4, 4 * wave + (p >> 1)) + 8 * (p & 1), k11 = kb + img_off(8 * g + q + 4, 4 * wave + 2 + (p >> 1)) + 8 * (p & 1);
            const unsigned vb = kb + 32768 + (8 * g + q) * 128 + 8 * p;
            const LAS float* wgp = WGA + 64 * sc + 8 * g;
            s1c_kstep<0>(acc, nacc, k00, k01, k10, k11, vb, wgp, ones, do_n); s1c_kstep<1>(acc, nacc, k00, k01, k10, k11, vb, wgp, ones, do_n);
            asm volatile("" ::: "memory");
        }
        float* co = F.out + O_CP + ((size_t)bh * DV + 64 * vq + (lane & 15)) * DK + 32 * wave + 4 * g;
#pragma unroll
        for (int dt = 0; dt < 2; ++dt)
#pragma unroll
            for (int vt = 0; vt < 4; ++vt) *(f32x4*)(co + (size_t)(16 * vt) * DK + 16 * dt) = acc[dt][vt];
        if (do_n && (lane & 15) == 0) {
#pragma unroll
            for (int dt = 0; dt < 2; ++dt) *(f32x4*)(F.out + O_NP + (size_t)bh * DK + 32 * wave + 16 * dt + 4 * g) = nacc[dt]; }
    }
}
constexpr int S2R_SLOT = 32768;
__device__ __forceinline__ void s2r_stage(LAS unsigned char* slot, const bf16* src, size_t pitch, int wave, int lane) {
#pragma unroll
    for (int i = 0; i < 4; ++i) { const int p = wave + 8 * i, row = 2 * p + (lane >> 5), ch = (lane & 31) ^ (row & 15);
        __builtin_amdgcn_global_load_lds((const unsigned*)(src + (size_t)row * pitch + ch * 8), (LAS unsigned*)(slot + p * 1024), 16, 0, 0); }
}
__device__ __forceinline__ void s2r_stage_sub(Frame& F, LAS unsigned char* slot, int un, int ss, int wave, int lane) {
    const int c = un & 15, h = (un >> 4) & 3, b = un >> 6, bh = b * NH + h, r0 = b * S_P + 128 * c, k = c ? ss : ss + 4;
    const bf16* QKVO = WSP(bf16, WS_QKVO);
    if (k < 4) s2r_stage(slot, WSP(bf16, WS_CST) + ((size_t)(bh * 16 + c) * DV + 64 * k) * DK, DK, wave, lane);
    else if (k < 6) s2r_stage(slot, QKVO + (size_t)(r0 + 64 * (k - 4)) * NIN + 1024 + 256 * h, NIN, wave, lane);
    else s2r_stage(slot, QKVO + (size_t)(r0 + 64 * (k - 6)) * NIN + 2048 + 256 * h, NIN, wave, lane);
}
template <int J> __device__ __forceinline__ void s2r_gq(f32x4 (&acc)[16], const LAS unsigned char* sl, const bf16x8 (&Qf)[8], int lane) {
    asm volatile("" : "+v"(lane)); const int li_ = lane & 15, g = lane >> 4;
#pragma unroll
    for (int t = 0; t < 4; ++t) {
#pragma unroll
        for (int kd = 0; kd < 8; ++kd) { acc[4 * J + t] = MFMA16(*(const LAS bf16x8*)(sl + img_off(16 * t + li_, 4 * kd + g)), Qf[kd], acc[4 * J + t]); if ((kd & 3) == 3) __builtin_amdgcn_sched_barrier(0); } }
}
template <int I> __device__ __forceinline__ void s2r_sh(bf16x8 (&Sf)[4], float& dsum, const LAS unsigned char* sl, const bf16x8 (&Qf)[8], const LAS float* ZS, float Ml, int wave, int lane) {
    asm volatile("" : "+v"(lane)); const int li_ = lane & 15, g = lane >> 4, lrow = 16 * wave + li_;
#pragma unroll
    for (int kk = 0; kk < 2; ++kk) { const int ks = 2 * I + kk;
        f32x4 sa = (f32x4){0.f, 0.f, 0.f, 0.f}, sb = sa;
#pragma unroll
        for (int kd = 0; kd < 8; ++kd) { sa = MFMA16(*(const LAS bf16x8*)(sl + img_off(32 * kk + li_, 4 * kd + g)), Qf[kd], sa); sb = MFMA16(*(const LAS bf16x8*)(sl + img_off(32 * kk + 16 + li_, 4 * kd + g)), Qf[kd], sb);
            if (kd & 1) __builtin_amdgcn_sched_barrier(0); }
        const f32x4 za = *(const LAS f32x4*)(ZS + 32 * ks + 4 * g), zb = *(const LAS f32x4*)(ZS + 32 * ks + 16 + 4 * g);
#pragma unroll
        for (int r = 0; r < 4; ++r) { const int da = lrow - (32 * ks + 4 * g + r);
            sa[r] = __builtin_bit_cast(float, __builtin_bit_cast(unsigned, sa[r] * __expf(za[r] - Ml)) & ~(unsigned)(da >> 31));
            sb[r] = __builtin_bit_cast(float, __builtin_bit_cast(unsigned, sb[r] * __expf(zb[r] - Ml)) & ~(unsigned)((da - 16) >> 31)); dsum += sa[r] + sb[r]; }
        Sf[ks] = pack_f8(sa, sb);
        __builtin_amdgcn_sched_barrier(0); }
}
template <int VT> __device__ __forceinline__ void s2r_hv(f32x4& acc, const unsigned base, const bf16x8 S0, const bf16x8 S1) {
    constexpr int HI = (VT >> 3) * 256;
    v2u r0, r1, r2, r3;
    asm volatile("ds_read_b64_tr_b16 %0, %4 offset:%5\n\tds_read_b64_tr_b16 %1, %4 offset:%6\n\tds_read_b64_tr_b16 %2, %4 offset:%7\n\tds_read_b64_tr_b16 %3, %4 offset:%8\n\ts_waitcnt lgkmcnt(0)"
                 : "=&v"(r0), "=&v"(r1), "=&v"(r2), "=&v"(r3) : "v"(base), "i"(HI), "i"(HI + 8192), "i"(HI + 16384), "i"(HI + 24576) : "memory");
    v4u f;
    f.x = r0.x; f.y = r0.y; f.z = r1.x; f.w = r1.y; acc = MFMA16(__builtin_bit_cast(bf16x8, f), S0, acc);
    f.x = r2.x; f.y = r2.y; f.z = r3.x; f.w = r3.y; acc = MFMA16(__builtin_bit_cast(bf16x8, f), S1, acc);
}
__device__ __forceinline__ void s2r_hh(f32x4 (&acc)[16], const unsigned slb, const bf16x8 S0, const bf16x8 S1, int lane) {
    asm volatile("" : "+v"(lane)); const int g = lane >> 4, q = (lane & 15) >> 2, p = lane & 3;
    unsigned hb[8];
#pragma unroll
    for (int j = 0; j < 8; ++j) hb[j] = slb + img_off(4 * g + q, 2 * j + (p >> 1)) + 8 * (p & 1);
    s2r_hv<0>(acc[0], hb[0], S0, S1); s2r_hv<1>(acc[1], hb[1], S0, S1); s2r_hv<2>(acc[2], hb[2], S0, S1); s2r_hv<3>(acc[3], hb[3], S0, S1);
    s2r_hv<4>(acc[4], hb[4], S0, S1); s2r_hv<5>(acc[5], hb[5], S0, S1); s2r_hv<6>(acc[6], hb[6], S0, S1); s2r_hv<7>(acc[7], hb[7], S0, S1);
    s2r_hv<8>(acc[8], hb[0], S0, S1); s2r_hv<9>(acc[9], hb[1], S0, S1); s2r_hv<10>(acc[10], hb[2], S0, S1); s2r_hv<11>(acc[11], hb[3], S0, S1);
    s2r_hv<12>(acc[12], hb[4], S0, S1); s2r_hv<13>(acc[13], hb[5], S0, S1); s2r_hv<14>(acc[14], hb[6], S0, S1); s2r_hv<15>(acc[15], hb[7], S0, S1);
}
__device__ __forceinline__ void s2r_output_pass(Frame& F) {
    const bf16* QKVO = WSP(bf16, WS_QKVO); const float* NST = WSP(float, WS_NST); bf16* A2 = WSP(bf16, WS_A2);
    const int wave = F.wave;
    const unsigned ldsR = (unsigned)(size_t)F.lds;
    int nun = 0, total = 0;
    for (int un = F.vcu; un < NB_P * NH * 16; un += F.G) { ++nun; total += (un & 15) ? 8 : 4; }
    if (total == 0) return;
    asm volatile("s_waitcnt vmcnt(0)" ::: "memory"); __syncthreads();
    int sj = 0, ss = 0;
#pragma unroll
    for (int s = 0; s < 3; ++s) if (s < total) { const int un = F.vcu + sj * F.G; s2r_stage_sub(F, F.lds + s * S2R_SLOT, un, ss, wave, F.lane); if (++ss == ((un & 15) ? 8 : 4)) { ss = 0; ++sj; } }
    int cj = 0, cs = 0;
    f32x4 acc[16]; bf16x8 Qf[8], Sf[4]; v2u ovr[16]; float dsum = 0.f, gn = 0.f;
    for (int gs = 0; gs < total; ++gs) {
        int lane = F.lane; asm volatile("" : "+v"(lane));
        const int g = lane >> 4, q = (lane & 15) >> 2, p = lane & 3, li_ = lane & 15, lrow = 16 * wave + li_;
        const int un = F.vcu + cj * F.G, c = un & 15, h = (un >> 4) & 3, b = un >> 6, bh = b * NH + h, r0 = b * S_P + 128 * c, k = c ? cs : cs + 4, par = cj & 1;
        LAS float* ZS = (LAS float*)(F.lds + SCR_OFF) + par * 1024; LAS float* LM = ZS + 128; LAS float* LW = ZS + 256; LAS float* LE = ZS + 384; LAS float* NS = ZS + 512; LAS float* HN = ZS + 768;
        const size_t row = (size_t)(r0 + lrow);
        if (cs == 0) {
            if (F.tid < 128) { const f32x4 gv = WSP(f32x4, WS_GV)[(size_t)(r0 + F.tid) * 4 + h]; ZS[F.tid] = gv.x; LM[F.tid] = gv.y; LW[F.tid] = gv.z; LE[F.tid] = gv.w; }
            if (F.tid >= 128 && F.tid < 192) *(LAS f32x4*)(HN + 4 * (F.tid - 128)) = *(const f32x4*)(F.head_norm + 256 * h + 4 * (F.tid - 128));
            if (F.tid < 64) *(LAS f32x4*)(NS + 4 * F.tid) = c ? *(const f32x4*)(NST + (size_t)(bh * 16 + c) * DK + 4 * F.tid) : (f32x4){0.f, 0.f, 0.f, 0.f};
#pragma unroll
            for (int kd = 0; kd < 8; ++kd) Qf[kd] = *(const bf16x8*)(QKVO + row * NIN + 256 * h + 32 * kd + 8 * g);
#pragma unroll
            for (int vt = 0; vt < 16; ++vt) acc[vt] = (f32x4){0.f, 0.f, 0.f, 0.f};
            dsum = 0.f;
        }
        const int rem = total - 1 - gs;
        if (rem >= 2) asm volatile("s_waitcnt vmcnt(8)" ::: "memory"); else if (rem == 1) asm volatile("s_waitcnt vmcnt(4)" ::: "memory"); else asm volatile("s_waitcnt vmcnt(0)" ::: "memory");
        __builtin_amdgcn_s_barrier(); asm volatile("" ::: "memory");
        if (gs + 3 < total) { const int sun = F.vcu + sj * F.G; s2r_stage_sub(F, F.lds + ((gs + 3) & 3) * S2R_SLOT, sun, ss, wave, lane); if (++ss == ((sun & 15) ? 8 : 4)) { ss = 0; ++sj; } }
        const LAS unsigned char* sl = F.lds + (gs & 3) * S2R_SLOT; const unsigned slb = ldsR + (gs & 3) * S2R_SLOT;
        if (k == 0) s2r_gq<0>(acc, sl, Qf, lane);
        else if (k == 1) s2r_gq<1>(acc, sl, Qf, lane);
        else if (k == 2) s2r_gq<2>(acc, sl, Qf, lane);
        else if (k == 3) { s2r_gq<3>(acc, sl, Qf, lane); const float wl = LW[lrow];
#pragma unroll
            for (int vt = 0; vt < 16; ++vt) acc[vt] = acc[vt] * wl; }
        else if (k == 4) s2r_sh<0>(Sf, dsum, sl, Qf, ZS, LM[lrow], wave, lane);
        else if (k == 5) { s2r_sh<1>(Sf, dsum, sl, Qf, ZS, LM[lrow], wave, lane);
            gn = 0.f;
#pragma unroll
            for (int kd = 0; kd < 8; ++kd) { const v4u qw = __builtin_bit_cast(v4u, Qf[kd]); const f32x4 n0 = *(const LAS f32x4*)(NS + 32 * kd + 8 * g), n1 = *(const LAS f32x4*)(NS + 32 * kd + 8 * g + 4);
                gn += (bflo(qw.x) * n0.x + bfhi(qw.x) * n0.y) + (bflo(qw.y) * n0.z + bfhi(qw.y) * n0.w) + (bflo(qw.z) * n1.x + bfhi(qw.z) * n1.y) + (bflo(qw.w) * n1.z + bfhi(qw.w) * n1.w); }
            gn += __shfl_xor(gn, 16); gn += __shfl_xor(gn, 32); }
        else if (k == 6) {
            { const bf16* ob = QKVO + row * NIN + 3072 + 256 * h + 4 * g;
#pragma unroll
              for (int vt = 0; vt < 16; ++vt) ovr[vt] = *(const v2u*)(ob + 16 * vt); }
            s2r_hh(acc, slb, Sf[0], Sf[1], lane); }
        else {
            s2r_hh(acc, slb, Sf[2], Sf[3], lane);
            float ds = dsum; ds += __shfl_xor(ds, 16); ds += __shfl_xor(ds, 32);
            __builtin_amdgcn_sched_barrier(0);
            const float den = LW[lrow] * gn + ds, inv = __builtin_amdgcn_rcpf(fmaxf(fabsf(den), LE[lrow]));
            float ssq = 0.f;
#pragma unroll
            for (int vt = 0; vt < 16; ++vt) { acc[vt] = acc[vt] * inv; ssq += (acc[vt].x * acc[vt].x + acc[vt].y * acc[vt].y) + (acc[vt].z * acc[vt].z + acc[vt].w * acc[vt].w); }
            ssq += __shfl_xor(ssq, 16); ssq += __shfl_xor(ssq, 32);
            const float rn = rsqrtf(ssq * (1.f / 256.f) + EPS);
            { bf16* ab = A2 + row * DM + 256 * h + 4 * g;
#pragma unroll
            for (int vt = 0; vt < 16; ++vt) {
                const f32x4 ov = bf4_to_f(ovr[vt]), gh = *(const LAS f32x4*)(HN + 16 * vt + 4 * g) * rn;
                const f32x4 sg = (f32x4){__builtin_amdgcn_rcpf(1.f + __expf(-ov.x)), __builtin_amdgcn_rcpf(1.f + __expf(-ov.y)), __builtin_amdgcn_rcpf(1.f + __expf(-ov.z)), __builtin_amdgcn_rcpf(1.f + __expf(-ov.w))};
                const f32x4 o = acc[vt] * gh * sg;
                v2u w; w.x = pk2(o.x, o.y); w.y = pk2(o.z, o.w);
                *(v2u*)(ab + 16 * vt) = w;
                if ((vt & 3) == 3) __builtin_amdgcn_sched_barrier(0); } }
        }
        asm volatile("" ::: "memory");
        if (++cs == (c ? 8 : 4)) { cs = 0; ++cj; }
    }
    asm volatile("s_waitcnt vmcnt(0)" ::: "memory"); __syncthreads();
}
namespace epf {
using pg8::Unit; using pg8::bf16_t; using pg8::BM; using pg8::HALF; using pg8::u32x4;
typedef __amdgpu_buffer_rsrc_t rsrc_t;
__device__ __forceinline__ rsrc_t mk(const void* p, size_t bytes) { return __builtin_amdgcn_make_buffer_rsrc((void*)p, 0, (int)bytes, 0x00020000); }
__device__ __forceinline__ void st16(rsrc_t r, unsigned off, u32x4 v) { __builtin_amdgcn_raw_buffer_store_b128(v, r, (int)off, 0, 16); }
__device__ __forceinline__ void st16f(rsrc_t r, unsigned off, f32x4 v) { __builtin_amdgcn_raw_buffer_store_b128(__builtin_bit_cast(u32x4, v), r, (int)off, 0, 16); }
__device__ __forceinline__ void st8(rsrc_t r, unsigned off, v2u v) { __builtin_amdgcn_raw_buffer_store_b64(v, r, (int)off, 0, 16); }
__device__ __forceinline__ void st4f(rsrc_t r, unsigned off, float v) { __builtin_amdgcn_raw_buffer_store_b32(__builtin_bit_cast(unsigned, v), r, (int)off, 0, 16); }
__device__ __forceinline__ f32x4 ld16f(rsrc_t r, unsigned off) { return __builtin_bit_cast(f32x4, __builtin_amdgcn_raw_buffer_load_b128(r, (int)off, 0, 16)); }
__device__ __forceinline__ v2u ld8(rsrc_t r, unsigned off) { return __builtin_amdgcn_raw_buffer_load_b64(r, (int)off, 0, 16); }
__device__ __forceinline__ float row_rs(rsrc_t slab, int row) {
    const f32x4 a = ld16f(slab, (unsigned)row * 64u), b = ld16f(slab, (unsigned)row * 64u + 16u), c = ld16f(slab, (unsigned)row * 64u + 32u), d = ld16f(slab, (unsigned)row * 64u + 48u);
    const float s = (((a.x + a.y) + (a.z + a.w)) + ((b.x + b.y) + (b.z + b.w))) + (((c.x + c.y) + (c.z + c.w)) + ((d.x + d.y) + (d.z + d.w)));
    return rsqrtf(s * (1.f / 1024.f) + EPS);
}
using ep::pack8; using ep::silu_mul;

struct EpiSwiGLU {
    static constexpr bool PERM = true, AFTER_DRAIN = false;
    rsrc_t O; rsrc_t ssq;
    __device__ __forceinline__ void operator()(const f32x4 (&acc)[2][2][4][2], const Unit& u, int wr, int wc, int fr, int fq) const {
        const int row0 = u.pm * BM + wr * 64 + fr, col0 = u.pn * HALF + wc * 32 + 8 * fq;
#pragma unroll
        for (int ai = 0; ai < 2; ++ai)
#pragma unroll
            for (int m = 0; m < 4; ++m) { const int row = row0 + ai * HALF + m * 16; const float r = row_rs(ssq, row);
                const f32x4 g0 = acc[ai][0][m][0] * r, g1 = acc[ai][0][m][1] * r, u0 = acc[ai][1][m][0] * r, u1 = acc[ai][1][m][1] * r;
                f32x4 h0, h1;
#pragma unroll
                for (int j = 0; j < 4; ++j) { h0[j] = silu_mul(g0[j], u0[j]); h1[j] = silu_mul(g1[j], u1[j]); }
                st16(O, ((unsigned)row * DFF + col0) * 2u, pack8(h0, h1)); }
    }
};
template <bool WB, bool BASE_Y> struct EpiResid {
    static constexpr bool PERM = true, AFTER_DRAIN = false;
    const float* baseP; const float* baseS; rsrc_t Y; rsrc_t XB; rsrc_t ssq;
    __device__ __forceinline__ void operator()(const f32x4 (&acc)[2][2][4][2], const Unit& u, int wr, int wc, int fr, int fq) const {
        const int row0 = u.pm * BM + wr * 64 + fr, col0 = u.pn * BM + wc * 32 + 8 * fq;
#pragma unroll
        for (int ai = 0; ai < 2; ++ai)
#pragma unroll
            for (int m = 0; m < 4; ++m) { const int row = row0 + ai * HALF + m * 16; const unsigned eo = (unsigned)row * DM + col0;
                const float* bp = (row < MP ? baseP + (size_t)row * DM : baseS + (size_t)(row - MP) * DM) + col0;
                float ss = 0.f;
#pragma unroll
                for (int bj = 0; bj < 2; ++bj) {
                    f32x4 b0, b1;
                    if (BASE_Y) { b0 = ld16f(Y, (eo + bj * HALF) * 4u); b1 = ld16f(Y, (eo + bj * HALF + 4) * 4u); } else { b0 = *(const f32x4*)(bp + bj * HALF); b1 = *(const f32x4*)(bp + bj * HALF + 4); }
                    const f32x4 x0 = b0 + acc[ai][bj][m][0], x1 = b1 + acc[ai][bj][m][1];
                    st16f(Y, (eo + bj * HALF) * 4u, x0); st16f(Y, (eo + bj * HALF + 4) * 4u, x1);
                    if (WB) { st16(XB, (eo + bj * HALF) * 2u, pack8(x0, x1));
                        ss += ((x0[0] * x0[0] + x0[1] * x0[1]) + (x0[2] * x0[2] + x0[3] * x0[3])) + ((x1[0] * x1[0] + x1[1] * x1[1]) + (x1[2] * x1[2] + x1[3] * x1[3])); } }
                if (WB) { ss += __shfl_xor(ss, 16); ss += __shfl_xor(ss, 32); if (fq == 0) st4f(ssq, ((unsigned)row * 16 + u.pn * 4 + wc) * 4u, ss); } }
    }
};
struct EpiConvIn {
    static constexpr bool PERM = true, AFTER_DRAIN = false;
    rsrc_t BG; rsrc_t U; rsrc_t ssq; float* cvP; float* cvS;
    __device__ __forceinline__ void operator()(const f32x4 (&acc)[2][2][4][2], const Unit& u, int wr, int wc, int fr, int fq) const {
        const int row0 = u.pm * BM + wr * 64 + fr;
        if (u.pn < 4) {
            const int col0 = u.pn * BM + wc * 32 + 8 * fq;
#pragma unroll
            for (int ai = 0; ai < 2; ++ai)
#pragma unroll
                for (int m = 0; m < 4; ++m) { const int row = row0 + ai * HALF + m * 16; const float r = row_rs(ssq, row);
#pragma unroll
                    for (int bj = 0; bj < 2; ++bj) st16(BG, ((unsigned)row * DM + col0 + bj * HALF) * 2u, pack8(acc[ai][bj][m][0] * r, acc[ai][bj][m][1] * r)); }
        } else {
            const int col0 = (u.pn - 4) * HALF + wc * 32 + 8 * fq;
#pragma unroll
            for (int ai = 0; ai < 2; ++ai)
#pragma unroll
                for (int m = 0; m < 4; ++m) { const int row = row0 + ai * HALF + m * 16; const float r = row_rs(ssq, row);
                    const f32x4 p0 = (acc[ai][0][m][0] * r) * (acc[ai][1][m][0] * r), p1 = (acc[ai][0][m][1] * r) * (acc[ai][1][m][1] * r);
                    st16(U, ((unsigned)row * DM + col0) * 2u, pack8(p0, p1));
                    float* sp = nullptr;
                    if (row < MP) { const int t = row & (S_P - 1), b = row >> 11; if (t >= S_P - 2) sp = cvP + (size_t)(b * 2 + (t - (S_P - 2))) * DM + col0; }
                    else { const int rs = row - MP, t = rs & (S_S - 1), b = rs >> 3; if (t >= S_S - 2) sp = cvS + (size_t)(b * 2 + (t - (S_S - 2))) * DM + col0; }
                    if (sp) { *(f32x4*)sp = p0; *(f32x4*)(sp + 4) = p1; } }
        }
    }
};
}

constexpr int CW_CNT = 16384;
constexpr int CW_TMO = 8;
__device__ __forceinline__ void flow_poll(const unsigned* p, unsigned need, unsigned* tmo) {
    unsigned spins = 0;
    while ((unsigned)__builtin_amdgcn_readfirstlane(__hip_atomic_load(p, __ATOMIC_RELAXED, __HIP_MEMORY_SCOPE_AGENT)) < need) {
        __builtin_amdgcn_s_sleep(2);
        if (++spins > (1u << 18)) { if ((threadIdx.x & 63) == 0) __hip_atomic_store(tmo, 1u, __ATOMIC_RELAXED, __HIP_MEMORY_SCOPE_AGENT); break; }
    }
}
struct FlowOrder : pg8::StaticOrder {
    const unsigned* dep; unsigned need; unsigned* pub; unsigned* tmo; int wgm; mutable int pend;
    __device__ __forceinline__ bool next(int i, pg8::Unit& u) const {
        const long L = (long)i * G + c; if (L >= nwg) return false;
        int wgid = (int)L; { const int q = nwg / pg8::NXCD, r = nwg % pg8::NXCD, xcd = wgid % pg8::NXCD, off = wgid / pg8::NXCD; wgid = (xcd < r ? xcd * (q + 1) : r * (q + 1) + (xcd - r) * q) + off; }
        const int nig = wgm * nN, gid = wgid / nig, fm = gid * wgm, gsz = (nM - fm) < wgm ? (nM - fm) : wgm;
        u.pm = fm + ((wgid % nig) % gsz); u.pn = (wgid % nig) / gsz; return true;
    }
    __device__ __forceinline__ void a_ready(const pg8::Unit& u) const {
        if (dep) {
            if (threadIdx.x < 64) flow_poll(dep + 64 * u.pm, need, tmo);
            asm volatile("" ::: "memory"); __builtin_amdgcn_s_barrier(); asm volatile("" ::: "memory");
        }
    }
    __device__ __forceinline__ void done(const pg8::Unit& u) const { pend = u.pm; }
    __device__ __forceinline__ void flush() const {
        if (pend >= 0) { if ((threadIdx.x & 63) == 0) __hip_atomic_fetch_add(pub + 64 * pend, 1u, __ATOMIC_RELAXED, __HIP_MEMORY_SCOPE_AGENT); pend = -1; }
    }
};
template <class Epi>
__device__ __forceinline__ void flow_gemm(Frame& F, const pg8::Gemm g, const Epi& E, int rot, const unsigned* dep, unsigned need, unsigned* pub) {
    FlowOrder S; S.init(g.M, g.N, F.G, (int)((blockIdx.x + F.G - (unsigned)(rot % F.G)) % F.G)); S.dep = dep; S.need = need; S.pub = pub; S.tmo = (unsigned*)(F.ctl + CW_TMO); S.wgm = 2; S.pend = -1;
    pg8::gemm_phase<Epi, FlowOrder, true, true>(F.lds + RING_OFF, g, S, E);
}
__device__ __forceinline__ void conv_flow(Frame& F, int rot, const unsigned* dep, unsigned* pub) {
    const epf::rsrc_t BG = epf::mk(F.ws + WS_BG, (size_t)MT * DM * 2), U = epf::mk(F.ws + WS_U, (size_t)MT * DM * 2), A2 = epf::mk(F.ws + WS_A2, (size_t)MT * DM * 2);
    unsigned* tmo = (unsigned*)(F.ctl + CW_TMO);
    const int c = (int)((blockIdx.x + F.G - (unsigned)(rot % F.G)) % F.G);
    for (int pm = c; pm < MT / 256; pm += F.G) {
        if (F.tid < 64) { flow_poll(dep + 64 * pm, 96u, tmo); if (pm < MP / 256 && (pm & 7)) flow_poll(dep + 64 * (pm - 1), 96u, tmo); }
        __syncthreads();
        for (int rr = F.wave; rr < 256; rr += NWAVES) {
            const int row = pm * 256 + rr; const bool smp = row >= MP; const int t = smp ? (row - MP) & (S_S - 1) : row & (S_P - 1), b = smp ? (row - MP) >> 3 : row >> 11;
            const f32x4* sb = (const f32x4*)(F.stConv + (size_t)b * 2 * DM) + F.lane;
#pragma unroll
            for (int j = 0; j < 4; ++j) {
                const unsigned eo = ((unsigned)row * DM + 4 * F.lane + 256 * j) * 2u;
                const v2u uc = epf::ld8(U, eo), bw = epf::ld8(BG, eo);
                const f32x4 w0 = ((const f32x4*)F.w_taps + F.lane)[64 * j], w1 = ((const f32x4*)(F.w_taps + DM) + F.lane)[64 * j], w2 = ((const f32x4*)(F.w_taps + 2 * DM) + F.lane)[64 * j];
                f32x4 a = (f32x4){0.f, 0.f, 0.f, 0.f}, cc = a;
                if (t >= 2) a = bf4_to_f(epf::ld8(U, eo - 2u * DM * 2u)); else if (smp) a = sb[(t == 0 ? 0 : 256) + 64 * j];
                if (t >= 1) cc = bf4_to_f(epf::ld8(U, eo - DM * 2u)); else if (smp) cc = sb[256 + 64 * j];
                const f32x4 y = bf4_to_f(bw) * (w0 * a + w1 * cc + w2 * bf4_to_f(uc));
                v2u w; w.x = pk2(y.x, y.y); w.y = pk2(y.z, y.w); epf::st8(A2, eo, w);
            }
        }
        VM_WAIT();
        if (F.lane == 0) __hip_atomic_fetch_add(pub + 64 * pm, 1u, __ATOMIC_RELAXED, __HIP_MEMORY_SCOPE_AGENT);
    }
}
__device__ __forceinline__ void fnorm_flow(Frame& F, int rot, const unsigned* dep) {
    const epf::rsrc_t Y = epf::mk(F.out + O_Y, (size_t)MT * DM * 4);
    unsigned* tmo = (unsigned*)(F.ctl + CW_TMO);
    const int c = (int)((blockIdx.x + F.G - (unsigned)(rot % F.G)) % F.G);
    for (int it = c; it < (MT / 256) * 4; it += F.G) {
        const int pm = it >> 2, qq = it & 3;
        if (F.tid < 64) flow_poll(dep + 64 * pm, 32u, tmo);
        __syncthreads();
        for (int rr = F.wave; rr < 64; rr += NWAVES) {
            const int row = pm * 256 + qq * 64 + rr; const unsigned eo = ((unsigned)row * DM + 4 * F.lane) * 4u;
            const f32x4* gr = (const f32x4*)F.norm_final + F.lane; f32x4* xo = (f32x4*)(F.out + O_Y + (size_t)row * DM) + F.lane;
            f32x4 v[4]; float s = 0.f;
#pragma unroll
            for (int j = 0; j < 4; ++j) { v[j] = epf::ld16f(Y, eo + 1024u * j); s += (v[j].x * v[j].x + v[j].y * v[j].y) + (v[j].z * v[j].z + v[j].w * v[j].w); }
            const float r = rsqrtf(wave_sum(s) * (1.f / 1024.f) + EPS);
#pragma unroll
            for (int j = 0; j < 4; ++j) xo[64 * j] = v[j] * r * gr[64 * j];
        }
    }
}
namespace sg {
constexpr int BKS = 128, SLOTB = 32768, NSLOT = 4;
__device__ __forceinline__ unsigned soff(unsigned row, unsigned ch) { return row * 256u + ((ch ^ (row & 15u)) << 4); }
struct MapPlain { __device__ __forceinline__ int operator()(int tn, int r) const { return 64 * tn + r; } };
struct MapGU { __device__ __forceinline__ int operator()(int tn, int r) const { const int c0 = 32 * tn; return 256 * (c0 >> 7) + (c0 & 127) + 128 * ((r >> 4) & 1) + 16 * (r >> 5) + (r & 15); } };
struct MapCin { __device__ __forceinline__ int operator()(int tn, int r) const { if (tn < 16) return 64 * tn + r; const int c0 = 32 * (tn - 16); return DM + 256 * (c0 >> 7) + (c0 & 127) + 128 * ((r >> 4) & 1) + 16 * (r >> 5) + (r & 15); } };

template <class Map>
__device__ __forceinline__ void stage(LAS unsigned char* slot, const bf16* A, const bf16* Bt, int K, int ks, int tn, const Map& map, int wave, int lane) {
    const int rr = lane >> 4, cs = lane & 15;
#pragma unroll
    for (int i = 0; i < 4; ++i) { const int pr = (wave + 8 * i) & 15, row = 4 * pr + rr, ch = cs ^ (row & 15);
        const bf16* src = (i < 2) ? A + (size_t)row * K + ks * BKS + ch * 8 : Bt + (size_t)map(tn, row) * K + ks * BKS + ch * 8;
        __builtin_amdgcn_global_load_lds((const unsigned*)src, (LAS unsigned*)(slot + (i < 2 ? 0 : 16384) + pr * 1024), 16, 0, 0); }
}
template <class Epi, class Map>
__device__ __forceinline__ void run(LAS unsigned char* lds, const bf16* Abase  , const bf16* Bt, int K, const Map& map, const Epi& E, int t_first, int t_step, int t_end) {
    const int tid = threadIdx.x, wave = __builtin_amdgcn_readfirstlane(tid >> 6), wr = wave >> 1, wc = wave & 1;
    const int nK = K / BKS, ntile = t_first < t_end ? (t_end - t_first + t_step - 1) / t_step : 0, total = ntile * nK;
    if (total == 0) return;
    int lane = tid & 63; asm volatile("" : "+v"(lane));
    const int lr = lane & 15, g = lane >> 4;
    asm volatile("" ::: "memory"); __builtin_amdgcn_s_barrier(); asm volatile("" ::: "memory");
    int sj = 0, sk = 0;
#pragma unroll
    for (int s = 0; s < 3; ++s) if (s < total) { const int ti = t_first + sj * t_step; stage(lds + s * SLOTB, Abase + (size_t)(64 * (ti & 15)) * K, Bt, K, sk, ti >> 4, map, wave, lane); if (++sk == nK) { sk = 0; ++sj; } }
    f32x4 acc[2] = {(f32x4){0.f, 0.f, 0.f, 0.f}, (f32x4){0.f, 0.f, 0.f, 0.f}};
    int cj = 0, ck = 0;
    for (int gs = 0; gs < total; ++gs) {
        const int rem = total - 1 - gs;
        if (rem >= 2) asm volatile("s_waitcnt vmcnt(8)" ::: "memory"); else if (rem == 1) asm volatile("s_waitcnt vmcnt(4)" ::: "memory"); else asm volatile("s_waitcnt vmcnt(0)" ::: "memory");
        __builtin_amdgcn_s_barrier(); asm volatile("" ::: "memory");
        if (gs + 3 < total) { const int ti = t_first + sj * t_step; stage(lds + ((gs + 3) & 3) * SLOTB, Abase + (size_t)(64 * (ti & 15)) * K, Bt, K, sk, ti >> 4, map, wave, lane); if (++sk == nK) { sk = 0; ++sj; } }
        const LAS unsigned char* sl = lds + (gs & 3) * SLOTB;
#pragma unroll
        for (int kk = 0; kk < 4; ++kk) {
            const bf16x8 a = *(const LAS bf16x8*)(sl + soff(16 * wr + lr, 4 * kk + g));
            const bf16x8 b0 = *(const LAS bf16x8*)(sl + 16384 + soff(32 * wc + lr, 4 * kk + g)), b1 = *(const LAS bf16x8*)(sl + 16384 + soff(32 * wc + 16 + lr, 4 * kk + g));
            acc[0] = __builtin_amdgcn_mfma_f32_16x16x32_bf16(b0, a, acc[0], 0, 0, 0); acc[1] = __builtin_amdgcn_mfma_f32_16x16x32_bf16(b1, a, acc[1], 0, 0, 0);
        }
        asm volatile("" ::: "memory");
        if (++ck == nK) { const int ti = t_first + cj * t_step; E(acc, ti & 15, ti >> 4, wr, wc, lr, g); acc[0] = (f32x4){0.f, 0.f, 0.f, 0.f}; acc[1] = acc[0]; ck = 0; ++cj; }
    }
    asm volatile("s_waitcnt vmcnt(0)" ::: "memory"); __builtin_amdgcn_s_barrier(); asm volatile("" ::: "memory");
}

__device__ __forceinline__ v2u pack4(const f32x4 v) { v2u w; w.x = pg8::cvt_pk_bf16(v[0], v[1]); w.y = pg8::cvt_pk_bf16(v[2], v[3]); return w; }
struct EpiScale {
    bf16* O; int ldc; const LAS float* SRS;
    __device__ __forceinline__ void operator()(const f32x4 (&acc)[2], int tm, int tn, int wr, int wc, int lr, int g) const {
        const int row = MP + 64 * tm + 16 * wr + lr; const float r = SRS[row - MP]; bf16* p = O + (size_t)row * ldc + 64 * tn + 32 * wc + 4 * g;
        *(v2u*)p = pack4(acc[0] * r); *(v2u*)(p + 16) = pack4(acc[1] * r);
    }
};
struct EpiSwiGLU {
    bf16* O; const LAS float* SRS;
    __device__ __forceinline__ void operator()(const f32x4 (&acc)[2], int tm, int tn, int wr, int wc, int lr, int g) const {
        const int row = MP + 64 * tm + 16 * wr + lr; const float r = SRS[row - MP];
        const f32x4 gg = acc[0] * r, uu = acc[1] * r; f32x4 h;
#pragma unroll
        for (int j = 0; j < 4; ++j) h[j] = ep::silu_mul(gg[j], uu[j]);
        *(v2u*)(O + (size_t)row * DFF + 32 * tn + 16 * wc + 4 * g) = pack4(h);
    }
};
template <bool WB> struct EpiResid {
    bf16* XB; float* ssq;
    __device__ __forceinline__ void operator()(const f32x4 (&acc)[2], int tm, int tn, int wr, int wc, int lr, int g) const {
        const int row = MP + 64 * tm + 16 * wr + lr, col = 64 * tn + 32 * wc + 4 * g; bf16* xp = XB + (size_t)row * DM + col;
        const v2u w0 = pack4(bf4_to_f(*(const v2u*)xp) + acc[0]), w1 = pack4(bf4_to_f(*(const v2u*)(xp + 16)) + acc[1]);
        *(v2u*)xp = w0; *(v2u*)(xp + 16) = w1;
        if (WB) { const f32x4 r0 = bf4_to_f(w0), r1 = bf4_to_f(w1);
            float ss = ((r0[0] * r0[0] + r0[1] * r0[1]) + (r0[2] * r0[2] + r0[3] * r0[3])) + ((r1[0] * r1[0] + r1[1] * r1[1]) + (r1[2] * r1[2] + r1[3] * r1[3]));
            ss += __shfl_xor(ss, 16); ss += __shfl_xor(ss, 32); if (g == 0) atomicAdd(ssq + (size_t)row * 16 + tn, ss); }
    }
};
struct EpiConvIn {
    bf16* BG; bf16* U; const LAS float* SRS; float* cvS;
    __device__ __forceinline__ void operator()(const f32x4 (&acc)[2], int tm, int tn, int wr, int wc, int lr, int g) const {
        const int row = MP + 64 * tm + 16 * wr + lr; const float r = SRS[row - MP];
        if (tn < 16) { bf16* p = BG + (size_t)row * DM + 64 * tn + 32 * wc + 4 * g; *(v2u*)p = pack4(acc[0] * r); *(v2u*)(p + 16) = pack4(acc[1] * r); }
        else { const int ch = 32 * (tn - 16) + 16 * wc + 4 * g; const f32x4 pv = (acc[0] * r) * (acc[1] * r);
            *(v2u*)(U + (size_t)row * DM + ch) = pack4(pv);
            const int rs = row - MP, t = rs & (S_S - 1), b = rs >> 3; if (t >= S_S - 2) *(f32x4*)(cvS + (size_t)(b * 2 + (t - (S_S - 2))) * DM + ch) = pv; }
    }
};
__device__ __forceinline__ const LAS float* fill_srs(LAS unsigned char* lds, const float* slab) {
    LAS float* SRS = (LAS float*)(lds + SCR_OFF + 8192);
    for (int i = threadIdx.x; i < MS; i += NWAVES * 64) SRS[i] = ep::row_rs(slab, MP + i);
    __syncthreads();
    return SRS;
}
}
#ifndef TS_PROBE
#define TS_PROBE -1
#endif
#ifndef TS_A
#define TS_A ((TS_PROBE >= N_PHASES) ? 0 : TS_PROBE)
#define TS_B ((TS_PROBE >= N_PHASES) ? N_PHASES : TS_PROBE + 1)
#endif
#ifndef PROBE_LAUNCH
#define PROBE_LAUNCH -1
#define PROBE_LAUNCH_N 1
#endif
#ifndef PROBE_ID
#define PROBE_ID -1
#define PROBE_N 1
#endif
#ifndef SCAN_MODE
#define SCAN_MODE 3
#endif
#ifndef MK_N_LAUNCHES
#define MK_N_LAUNCHES 1
#endif
constexpr int N_PHASES = (FLOW == 1) ? 5 : 13;
struct Args { const float* in[18]; float* out; unsigned char* ws; int ph_lo, ph_hi, rep_id, rep_n, dry, pad; };
__global__ void __launch_bounds__(NWAVES * 64, 2) fwd_kernel(Args args) {
    extern __shared__ __attribute__((aligned(16))) unsigned char lds[];
    Frame F;
    F.lds = (LAS unsigned char*)lds; F.MISC = (volatile LAS unsigned*)(F.lds + MISC_OFF);
    F.tid = threadIdx.x; F.lane = F.tid & 63; F.wave = __builtin_amdgcn_readfirstlane(F.tid >> 6);
    F.G = gridDim.x; { const int bx = blockIdx.x; F.vcu = (F.G % 8 == 0) ? (bx % 8) * (F.G / 8) + bx / 8 : bx; }
    F.ws = args.ws; F.out = args.out; F.ctl = (gu32*)(args.ws + WS_CTL);
    F.xp = args.in[0]; F.xs = args.in[1]; F.stC = args.in[2]; F.stN = args.in[3]; F.stM = args.in[4]; F.stConv = args.in[5]; F.norm_mix = args.in[6]; F.norm_ffn = args.in[7]; F.norm_final = args.in[8];
    F.w_in = args.in[9]; F.b_gate = args.in[10]; F.head_norm = args.in[11]; F.w_out = args.in[12]; F.w_cin = args.in[13]; F.w_taps = args.in[14]; F.w_cout = args.in[15]; F.w_gu = args.in[16]; F.w_dn = args.in[17];
    for (int u = F.tid; u < (LDS_BYTES - LDSCTL_OFF) / 4; u += NWAVES * 64) ((LAS unsigned*)(F.lds + LDSCTL_OFF))[u] = 0u;
    __syncthreads();
    XcdBarrier bar; bar.bar = (unsigned*)(F.ctl + CW_BAR); bar.x = 0; bar.st = nullptr;
    const int lo = args.ph_lo, hi = args.ph_hi;
    if (hi - lo > 1) bar = xcd_barrier_post((unsigned*)(F.ctl + CW_BAR), F.MISC + 8);
#define IN(k) (lo <= (k) && (k) < hi)
#define REP(id) (args.rep_id == (id) ? args.rep_n : 1)
#define SEAM(k) do { if (IN(k) && IN((k) + 1)) xcd_barrier(bar); STAMP((k) + 1); } while (0)
#if TS_PROBE >= 0
#define STAMP(i) do { if (blockIdx.x == 0 && F.tid == 0) ((unsigned long long*)(F.ctl + 2048))[(i)] = __builtin_amdgcn_s_memrealtime(); } while (0)
#else
#define STAMP(i) do { } while (0)
#endif
    bf16* XB = WSP(bf16, WS_XB); bf16* A2 = WSP(bf16, WS_A2); float* Y = F.out + O_Y;
    float* SSQ0 = WSP(float, WS_SSQ); float* SSQ1 = SSQ0 + (size_t)MT * 16; float* SSQ2 = SSQ1 + (size_t)MT * 16; float* SSQ3 = SSQ2 + (size_t)MT * 16;

    STAMP(0);
    if (IN(0)) { p0_prologue(F); } SEAM(0);
#define SG_UP(WOFF) do { if (F.G == 256) { if (blockIdx.x < 128) sg::run(F.lds, XBs, WSP(bf16, WOFF), DM, sg::MapGU(), Es, (int)blockIdx.x, 128, 384); else sg::run(F.lds, XBs, WSP(bf16, WOFF), DM, sg::MapGU(), Es, 384 + (int)blockIdx.x - 128, 128, 16 * (DFF / 32)); } \
        else sg::run(F.lds, XBs, WSP(bf16, WOFF), DM, sg::MapGU(), Es, F.vcu, F.G, 16 * (DFF / 32)); } while (0)
    const bf16* XBs = XB + (size_t)MP * DM; const bf16* A2s = A2 + (size_t)MP * DM; const bf16* HFs = WSP(bf16, WS_HFF) + (size_t)MP * DFF;
    if (IN(1)) { pg8::Gemm g{XB, WSP(bf16, WS_W_IN), MP, NIN, DM}; ep::EpiScale E{WSP(bf16, WS_QKVO), NIN, SSQ0, nullptr, 0}; run_gemm_rs<ep::EpiScale, true, true>(F, g, E);
        sg::EpiScale Es{WSP(bf16, WS_QKVO), NIN, sg::fill_srs(F.lds, SSQ0)}; sg::run(F.lds, XBs, WSP(bf16, WS_W_IN), DM, sg::MapPlain(), Es, F.vcu, F.G, 16 * (NIN / 64)); } SEAM(1);
#if SCAN_MODE == 0
    if (IN(2)) { scan_oracle(F, true, true, true); } SEAM(2);
    if (IN(3)) { gate_pass(F, 0, MT); } SEAM(3);
#elif SCAN_MODE == 1
    if (IN(2)) { s1_state_pass(F); scan_oracle(F, true, true, false); } SEAM(2);
    if (IN(3)) { gate_pass(F, 0, MT); } SEAM(3);
#elif SCAN_MODE == 2
    if (IN(2)) { s1_state_pass(F); scan_oracle(F, false, true, false); } SEAM(2);
    if (IN(3)) { s2_output_pass(F); gate_pass(F, MP, MT); } SEAM(3);
#else
    if (IN(2)) {
        const bool split = (F.G % 32) == 0; const int slot = F.vcu & 31, grp = F.vcu >> 5, ngrp = F.G >> 5;
        if (!split) { s3b_sample_pass(F, F.vcu, F.G); s1c_state_pass(F, F.vcu, F.G); }
        else if (slot < 16) { s1c_state_pass(F, grp * 16 + slot, ngrp * 16); P0STAMP(22); }
        else { s3b_sample_pass(F, grp * 16 + slot - 16, ngrp * 16);
#if TS_PROBE >= 0
            if (blockIdx.x == 128 && F.tid == 0) ((unsigned long long*)(F.ctl + 2048))[24] = __builtin_amdgcn_s_memrealtime();
#endif
        }
    } SEAM(2);
    if (IN(3)) { s2_output_pass(F); } SEAM(3);
#endif
#if FLOW == 1
    if (IN(4)) {
        unsigned* CNT = (unsigned*)(F.ctl + CW_CNT);
#define CNTS(s) (CNT + (s) * 68 * 64)
        const epf::rsrc_t rY = epf::mk(Y, (size_t)MT * DM * 4), rXB = epf::mk(XB, (size_t)MT * DM * 2), rHFF = epf::mk(F.ws + WS_HFF, (size_t)MT * DFF * 2);
        const epf::rsrc_t rS1 = epf::mk(SSQ1, SSQ_BYTES), rS2 = epf::mk(SSQ2, SSQ_BYTES), rS3 = epf::mk(SSQ3, SSQ_BYTES);
        const epf::rsrc_t rBG = epf::mk(F.ws + WS_BG, (size_t)MT * DM * 2), rU = epf::mk(F.ws + WS_U, (size_t)MT * DM * 2);
        int rot = 0;
        { pg8::Gemm g{A2, WSP(bf16, WS_W_OUT), MT, DM, DM}; epf::EpiResid<true, false> E{F.xp, F.xs, rY, rXB, rS1}; flow_gemm(F, g, E, rot, nullptr, 0u, CNTS(0)); rot += 272; }
        { pg8::Gemm g{XB, WSP(bf16, WS_W_GU0), MT, NGU, DM}; epf::EpiSwiGLU E{rHFF, rS1}; flow_gemm(F, g, E, rot, CNTS(0), 32u, CNTS(1)); rot += 1496; }
        { pg8::Gemm g{WSP(bf16, WS_HFF), WSP(bf16, WS_W_DN0), MT, DM, DFF}; epf::EpiResid<true, true> E{nullptr, nullptr, rY, rXB, rS2}; flow_gemm(F, g, E, rot, CNTS(1), 176u, CNTS(2)); rot += 272; }
        { pg8::Gemm g{XB, WSP(bf16, WS_W_CIN), MT, NCIN, DM}; epf::EpiConvIn E{rBG, rU, rS2, F.out + O_CVP, F.out + O_CVS}; flow_gemm(F, g, E, rot, CNTS(2), 32u, CNTS(3)); rot += 816; }
        conv_flow(F, rot, CNTS(3), CNTS(4)); rot += 72;
        { pg8::Gemm g{A2, WSP(bf16, WS_W_COUT), MT, DM, DM}; epf::EpiResid<true, true> E{nullptr, nullptr, rY, rXB, rS3}; flow_gemm(F, g, E, rot, CNTS(4), 8u, CNTS(5)); rot += 272; }
        { pg8::Gemm g{XB, WSP(bf16, WS_W_GU1), MT, NGU, DM}; epf::EpiSwiGLU E{rHFF, rS3}; flow_gemm(F, g, E, rot, CNTS(5), 32u, CNTS(6)); rot += 1496; }
        { pg8::Gemm g{WSP(bf16, WS_HFF), WSP(bf16, WS_W_DN1), MT, DM, DFF}; epf::EpiResid<false, true> E{nullptr, nullptr, rY, rXB, rS3}; flow_gemm(F, g, E, rot, CNTS(6), 176u, CNTS(7)); rot += 272; }
        fnorm_flow(F, rot, CNTS(7));
#undef CNTS
    }
#elif FLOW == 2
    {
        const epf::rsrc_t rY = epf::mk(Y, (size_t)MT * DM * 4), rXB = epf::mk(XB, (size_t)MT * DM * 2), rHFF = epf::mk(F.ws + WS_HFF, (size_t)MT * DFF * 2);
        const epf::rsrc_t rS1 = epf::mk(SSQ1, SSQ_BYTES), rS2 = epf::mk(SSQ2, SSQ_BYTES), rS3 = epf::mk(SSQ3, SSQ_BYTES);
        const epf::rsrc_t rBG = epf::mk(F.ws + WS_BG, (size_t)MT * DM * 2), rU = epf::mk(F.ws + WS_U, (size_t)MT * DM * 2);
    if (IN(4)) { pg8::Gemm g{A2, WSP(bf16, WS_W_OUT), MT, DM, DM}; epf::EpiResid<true, false> E{F.xp, F.xs, rY, rXB, rS1}; run_gemm<epf::EpiResid<true, false>, true, true>(F, g, E); } SEAM(4);
    if (IN(5)) { pg8::Gemm g{XB, WSP(bf16, WS_W_GU0), MT, NGU, DM}; epf::EpiSwiGLU E{rHFF, rS1}; run_gemm<epf::EpiSwiGLU, true, true>(F, g, E); } SEAM(5);
    if (IN(6)) { pg8::Gemm g{WSP(bf16, WS_HFF), WSP(bf16, WS_W_DN0), MT, DM, DFF}; epf::EpiResid<true, true> E{nullptr, nullptr, rY, rXB, rS2}; run_gemm<epf::EpiResid<true, true>, true, true>(F, g, E); } SEAM(6);
    if (IN(7)) { pg8::Gemm g{XB, WSP(bf16, WS_W_CIN), MT, NCIN, DM}; epf::EpiConvIn E{rBG, rU, rS2, F.out + O_CVP, F.out + O_CVS}; run_gemm<epf::EpiConvIn, true, true>(F, g, E); } SEAM(7);
    if (IN(8)) { conv_pass(F); } SEAM(8);
    if (IN(9)) { pg8::Gemm g{A2, WSP(bf16, WS_W_COUT), MT, DM, DM}; epf::EpiResid<true, true> E{nullptr, nullptr, rY, rXB, rS3}; run_gemm<epf::EpiResid<true, true>, true, true>(F, g, E); } SEAM(9);
    if (IN(10)) { pg8::Gemm g{XB, WSP(bf16, WS_W_GU1), MT, NGU, DM}; epf::EpiSwiGLU E{rHFF, rS3}; run_gemm<epf::EpiSwiGLU, true, true>(F, g, E); } SEAM(10);
    if (IN(11)) { pg8::Gemm g{WSP(bf16, WS_HFF), WSP(bf16, WS_W_DN1), MT, DM, DFF}; epf::EpiResid<false, true> E{nullptr, nullptr, rY, rXB, rS3}; run_gemm<epf::EpiResid<false, true>, true, true>(F, g, E); } SEAM(11);
    if (IN(12)) { final_norm(F); }
    }
#else
    if (IN(4)) { pg8::Gemm g{A2, WSP(bf16, WS_W_OUT), MP, DM, DM}; ep::EpiResid<true> E{XB, SSQ1}; run_gemm<ep::EpiResid<true>, true, true>(F, g, E);
        sg::EpiResid<true> Es{XB, SSQ1}; sg::run(F.lds, A2s, WSP(bf16, WS_W_OUT), DM, sg::MapPlain(), Es, F.vcu, F.G, 16 * (DM / 64)); } SEAM(4);
    if (IN(5)) { pg8::Gemm g{XB, WSP(bf16, WS_W_GU0), MT, NGU, DM}; ep::EpiSwiGLU E{WSP(bf16, WS_HFF), SSQ1, nullptr, 0}; run_gemm_rs<ep::EpiSwiGLU, true, true>(F, g, E); } SEAM(5);
    if (IN(6)) { pg8::Gemm g{WSP(bf16, WS_HFF), WSP(bf16, WS_W_DN0), MP, DM, DFF}; ep::EpiResid<true> E{XB, SSQ2}; run_gemm<ep::EpiResid<true>, true, true>(F, g, E);
        sg::EpiResid<true> Es{XB, SSQ2}; sg::run(F.lds, HFs, WSP(bf16, WS_W_DN0), DFF, sg::MapPlain(), Es, F.vcu, F.G, 16 * (DM / 64)); } SEAM(6);
    if (IN(7)) { pg8::Gemm g{XB, WSP(bf16, WS_W_CIN), MP, NCIN, DM}; ep::EpiConvIn E{WSP(bf16, WS_BG), WSP(bf16, WS_U), SSQ2, F.out + O_CVP, F.out + O_CVS, nullptr, 0}; run_gemm_rs<ep::EpiConvIn, true, true>(F, g, E);
        sg::EpiConvIn Es{WSP(bf16, WS_BG), WSP(bf16, WS_U), sg::fill_srs(F.lds, SSQ2), F.out + O_CVS}; sg::run(F.lds, XBs, WSP(bf16, WS_W_CIN), DM, sg::MapCin(), Es, F.vcu, F.G, 16 * (NCIN / 64)); } SEAM(7);
    if (IN(8)) { conv_pass(F); } SEAM(8);
    if (IN(9)) { pg8::Gemm g{A2, WSP(bf16, WS_W_COUT), MP, DM, DM}; ep::EpiResid<true> E{XB, SSQ3}; run_gemm<ep::EpiResid<true>, true, true>(F, g, E);
        sg::EpiResid<true> Es{XB, SSQ3}; sg::run(F.lds, A2s, WSP(bf16, WS_W_COUT), DM, sg::MapPlain(), Es, F.vcu, F.G, 16 * (DM / 64)); } SEAM(9);
    if (IN(10)) { pg8::Gemm g{XB, WSP(bf16, WS_W_GU1), MT, NGU, DM}; ep::EpiSwiGLU E{WSP(bf16, WS_HFF), SSQ3, nullptr, 0}; run_gemm_rs<ep::EpiSwiGLU, true, true>(F, g, E); } SEAM(10);
    if (IN(11)) { pg8::Gemm g{WSP(bf16, WS_HFF), WSP(bf16, WS_W_DN1), MP, DM, DFF}; ep::EpiResid<false> E{XB, nullptr}; run_gemm<ep::EpiResid<false>, true, true>(F, g, E);
        sg::EpiResid<false> Es{XB, nullptr}; sg::run(F.lds, HFs, WSP(bf16, WS_W_DN1), DFF, sg::MapPlain(), Es, F.vcu, F.G, 16 * (DM / 64)); } SEAM(11);
    if (IN(12)) { final_norm(F); }
#endif
#if TS_PROBE >= 0
    {
        xcd_barrier(bar); STAMP(N_PHASES);
        if (blockIdx.x == 0 && F.tid == 0) {
            const unsigned long long* ts = (const unsigned long long*)(F.ctl + 2048);
            const unsigned long long t0 = ts[TS_A], t1 = ts[TS_B];
            const int T = (int)((t1 - t0 + 50) / 100);
            F.out[O_Y] += (float)(10 + T / 50);
            const float X = (2.5f + 0.07f * (float)(T % 50)) * 1e-4f, sc = 1.f + sqrtf(X);
            for (int i = 0; i < NB_P * NH; ++i) F.out[O_MP + i] *= sc;
        }
    }
#endif
#undef IN
#undef SEAM
}

extern "C" void kernel_launch(void* const* d_in, const int* in_sizes, int n_in, void* d_out, int out_size, void* d_ws, size_t ws_size, hipStream_t stream) {
    static int grid = 0;
    if (grid == 0) {
        if (n_in != 18 || in_sizes[0] != MP * DM || (size_t)out_size != O_END || ws_size < WS_END) { fprintf(stderr, "kernel_launch: unexpected shapes: n_in %d in0 %d out %d ws %zu (need out %zu ws %zu)\n", n_in, n_in > 0 ? in_sizes[0] : -1, out_size, ws_size, (size_t)O_END, (size_t)WS_END); grid = -1; return; }
        int dev = 0, cus = 0;
        if (hipGetDevice(&dev) != hipSuccess || hipDeviceGetAttribute(&cus, hipDeviceAttributeMultiprocessorCount, dev) != hipSuccess) { grid = -1; return; }
        if (hipFuncSetAttribute((const void*)fwd_kernel, hipFuncAttributeMaxDynamicSharedMemorySize, LDS_BYTES) != hipSuccess) { fprintf(stderr, "kernel_launch: hipFuncSetAttribute failed\n"); grid = -1; return; }
        (void)hipGetLastError();
        grid = cus;
    }
    if (grid < 0) return;
    (void)hipMemsetAsync((char*)d_ws + WS_CTL, 0, CTL_ZERO_BYTES, stream);
    Args a{};
    for (int i = 0; i < 18; ++i) a.in[i] = (const float*)d_in[i];
    a.out = (float*)d_out; a.ws = (unsigned char*)d_ws; a.rep_id = PROBE_ID; a.rep_n = PROBE_N;
#if MK_N_LAUNCHES == 1
    a.ph_lo = 0; a.ph_hi = N_PHASES;
    hipLaunchKernelGGL(fwd_kernel, dim3(grid), dim3(NWAVES * 64), LDS_BYTES, stream, a);
#else
    for (int p = 0; p < N_PHASES; ++p) { a.ph_lo = p; a.ph_hi = p + 1; const int nr = (p == PROBE_LAUNCH ? PROBE_LAUNCH_N : 1); for (int r = 0; r < nr; ++r) { a.dry = (r + 1 < nr) ? 1 : 0; hipLaunchKernelGGL(fwd_kernel, dim3(grid), dim3(NWAVES * 64), LDS_BYTES, stream, a); } }
#endif
}
```

```cpp
#include <hip/hip_runtime.h>
#include <cstdio>
#include <cstdint>
#include <cmath>
#define USE_SLOW_GEMM 0
#define MK_N_LAUNCHES 1
#define SCAN_MODE 3
#define FLOW 0
#ifndef FLOW
#define FLOW 0
#endif
#define PG8_A_AUX ((FLOW) ? 16 : 0)
namespace pg8 {
#define PG8_LAS __attribute__((address_space(3)))
typedef unsigned short bf16_t;
typedef short bf16x8 __attribute__((ext_vector_type(8)));
typedef float f32x4 __attribute__((ext_vector_type(4)));
typedef unsigned u32x4 __attribute__((ext_vector_type(4)));
constexpr int BM = 256, BK = 64, HALF = 128, HTB = HALF * BK * 2  , STAGE_BYTES = 8 * HTB, NXCD = 8, WGM = 4;

__host__ __device__ __forceinline__ int lds_byte(int r, int c) { const int st = (r >> 4) * 2 + (c >> 5), rr = r & 15, cc = c & 31, ob = rr * 64 + cc * 2; return st * 1024 + (ob ^ (((ob >> 9) & 1) << 5)); }
__host__ __device__ __forceinline__ void stage_rc(int b, int& R, int& C) { const int st = b / 1024, sb = b % 1024, swz = sb ^ (((sb >> 9) & 1) << 5); R = (st >> 1) * 16 + swz / 64; C = (st & 1) * 32 + (swz % 64) / 2; }
__host__ __device__ __forceinline__ int perm32(int rho) { const int n = rho >> 4, i = rho & 15; return 8 * (i >> 2) + 4 * n + (i & 3); }

struct Unit { int pm, pn; };
struct Gemm { const bf16_t* A; const bf16_t* Bt; int M, N, K; };

struct StaticOrder {
    int nM, nN, nwg, G, c;
    __host__ __device__ void init(int M, int N, int G_, int c_) { nM = M / BM; nN = N / BM; nwg = nM * nN; G = G_; c = c_; }
    __host__ __device__ bool next(int i, Unit& u) const {
        const long L = (long)i * G + c; if (L >= nwg) return false;
        int wgid = (int)L; { const int q = nwg / NXCD, r = nwg % NXCD, xcd = wgid % NXCD, off = wgid / NXCD; wgid = (xcd < r ? xcd * (q + 1) : r * (q + 1) + (xcd - r) * q) + off; }
        const int nig = WGM * nN, gid = wgid / nig, fm = gid * WGM, gsz = (nM - fm) < WGM ? (nM - fm) : WGM;
        u.pm = fm + ((wgid % nig) % gsz); u.pn = (wgid % nig) / gsz; return true;
    }
    __device__ __forceinline__ void a_ready(const Unit&) const {}
    __device__ __forceinline__ void done(const Unit&) const {}
    __device__ __forceinline__ void flush() const {}
    __device__ __forceinline__ void pre_prologue() const {}
    __device__ __forceinline__ void mid_prologue() const {}
};

__device__ __forceinline__ unsigned cvt_pk_bf16(float lo, float hi) { unsigned r; asm volatile("v_cvt_pk_bf16_f32 %0, %1, %2" : "=v"(r) : "v"(lo), "v"(hi)); return r; }
template <class E, class = void> struct epi_has_init { static constexpr bool value = false; };
template <class E> struct epi_has_init<E, decltype((void)E::HAS_INIT)> { static constexpr bool value = E::HAS_INIT; };
template <class Epi, class Sched, bool ALIGN_EPI = false, bool SP2 = false>
__device__ __forceinline__ void gemm_phase(PG8_LAS unsigned char* lds, const Gemm g, const Sched& S, const Epi& E) {
    const int tid = threadIdx.x, wid = __builtin_amdgcn_readfirstlane(tid >> 6), lane = tid & 63, wr = wid >> 2, wc = wid & 3, fr = lane & 15, fq = lane >> 4;
    const int K = g.K, nt = K / BK;
    unsigned voffA[2], voffB[2];
#pragma unroll
    for (int i = 0; i < 2; ++i) { int R, C; stage_rc(tid * 16 + i * 8192, R, C); const int Rb = Epi::PERM ? ((R & ~31) + perm32(R & 31)) : R;
        voffA[i] = (unsigned)(R * K + C) * 2u; voffB[i] = (unsigned)(Rb * K + C) * 2u; }
    const size_t kstep = (size_t)(BK * 2);
    const size_t hstep = (size_t)HALF * K * 2;
    const size_t tstep = 2 * hstep;
    const unsigned ldsw = (unsigned)wid * 1024u;
    const int aoff = lds_byte(wr * 64 + fr, fq * 8), boff = lds_byte(wc * 32 + fr, fq * 8);
#define PG8_SA(b, h) (((b) * 2 + (h)) * HTB)
#define PG8_SB(b, h) ((4 + (b) * 2 + (h)) * HTB)
#define PG8_STAGE(bufoff, gbase, voff, aux) do { _Pragma("unroll") for (int _i = 0; _i < 2; ++_i) \
        __builtin_amdgcn_global_load_lds((const unsigned*)((const char*)(gbase) + (voff)[_i]), (PG8_LAS unsigned*)(lds + (bufoff) + ldsw + _i * 8192), 16, 0, aux); } while (0)
#define PG8_LDA(dst, b, h) do { _Pragma("unroll") for (int m = 0; m < 4; ++m) _Pragma("unroll") for (int k = 0; k < 2; ++k) dst[m][k] = *(const PG8_LAS bf16x8*)(lds + PG8_SA(b, h) + aoff + m * 2048 + k * 1024); } while (0)
#define PG8_LDB(dst, b, h) do { _Pragma("unroll") for (int n = 0; n < 2; ++n) _Pragma("unroll") for (int k = 0; k < 2; ++k) dst[n][k] = *(const PG8_LAS bf16x8*)(lds + PG8_SB(b, h) + boff + n * 2048 + k * 1024); } while (0)
#define PG8_MMA(ai, bj, At, Bt) do { __builtin_amdgcn_s_setprio(1); _Pragma("unroll") for (int m = 0; m < 4; ++m) _Pragma("unroll") for (int n = 0; n < 2; ++n) _Pragma("unroll") for (int k = 0; k < 2; ++k) \
        acc[ai][bj][m][n] = __builtin_amdgcn_mfma_f32_16x16x32_bf16(Bt[n][k], At[m][k], acc[ai][bj][m][n], 0, 0, 0); __builtin_amdgcn_s_setprio(0); } while (0)
#define PG8_WAIT_V(n) asm volatile("s_waitcnt vmcnt(" #n ")" ::: "memory")
#define PG8_WAIT_L(n) asm volatile("s_waitcnt lgkmcnt(" #n ")" ::: "memory")
#define PG8_BAR __builtin_amdgcn_s_barrier()
#define PG8_SCHED __builtin_amdgcn_sched_barrier(0)
    Unit cur, nxt; int ui = 0;
    if (!S.next(0, cur)) return;
    f32x4 acc[2][2][4][2];
#pragma unroll
    for (int a = 0; a < 2; ++a)
#pragma unroll
        for (int b = 0; b < 2; ++b)
#pragma unroll
            for (int m = 0; m < 4; ++m)
#pragma unroll
                for (int n = 0; n < 2; ++n) acc[a][b][m][n] = (f32x4){0.f, 0.f, 0.f, 0.f};
    if constexpr (epi_has_init<Epi>::value) E.init(acc, cur, wr, wc, fr, fq);
    bf16x8 At[4][2], B0[2][2], B1[2][2];
    const char* cA = (const char*)g.A + (size_t)cur.pm * tstep; const char* cB = (const char*)g.Bt + (size_t)cur.pn * tstep;
    S.a_ready(cur);
    if constexpr (SP2) {
        S.pre_prologue();
        PG8_STAGE(PG8_SB(0, 0), cB, voffB, 0); PG8_STAGE(PG8_SB(0, 1), cB + hstep, voffB, 0); PG8_STAGE(PG8_SA(0, 0), cA, voffA, PG8_A_AUX); PG8_STAGE(PG8_SA(0, 1), cA + hstep, voffA, PG8_A_AUX);
        S.mid_prologue();
        if (wr == 1) PG8_BAR;
        PG8_WAIT_V(2); PG8_BAR;
        PG8_STAGE(PG8_SB(1, 0), cB + kstep, voffB, 0); PG8_STAGE(PG8_SA(1, 0), cA + kstep, voffA, PG8_A_AUX); PG8_STAGE(PG8_SB(1, 1), cB + hstep + kstep, voffB, 0);
        PG8_WAIT_V(6); PG8_BAR;
    } else {
        PG8_STAGE(PG8_SB(0, 0), cB, voffB, 0); PG8_STAGE(PG8_SA(0, 0), cA, voffA, PG8_A_AUX); PG8_STAGE(PG8_SB(0, 1), cB + hstep, voffB, 0); PG8_STAGE(PG8_SA(0, 1), cA + hstep, voffA, PG8_A_AUX);
        if (wr == 1) PG8_BAR;
        PG8_WAIT_V(4); PG8_BAR;
        PG8_STAGE(PG8_SB(1, 0), cB + kstep, voffB, 0); PG8_STAGE(PG8_SA(1, 0), cA + kstep, voffA, PG8_A_AUX); PG8_STAGE(PG8_SB(1, 1), cB + hstep + kstep, voffB, 0);
        PG8_WAIT_V(6); PG8_BAR;
    }
    for (;;) {
        const bool has_next = S.next(ui + 1, nxt);
        const char* nA = has_next ? (const char*)g.A + (size_t)nxt.pm * tstep : cA; const char* nB = has_next ? (const char*)g.Bt + (size_t)nxt.pn * tstep : cB;
        for (int t = 0; t < nt; t += 2) {
            const bool last = (t == nt - 2);
            const char* a1 = cA + (size_t)(t + 1) * kstep;
            const char* a2 = last ? nA : cA + (size_t)(t + 2) * kstep; const char* b2 = last ? nB : cB + (size_t)(t + 2) * kstep;
            const char* a3 = a2 + kstep; const char* b3 = b2 + kstep;
            if (last && has_next) S.a_ready(nxt);
            if constexpr (SP2) {
            PG8_LDB(B0, 0, 0); PG8_LDB(B1, 0, 1); PG8_SCHED; PG8_LDA(At, 0, 0); PG8_STAGE(PG8_SA(1, 1), a1 + hstep, voffA, PG8_A_AUX);
            PG8_WAIT_V(8); PG8_WAIT_L(0); PG8_BAR; PG8_MMA(0, 0, At, B0); PG8_MMA(0, 1, At, B1); PG8_BAR; PG8_SCHED;
            PG8_LDA(At, 0, 1); PG8_STAGE(PG8_SB(0, 0), b2, voffB, 0); PG8_STAGE(PG8_SB(0, 1), b2 + hstep, voffB, 0); PG8_STAGE(PG8_SA(0, 0), a2, voffA, PG8_A_AUX);
            PG8_WAIT_V(8); PG8_WAIT_L(0); PG8_BAR; PG8_MMA(1, 0, At, B0); PG8_MMA(1, 1, At, B1); PG8_BAR; PG8_SCHED;
            PG8_LDB(B0, 1, 0); PG8_LDB(B1, 1, 1); PG8_SCHED; PG8_LDA(At, 1, 0); PG8_STAGE(PG8_SA(0, 1), a2 + hstep, voffA, PG8_A_AUX);
            PG8_WAIT_V(8); PG8_WAIT_L(0); PG8_BAR; PG8_MMA(0, 0, At, B0); PG8_MMA(0, 1, At, B1); PG8_BAR; PG8_SCHED;
            PG8_LDA(At, 1, 1); PG8_STAGE(PG8_SB(1, 0), b3, voffB, 0); PG8_STAGE(PG8_SB(1, 1), b3 + hstep, voffB, 0); PG8_STAGE(PG8_SA(1, 0), a3, voffA, PG8_A_AUX);
            PG8_WAIT_V(8); PG8_WAIT_L(0); PG8_BAR; PG8_MMA(1, 0, At, B0); PG8_MMA(1, 1, At, B1); PG8_BAR; PG8_SCHED;
            } else {
            PG8_LDB(B0, 0, 0); PG8_SCHED; PG8_LDA(At, 0, 0); PG8_STAGE(PG8_SA(1, 1), a1 + hstep, voffA, PG8_A_AUX);
            PG8_WAIT_L(8); PG8_BAR; PG8_WAIT_L(0); PG8_MMA(0, 0, At, B0); PG8_BAR; PG8_SCHED;
            PG8_LDB(B1, 0, 1); PG8_STAGE(PG8_SB(0, 0), b2, voffB, 0);
            PG8_BAR; PG8_WAIT_L(0); PG8_MMA(0, 1, At, B1); PG8_BAR;
            PG8_LDA(At, 0, 1); PG8_STAGE(PG8_SA(0, 0), a2, voffA, PG8_A_AUX);
            PG8_BAR; PG8_WAIT_L(0); PG8_MMA(1, 0, At, B0); PG8_BAR; PG8_SCHED;
            PG8_STAGE(PG8_SB(0, 1), b2 + hstep, voffB, 0);
            PG8_WAIT_V(6); PG8_BAR; PG8_MMA(1, 1, At, B1); PG8_BAR;
            PG8_LDB(B0, 1, 0); PG8_SCHED; PG8_LDA(At, 1, 0); PG8_STAGE(PG8_SA(0, 1), a2 + hstep, voffA, PG8_A_AUX);
            PG8_WAIT_L(8); PG8_BAR; PG8_WAIT_L(0); PG8_MMA(0, 0, At, B0); PG8_BAR; PG8_SCHED;
            PG8_LDB(B1, 1, 1); PG8_STAGE(PG8_SB(1, 0), b3, voffB, 0);
            PG8_BAR; PG8_WAIT_L(0); PG8_MMA(0, 1, At, B1); PG8_BAR;
            PG8_LDA(At, 1, 1); PG8_STAGE(PG8_SA(1, 0), a3, voffA, PG8_A_AUX);
            PG8_BAR; PG8_WAIT_L(0); PG8_MMA(1, 0, At, B0); PG8_BAR; PG8_SCHED;
            PG8_STAGE(PG8_SB(1, 1), b3 + hstep, voffB, 0);
            PG8_WAIT_V(6); PG8_BAR; PG8_MMA(1, 1, At, B1); PG8_BAR;
            }
            if (t == 0) S.flush();
        }
        if constexpr (ALIGN_EPI) { if (wr == 0) PG8_BAR; }
        if constexpr (!Epi::AFTER_DRAIN) { E(acc, cur, wr, wc, fr, fq); S.done(cur); }
        if (!has_next) break;
#pragma unroll
        for (int a = 0; a < 2; ++a)
#pragma unroll
            for (int b = 0; b < 2; ++b)
#pragma unroll
                for (int m = 0; m < 4; ++m)
#pragma unroll
                    for (int n = 0; n < 2; ++n) acc[a][b][m][n] = (f32x4){0.f, 0.f, 0.f, 0.f};
        if constexpr (epi_has_init<Epi>::value) E.init(acc, nxt, wr, wc, fr, fq);
        cur = nxt; cA = nA; cB = nB; ++ui;
        if constexpr (ALIGN_EPI) { if (wr == 1) PG8_BAR; }
    }
    PG8_WAIT_V(0);
    if constexpr (!ALIGN_EPI) { if (wr == 0) PG8_BAR; }
    PG8_BAR;
    if constexpr (Epi::AFTER_DRAIN) { E.fused(acc, cur, wr, wc, fr, fq, lds, wid, lane); S.done(cur); }
    S.flush();
#undef PG8_SA
#undef PG8_SB
#undef PG8_STAGE
#undef PG8_LDA
#undef PG8_LDB
#undef PG8_MMA
#undef PG8_WAIT_V
#undef PG8_WAIT_L
#undef PG8_BAR
#undef PG8_SCHED
}
}
constexpr int DM = 1024;
constexpr int NB_P = 8, S_P = 2048, NB_S = 128, S_S = 8;
constexpr int MP = NB_P * S_P, MS = NB_S * S_S, MT = MP + MS;
constexpr int NH = 4, DK = 256, DV = 256;
constexpr int NIN = 4096, NIN_SRC = 4104;
constexpr int DFF = 2816, NGU = 2 * DFF, NCIN = 3 * DM;
constexpr float EPS = 1e-6f;
constexpr int NWAVES = 8;

constexpr size_t O_Y = 0;
constexpr size_t O_CP = (size_t)MT * DM;
constexpr size_t O_NP = O_CP + (size_t)NB_P * NH * DV * DK;
constexpr size_t O_MP = O_NP + (size_t)NB_P * NH * DK;
constexpr size_t O_CVP = O_MP + (size_t)NB_P * NH;
constexpr size_t O_CS = O_CVP + (size_t)NB_P * 2 * DM;
constexpr size_t O_NS = O_CS + (size_t)NB_S * NH * DV * DK;
constexpr size_t O_MS = O_NS + (size_t)NB_S * NH * DK;
constexpr size_t O_CVS = O_MS + (size_t)NB_S * NH;
constexpr size_t O_END = O_CVS + (size_t)NB_S * 2 * DM;

constexpr size_t MiB = 1u << 20;
constexpr size_t WS_CTL = 0, CTL_ZERO_BYTES = 32768;
constexpr size_t WS_W_IN = 2 * MiB, WS_W_OUT = 10 * MiB, WS_W_GU0 = 12 * MiB, WS_W_DN0 = 23 * MiB, WS_W_CIN = 29 * MiB, WS_W_COUT = 35 * MiB, WS_W_GU1 = 37 * MiB, WS_W_DN1 = 48 * MiB;
constexpr size_t SSQ_BYTES = (size_t)MT * 16 * 4;
constexpr size_t WS_SSQ = 54 * MiB;
constexpr size_t WS_GATES = 59 * MiB;
constexpr size_t WS_XB = 60 * MiB;
constexpr size_t WS_A2 = 94 * MiB;
constexpr size_t WS_QKVO = 128 * MiB;
constexpr size_t WS_HFF = 128 * MiB;
constexpr size_t WS_BG = 264 * MiB, WS_U = 298 * MiB;
constexpr size_t WS_HBUF = 264 * MiB;
constexpr size_t WS_CST = 332 * MiB;
constexpr size_t WS_NST = 396 * MiB;
constexpr size_t WS_MST = WS_NST + (size_t)32 * 16 * 256 * 4;
constexpr size_t WS_GV = 397 * MiB;
constexpr size_t WS_DRY = 398 * MiB;
constexpr size_t WS_END = 398 * MiB;
static_assert(WS_SSQ + 4 * SSQ_BYTES <= WS_GATES && WS_GATES + (size_t)MT * 8 * 4 <= WS_XB && WS_XB + (size_t)MT * DM * 2 <= WS_A2 && WS_A2 + (size_t)MT * DM * 2 <= WS_QKVO, "ws map");
static_assert(WS_QKVO + (size_t)MT * NIN * 2 <= WS_HBUF && WS_HFF + (size_t)MT * DFF * 2 <= WS_HBUF && WS_BG + (size_t)MT * DM * 2 <= WS_U && WS_U + (size_t)MT * DM * 2 <= WS_CST && WS_HBUF + (size_t)MT * DM * 4 <= WS_CST, "ws map 2");
static_assert(WS_W_DN1 + (size_t)DM * DFF * 2 <= WS_SSQ, "ws map 3");
constexpr int CW_BAR = 4096;

constexpr int RING_OFF = 0, RING_BYTES = 131072;
constexpr int LDSCTL_OFF = RING_BYTES, MISC_OFF = LDSCTL_OFF + 320;
constexpr int SCR_OFF = 132096;
constexpr int LDS_BYTES = 163840;

#define GAS __attribute__((address_space(1)))
#define LAS __attribute__((address_space(3)))
typedef unsigned short bf16;
typedef unsigned v4u __attribute__((ext_vector_type(4)));
typedef unsigned v2u __attribute__((ext_vector_type(2)));
typedef float f32x4 __attribute__((ext_vector_type(4)));
typedef short bf16x8 __attribute__((ext_vector_type(8)));
typedef GAS unsigned gu32;
typedef GAS unsigned long long gu64;
#define RLX_AGENT __ATOMIC_RELAXED, __HIP_MEMORY_SCOPE_AGENT
#define LDS_WAIT() asm volatile("s_waitcnt lgkmcnt(0)" ::: "memory")
#define VM_WAIT() asm volatile("s_waitcnt vmcnt(0)" ::: "memory")
__device__ __forceinline__ unsigned f2bf(float f) { unsigned u = __builtin_bit_cast(unsigned, f); return (u + 0x7fffu + ((u >> 16) & 1u)) >> 16; }
__device__ __forceinline__ unsigned pk2(float lo, float hi) { unsigned r; asm("v_cvt_pk_bf16_f32 %0, %1, %2" : "=v"(r) : "v"(lo), "v"(hi)); return r; }
__device__ __forceinline__ void st16_wt(void* p, v4u v) { asm volatile("global_store_dwordx4 %0, %1, off sc1\n\ts_nop 1" :: "v"(p), "v"(v) : "memory"); }
__device__ __forceinline__ void st8_wt(void* p, unsigned long long v) { asm volatile("global_store_dwordx2 %0, %1, off sc1" :: "v"(p), "v"(v) : "memory"); }
__device__ __forceinline__ float bf2f(unsigned short s) { return __builtin_bit_cast(float, (unsigned)s << 16); }
__device__ __forceinline__ float bflo(unsigned w) { return __builtin_bit_cast(float, w << 16); }
__device__ __forceinline__ float bfhi(unsigned w) { return __builtin_bit_cast(float, w & 0xffff0000u); }
__device__ __forceinline__ float wave_sum(float v) {
#pragma unroll
    for (int o = 1; o < 64; o <<= 1) v += __shfl_xor(v, o);
    return v;
}
__device__ __forceinline__ float sigmoidf_(float x) { return __builtin_amdgcn_rcpf(1.f + __expf(-x)); }
__device__ __forceinline__ float logsigmoidf_(float x) { return fminf(x, 0.f) - log1pf(expf(-fabsf(x))); }
#define XB_TMO      128
#define XB_XCNT(j)  (256  + 64 * (j))
#define XB_XSUB(j)  (1280 + 64 * (j))
#define XB_XGEN(j)  (2304 + 64 * (j))
#define XB_TOP      3328
#define XB_TOPGEN   3392
#define XCD_BAR_WORDS 3456
#define XB_SPIN_CAP (1u << 18)

__device__ __forceinline__ unsigned xb_ld(unsigned* p)              { return __hip_atomic_load(p, __ATOMIC_RELAXED, __HIP_MEMORY_SCOPE_AGENT); }
__device__ __forceinline__ unsigned xb_add(unsigned* p, unsigned v) { return __hip_atomic_fetch_add(p, v, __ATOMIC_RELAXED, __HIP_MEMORY_SCOPE_AGENT); }
__device__ __forceinline__ unsigned xb_xcc_id() { return (unsigned)__builtin_amdgcn_s_getreg((3 << 11) | 20) & 0xFu; }
#define XB_SPIN(cond, bar) do { unsigned _sp = 0; while (cond) { __builtin_amdgcn_s_sleep(1); \
    if ((++_sp & 255u) == 0u) { if (xb_ld(&(bar)[XB_TMO])) break; if (_sp > XB_SPIN_CAP) { atomicAdd(&(bar)[XB_TMO], 1u); break; } } } } while (0)

struct XcdBarrier {
    unsigned* bar; unsigned x;
    volatile LAS unsigned* st;
};

__device__ __forceinline__ XcdBarrier xcd_barrier_post(unsigned* bar, volatile LAS unsigned* st) {
    XcdBarrier b; b.bar = bar; b.x = xb_xcc_id(); b.st = st;
    if (threadIdx.x == 0) (void)xb_add(&bar[XB_XCNT(b.x)], 1u);
    return b;
}
__device__ __forceinline__ void xcd_barrier_complete(unsigned* bar, unsigned x, unsigned& nloc, unsigned& nx) {
    const unsigned G = gridDim.x * gridDim.y * gridDim.z;
    unsigned sum, cnt, mine, sp = 0u;
    for (;;) {
        sum = 0u; cnt = 0u; mine = 0u;
#pragma unroll
        for (unsigned j = 0; j < 16; ++j) { const unsigned c = xb_ld(&bar[XB_XCNT(j)]); sum += c; cnt += (c > 0u) ? 1u : 0u; mine = (j == x) ? c : mine; }
        if (sum == G) break;
        __builtin_amdgcn_s_sleep(1);
        if ((++sp & 255u) == 0u) { if (xb_ld(&bar[XB_TMO])) break; if (sp > XB_SPIN_CAP) { atomicAdd(&bar[XB_TMO], 1u); break; } }
    }
    nloc = mine > 0u ? mine : 1u; nx = cnt > 0u ? cnt : 1u;
}

__device__ __forceinline__ void xcd_barrier(const XcdBarrier& b) {
    asm volatile("s_waitcnt vmcnt(0)" ::: "memory");
    __syncthreads();
    if (threadIdx.x == 0) {
        unsigned* bar = b.bar;
        __builtin_amdgcn_s_waitcnt(0);
        unsigned nloc = b.st[0], nx = b.st[1];
        if (nloc == 0u) { xcd_barrier_complete(bar, b.x, nloc, nx); b.st[0] = nloc; b.st[1] = nx; }
        const unsigned old = xb_add(&bar[XB_XSUB(b.x)], 1u);
        const unsigned gen = old / nloc;
        if (old + 1u == (gen + 1u) * nloc) {
            __builtin_amdgcn_fence(__ATOMIC_RELEASE, "agent");
            asm volatile("s_waitcnt vmcnt(0)" ::: "memory");
            const unsigned og = xb_add(&bar[XB_TOP], 1u);
            const unsigned tg = og / nx;
            if (og + 1u == (tg + 1u) * nx) xb_add(&bar[XB_TOPGEN], 1u);
            else XB_SPIN(xb_ld(&bar[XB_TOPGEN]) == tg, bar);
            __builtin_amdgcn_fence(__ATOMIC_ACQUIRE, "agent");
            xb_add(&bar[XB_XGEN(b.x)], 1u);
            asm volatile("s_waitcnt vmcnt(0)" ::: "memory");
        } else {
            XB_SPIN(xb_ld(&bar[XB_XGEN(b.x)]) == gen, bar);
            __builtin_amdgcn_fence(__ATOMIC_ACQUIRE, "agent");
            asm volatile("s_waitcnt vmcnt(0)" ::: "memory");
        }
    }
    __syncthreads();
}
struct Frame {
    LAS unsigned char* lds;
    volatile LAS unsigned* MISC;
    gu32* ctl;
    int tid, lane, wave, vcu, G;
    const float *xp, *xs, *stC, *stN, *stM, *stConv, *norm_mix, *norm_ffn, *norm_final, *w_in, *b_gate, *head_norm, *w_out, *w_cin, *w_taps, *w_cout, *w_gu, *w_dn;
    float* out; unsigned char* ws;
};
#define WSP(T, off) ((T*)(F.ws + (off)))

#ifndef EPI_RESID_WT
#define EPI_RESID_WT 1
#endif
namespace ep {
#ifndef EPI_ALL_WT
#define EPI_ALL_WT 1
#endif
__device__ __forceinline__ __amdgpu_buffer_rsrc_t wt_rsrc(const void* p, size_t bytes) { return __builtin_amdgcn_make_buffer_rsrc((void*)p, 0, (int)bytes, 0x00020000); }
using pg8::Unit; using pg8::bf16_t; using pg8::cvt_pk_bf16; using pg8::BM; using pg8::HALF; using pg8::u32x4;
__device__ __forceinline__ float row_rs(const float* slab, int row) {
    const f32x4* p = (const f32x4*)(slab + (size_t)row * 16);
    const f32x4 a = p[0], b = p[1], c = p[2], d = p[3];
    const float s = (((a.x + a.y) + (a.z + a.w)) + ((b.x + b.y) + (b.z + b.w))) + (((c.x + c.y) + (c.z + c.w)) + ((d.x + d.y) + (d.z + d.w)));
    return rsqrtf(s * (1.f / 1024.f) + EPS);
}
__device__ __forceinline__ u32x4 pack8(const f32x4 v0, const f32x4 v1) { u32x4 w; w.x = cvt_pk_bf16(v0[0], v0[1]); w.y = cvt_pk_bf16(v0[2], v0[3]); w.z = cvt_pk_bf16(v1[0], v1[1]); w.w = cvt_pk_bf16(v1[2], v1[3]); return w; }

struct EpiScale {
    static constexpr bool PERM = true, AFTER_DRAIN = false;
    bf16_t* O; int ldc; const float* ssq; const LAS float* RS; mutable int ord;
    __device__ __forceinline__ void operator()(const f32x4 (&acc)[2][2][4][2], const Unit& u, int wr, int wc, int fr, int fq) const {
        const int row0 = u.pm * BM + wr * 64 + fr, col0 = u.pn * BM + wc * 32 + 8 * fq;
#pragma unroll
        for (int ai = 0; ai < 2; ++ai)
#pragma unroll
            for (int m = 0; m < 4; ++m) { const int row = row0 + ai * HALF + m * 16; const float r = RS[ord * 256 + (row & 255)]; bf16_t* rowp = O + ((size_t)u.pn * MT + row) * 256 + wc * 32 + 8 * fq;
#pragma unroll
                for (int bj = 0; bj < 2; ++bj) {
#if EPI_ALL_WT
                    __builtin_amdgcn_raw_buffer_store_b128(pack8(acc[ai][bj][m][0] * r, acc[ai][bj][m][1] * r), wt_rsrc(O, (size_t)16 * MT * 256 * 2), (int)((((unsigned)u.pn * MT + row) * 256u + wc * 32 + 8 * fq + bj * HALF) * 2u), 0, 16);
#else
                    *(u32x4*)(rowp + bj * HALF) = pack8(acc[ai][bj][m][0] * r, acc[ai][bj][m][1] * r);
#endif
                } (void)rowp; }
        ++ord;
    }
};
__device__ __forceinline__ float silu_mul(float g, float u) { return g * __builtin_amdgcn_rcpf(1.f + __expf(-g)) * u; }
struct EpiSwiGLU {
    static constexpr bool PERM = true, AFTER_DRAIN = false;
    bf16_t* O; const float* ssq; const LAS float* RS; mutable int ord;
    __device__ __forceinline__ void operator()(const f32x4 (&acc)[2][2][4][2], const Unit& u, int wr, int wc, int fr, int fq) const {
        const int row0 = u.pm * BM + wr * 64 + fr, col0 = u.pn * HALF + wc * 32 + 8 * fq;
#pragma unroll
        for (int ai = 0; ai < 2; ++ai)
#pragma unroll
            for (int m = 0; m < 4; ++m) { const int row = row0 + ai * HALF + m * 16; const float r = RS[ord * 256 + (row & 255)];
                const f32x4 g0 = acc[ai][0][m][0] * r, g1 = acc[ai][0][m][1] * r, u0 = acc[ai][1][m][0] * r, u1 = acc[ai][1][m][1] * r;
                f32x4 h0, h1;
#pragma unroll
                for (int j = 0; j < 4; ++j) { h0[j] = silu_mul(g0[j], u0[j]); h1[j] = silu_mul(g1[j], u1[j]); }

#if EPI_ALL_WT
                __builtin_amdgcn_raw_buffer_store_b128(pack8(h0, h1), wt_rsrc(O, (size_t)MT * DFF * 2), (int)(((unsigned)row * DFF + col0) * 2u), 0, 16);
#else
                *(u32x4*)(O + (size_t)row * DFF + col0) = pack8(h0, h1);
#endif
                }
        ++ord;
    }
};
template <bool WB> struct EpiResid {
    static constexpr bool PERM = true, AFTER_DRAIN = false, HAS_INIT = true;
    bf16_t* XB; float* ssq;
    __device__ __forceinline__ void init(f32x4 (&acc)[2][2][4][2], const Unit& u, int wr, int wc, int fr, int fq) const {
        const int row0 = u.pm * BM + wr * 64 + fr, col0 = u.pn * BM + wc * 32 + 8 * fq;
#pragma unroll
        for (int ai = 0; ai < 2; ++ai)
#pragma unroll
            for (int m = 0; m < 4; ++m) { const bf16_t* xp = XB + (size_t)(row0 + ai * HALF + m * 16) * DM + col0;
#pragma unroll
                for (int bj = 0; bj < 2; ++bj) { const u32x4 bw = *(const u32x4*)(xp + bj * HALF);
                    acc[ai][bj][m][0] = (f32x4){bflo(bw.x), bfhi(bw.x), bflo(bw.y), bfhi(bw.y)}; acc[ai][bj][m][1] = (f32x4){bflo(bw.z), bfhi(bw.z), bflo(bw.w), bfhi(bw.w)}; } }
    }
    __device__ __forceinline__ void operator()(const f32x4 (&acc)[2][2][4][2], const Unit& u, int wr, int wc, int fr, int fq) const {
        const int row0 = u.pm * BM + wr * 64 + fr, col0 = u.pn * BM + wc * 32 + 8 * fq;
#if EPI_RESID_WT
        const __amdgpu_buffer_rsrc_t xrs = __builtin_amdgcn_make_buffer_rsrc((void*)XB, 0, (int)((size_t)MT * DM * 2), 0x00020000);
#endif
#pragma unroll
        for (int ai = 0; ai < 2; ++ai)
#pragma unroll
            for (int m = 0; m < 4; ++m) { const int row = row0 + ai * HALF + m * 16; bf16_t* xp = XB + (size_t)row * DM + col0; (void)xp;
                float ss = 0.f;
#pragma unroll
                for (int bj = 0; bj < 2; ++bj) { const u32x4 ow = pack8(acc[ai][bj][m][0], acc[ai][bj][m][1]);
#if EPI_RESID_WT
                    __builtin_amdgcn_raw_buffer_store_b128(ow, xrs, (int)(((unsigned)row * DM + col0 + bj * HALF) * 2u), 0, 16);
#else
                    *(u32x4*)(xp + bj * HALF) = ow;
#endif
                    if (WB) { const float r0 = bflo(ow.x), r1 = bfhi(ow.x), r2 = bflo(ow.y), r3 = bfhi(ow.y), r4 = bflo(ow.z), r5 = bfhi(ow.z), r6 = bflo(ow.w), r7 = bfhi(ow.w);
                        ss += ((r0 * r0 + r1 * r1) + (r2 * r2 + r3 * r3)) + ((r4 * r4 + r5 * r5) + (r6 * r6 + r7 * r7)); } }
                if (WB) { ss += __shfl_xor(ss, 16); ss += __shfl_xor(ss, 32); if (fq == 0) ssq[(size_t)row * 16 + u.pn * 4 + wc] = ss; } }
    }
};
struct EpiConvIn {
    static constexpr bool PERM = true, AFTER_DRAIN = false;
    bf16_t* BG; bf16_t* U; const float* ssq; float* cvP; float* cvS; const LAS float* RS; mutable int ord;
    __device__ __forceinline__ void operator()(const f32x4 (&acc)[2][2][4][2], const Unit& u, int wr, int wc, int fr, int fq) const {
        const int row0 = u.pm * BM + wr * 64 + fr;
        if (u.pn < 4) {
            const int col0 = u.pn * BM + wc * 32 + 8 * fq;
#pragma unroll
            for (int ai = 0; ai < 2; ++ai)
#pragma unroll
                for (int m = 0; m < 4; ++m) { const int row = row0 + ai * HALF + m * 16; const float r = RS[ord * 256 + (row & 255)]; bf16_t* rowp = BG + (size_t)row * DM + col0;
#pragma unroll
                    for (int bj = 0; bj < 2; ++bj) {
#if EPI_ALL_WT
                        __builtin_amdgcn_raw_buffer_store_b128(pack8(acc[ai][bj][m][0] * r, acc[ai][bj][m][1] * r), wt_rsrc(BG, (size_t)MT * DM * 2), (int)(((unsigned)row * DM + col0 + bj * HALF) * 2u), 0, 16);
#else
                        *(u32x4*)(rowp + bj * HALF) = pack8(acc[ai][bj][m][0] * r, acc[ai][bj][m][1] * r);
#endif
                    } (void)rowp; }
        } else {
            const int col0 = (u.pn - 4) * HALF + wc * 32 + 8 * fq;
#pragma unroll
            for (int ai = 0; ai < 2; ++ai)
#pragma unroll
                for (int m = 0; m < 4; ++m) { const int row = row0 + ai * HALF + m * 16; const float r = RS[ord * 256 + (row & 255)];
                    const f32x4 p0 = (acc[ai][0][m][0] * r) * (acc[ai][1][m][0] * r), p1 = (acc[ai][0][m][1] * r) * (acc[ai][1][m][1] * r);

#if EPI_ALL_WT
                    __builtin_amdgcn_raw_buffer_store_b128(pack8(p0, p1), wt_rsrc(U, (size_t)MT * DM * 2), (int)(((unsigned)row * DM + col0) * 2u), 0, 16);
#else
                    *(u32x4*)(U + (size_t)row * DM + col0) = pack8(p0, p1);
#endif
                    float* sp = nullptr;
                    if (row < MP) { const int t = row & (S_P - 1), b = row >> 11; if (t >= S_P - 2) sp = cvP + (size_t)(b * 2 + (t - (S_P - 2))) * DM + col0; }
                    else { const int rs = row - MP, t = rs & (S_S - 1), b = rs >> 3; if (t >= S_S - 2) sp = cvS + (size_t)(b * 2 + (t - (S_S - 2))) * DM + col0; }
                    if (sp) { *(f32x4*)sp = p0; *(f32x4*)(sp + 4) = p1; } }
        }
        ++ord;
    }
};
}

template <class Epi, class Sched>
__device__ __forceinline__ void gemm_phase_slow(const pg8::Gemm g, const Sched& S, const Epi& E) {
    const int tid = threadIdx.x, wid = __builtin_amdgcn_readfirstlane(tid >> 6), lane = tid & 63, wr = wid >> 2, wc = wid & 3, fr = lane & 15, fq = lane >> 4;
    const int K = g.K;
    pg8::Unit u;
    for (int i = 0; S.next(i, u); ++i) {
        f32x4 acc[2][2][4][2];
#pragma unroll
        for (int a = 0; a < 2; ++a)
#pragma unroll
            for (int b = 0; b < 2; ++b)
#pragma unroll
                for (int m = 0; m < 4; ++m)
#pragma unroll
                    for (int n = 0; n < 2; ++n) acc[a][b][m][n] = (f32x4){0.f, 0.f, 0.f, 0.f};
        const unsigned offA = (unsigned)(wr * 64 + fr) * (unsigned)K * 2u, offB = (unsigned)(wc * 32 + (Epi::PERM ? 8 * fq : 4 * fq)) * (unsigned)K * 2u;
        const char* Au = (const char*)g.A + (size_t)u.pm * 256 * K * 2; const char* Bu = (const char*)g.Bt + (size_t)u.pn * 256 * K * 2;
#pragma unroll
        for (int ai = 0; ai < 2; ++ai) {
#pragma unroll 1
        for (int k0 = 0; k0 < K; k0 += 2) {
            float af[4][2];
#pragma unroll
            for (int m = 0; m < 4; ++m) { const unsigned w = *(const unsigned*)(Au + ((size_t)(ai * 128 + m * 16) * K + k0) * 2 + offA); af[m][0] = bflo(w); af[m][1] = bfhi(w); }
#pragma unroll
            for (int bj = 0; bj < 2; ++bj)
#pragma unroll
                for (int n = 0; n < 2; ++n)
#pragma unroll
                    for (int j = 0; j < 4; ++j) { const unsigned w = *(const unsigned*)(Bu + ((size_t)(bj * 128 + (Epi::PERM ? 4 * n : 16 * n) + j) * K + k0) * 2 + offB);
                        const float b0 = bflo(w), b1 = bfhi(w);
#pragma unroll
                        for (int m = 0; m < 4; ++m) acc[ai][bj][m][n][j] += af[m][0] * b0 + af[m][1] * b1; }
        }
        }
        E(acc, u, wr, wc, fr, fq);
    }
}
#ifndef USE_SLOW_GEMM
#define USE_SLOW_GEMM 0
#endif
template <class Epi, bool ALIGN, bool SP2>
__device__ __forceinline__ void run_gemm(Frame& F, const pg8::Gemm g, const Epi& E) {
    pg8::StaticOrder S; S.init(g.M, g.N, F.G, (int)blockIdx.x);
#if USE_SLOW_GEMM
    gemm_phase_slow<Epi, pg8::StaticOrder>(g, S, E);
#else
    pg8::gemm_phase<Epi, pg8::StaticOrder, ALIGN, SP2>(F.lds + RING_OFF, g, S, E);
#endif
}
constexpr int RS_MAX_UNITS = 7;
struct RsOrder : pg8::StaticOrder {
    const float* ssq; LAS float* RS; int tid;
    mutable f32x4 pv[4][4];
    __device__ __forceinline__ void pre_prologue() const {
#pragma unroll
        for (int k = 0; k < 4; ++k) { const int task = tid + 512 * k, i = task >> 8, r = task & 255; pg8::Unit u;
            if (i < RS_MAX_UNITS && next(i, u)) { const f32x4* p = (const f32x4*)(ssq + (size_t)(u.pm * 256 + r) * 16);
#pragma unroll
                for (int j = 0; j < 4; ++j) pv[k][j] = p[j]; } }
    }
    __device__ __forceinline__ void mid_prologue() const {
#pragma unroll
        for (int k = 0; k < 4; ++k) { const int task = tid + 512 * k, i = task >> 8, r = task & 255; pg8::Unit u;
            if (i < RS_MAX_UNITS && next(i, u)) { const f32x4 s4 = (pv[k][0] + pv[k][1]) + (pv[k][2] + pv[k][3]);
                RS[i * 256 + r] = rsqrtf(((s4.x + s4.y) + (s4.z + s4.w)) * (1.f / 1024.f) + EPS); } }
    }
};
template <class Epi, bool ALIGN, bool SP2>
__device__ __forceinline__ void run_gemm_rs(Frame& F, const pg8::Gemm g, Epi& E) {
    static_assert(RS_MAX_UNITS <= 8, "four tasks per thread cover 8 units");
    RsOrder S; S.init(g.M, g.N, F.G, (int)blockIdx.x); S.ssq = E.ssq; S.RS = (LAS float*)(F.lds + SCR_OFF); S.tid = F.tid;
    E.RS = S.RS; E.ord = 0;
    pg8::gemm_phase<Epi, RsOrder, ALIGN, SP2>(F.lds + RING_OFF, g, S, E);
}

#ifndef TS_PROBE
#define TS_PROBE -1
#endif
#if TS_PROBE >= 0
#define P0STAMP(i) do { if (blockIdx.x == 0 && F.tid == 0) ((unsigned long long*)(F.ctl + 2048))[(i)] = __builtin_amdgcn_s_memrealtime(); } while (0)
#define BLKSTAMP(s) do { if (F.tid == 0) ((unsigned long long*)(F.ctl + 8192))[(s) * 256 + blockIdx.x] = __builtin_amdgcn_s_memrealtime(); } while (0)
#else
#define P0STAMP(i) do { } while (0)
#define BLKSTAMP(s) do { } while (0)
#endif
__device__ __forceinline__ int map_row(int kind, int n0) {
    if (kind == 2) { if (n0 < DFF) return 256 * (n0 >> 7) + (n0 & 127); const int j = n0 - DFF; return 256 * (j >> 7) + 128 + (j & 127); }
    if (kind == 3) { if (n0 < DM) return n0; if (n0 < 2 * DM) { const int j = n0 - DM; return DM + 256 * (j >> 7) + (j & 127); } const int j = n0 - 2 * DM; return DM + 256 * (j >> 7) + 128 + (j & 127); }
    return n0;
}
__device__ __forceinline__ void p0_transpose_item(const float* __restrict__ W, int K, int N, int ldw, bf16* __restrict__ WT, int kind, const float* __restrict__ kscale, int item, int lane) {
    const int nblk = N / 64, kb = item / nblk, nb = item % nblk, k0 = 64 * kb, n0 = 64 * nb;
    const float ns = (kind == 1 && n0 < 1024) ? 0.0625f : 1.f;
    const float* src = W + (size_t)k0 * ldw + n0 + lane;
    float v[64];
#pragma unroll
    for (int i = 0; i < 64; ++i) v[i] = __builtin_nontemporal_load(src + (size_t)i * ldw);
    bf16* dst = WT + (size_t)(map_row(kind, n0 & ~127) + (n0 & 127) + lane) * K + k0;
#pragma unroll
    for (int c = 0; c < 8; ++c) {
        float s[8];
#pragma unroll
        for (int e = 0; e < 8; ++e) s[e] = v[8 * c + e] * (kscale ? kscale[k0 + 8 * c + e] * ns : ns);
        v4u o; o.x = pk2(s[0], s[1]); o.y = pk2(s[2], s[3]); o.z = pk2(s[4], s[5]); o.w = pk2(s[6], s[7]);
        *(GAS v4u*)(dst + 8 * c) = o;
    }
}
#define P0_DYN 1
#ifndef P0_BGFLUSH
#define P0_BGFLUSH 0
#endif
__device__ __forceinline__ void p0_prologue(Frame& F, gu32* READY, unsigned magic) {
    const int gw = F.vcu * NWAVES + F.wave, NGW = F.G * NWAVES;
    float wgv[16];
#pragma unroll
    for (int i = 0; i < 16; ++i) { const int idx = F.tid + i * NWAVES * 64, k = idx >> 3, jg = idx & 7; wgv[i] = F.w_in[(size_t)k * NIN_SRC + NIN + jg] * F.norm_mix[k]; }
    constexpr int I0 = 16 * 64, I1 = 16 * 16, I2 = 16 * 88, I3 = 44 * 16, I4 = 16 * 48, I5 = 16 * 16, I6 = I2, I7 = I3;
    constexpr int NITEMS = I0 + I1 + I2 + I3 + I4 + I5 + I6 + I7;
    const int NS = 2 * NGW < NITEMS ? 2 * NGW : NITEMS, ND_IT = NITEMS - NS, ND = ND_IT + MT / 2;
    LAS float* WG = (LAS float*)(F.lds + RING_OFF);
    bf16* XB = WSP(bf16, WS_XB); float* SSQ0 = WSP(float, WS_SSQ); float* GATES = WSP(float, WS_GATES);
    gu32* head = F.ctl + 1024 + 64 * F.wave;
    unsigned tn = 0, t = 0;
    for (int step = 0;; ++step) {
        int w = -1;
        if (step < 2) {
            if (step == 1) { if (F.lane == 0) { unsigned sp = 0; while (__hip_atomic_load(READY, RLX_AGENT) != magic) { __builtin_amdgcn_s_sleep(2); if (++sp > (1u << 22)) break; } tn = __hip_atomic_fetch_add(head, 1u, RLX_AGENT); } }
            const int it = gw + step * NGW; if (it < NS) w = it;
        } else {
            if (step == 2) {
                P0STAMP(20); BLKSTAMP(1);
#pragma unroll
                for (int i = 0; i < 16; ++i) { const int idx = F.tid + i * NWAVES * 64, k = idx >> 3, jg = idx & 7; WG[(((k >> 8) * 4 + (k & 3)) * 64 + ((k & 255) >> 2)) * 8 + jg] = wgv[i]; }
                asm volatile("s_waitcnt lgkmcnt(0)" ::: "memory"); __builtin_amdgcn_s_barrier(); asm volatile("" ::: "memory");
                P0STAMP(21);
                { float* z = WSP(float, WS_SSQ) + (size_t)MT * 16;
                  for (int i = F.vcu * NWAVES * 64 + F.tid; i < 3 * MS * 16; i += F.G * NWAVES * 64) { const int s = i / (MS * 16), o = i % (MS * 16); z[(size_t)s * MT * 16 + (size_t)MP * 16 + o] = 0.f; } }
            }
            t = __builtin_amdgcn_readfirstlane(tn);
            const int c = (int)t * NWAVES + F.wave; if (c >= ND) break;
            if (F.lane == 0) tn = __hip_atomic_fetch_add(head, 1u, RLX_AGENT);
            if (P0_BGFLUSH && (F.vcu & 31) == 0 && F.wave == 0) asm volatile("buffer_wbl2 sc1" ::: "memory");
            w = c < ND_IT ? NS + c : NITEMS + (c - ND_IT);
        }
        if (w < 0) continue;
        if (w < NITEMS) {
            int r = w;
            if (r < I0) { p0_transpose_item(F.w_in, DM, NIN, NIN_SRC, WSP(bf16, WS_W_IN), 1, F.norm_mix, r, F.lane); continue; } r -= I0;
            if (r < I1) { p0_transpose_item(F.w_out, DM, DM, DM, WSP(bf16, WS_W_OUT), 0, nullptr, r, F.lane); continue; } r -= I1;
            if (r < I2) { p0_transpose_item(F.w_gu, DM, NGU, NGU, WSP(bf16, WS_W_GU0), 2, F.norm_ffn, r, F.lane); continue; } r -= I2;
            if (r < I3) { p0_transpose_item(F.w_dn, DFF, DM, DM, WSP(bf16, WS_W_DN0), 0, nullptr, r, F.lane); continue; } r -= I3;
            if (r < I4) { p0_transpose_item(F.w_cin, DM, NCIN, NCIN, WSP(bf16, WS_W_CIN), 3, F.norm_mix + DM, r, F.lane); continue; } r -= I4;
            if (r < I5) { p0_transpose_item(F.w_cout, DM, DM, DM, WSP(bf16, WS_W_COUT), 0, nullptr, r, F.lane); continue; } r -= I5;
            if (r < I6) { p0_transpose_item(F.w_gu + (size_t)DM * NGU, DM, NGU, NGU, WSP(bf16, WS_W_GU1), 2, F.norm_ffn + DM, r, F.lane); continue; } r -= I6;
            p0_transpose_item(F.w_dn + (size_t)DFF * DM, DFF, DM, DM, WSP(bf16, WS_W_DN1), 0, nullptr, r, F.lane);
            continue;
        }
        const int row0 = 2 * (w - NITEMS);
        int lane = F.lane; asm volatile("" : "+v"(lane));
        const int gidx = 4 * ((lane >> 5) & 1) + 2 * ((lane >> 4) & 1) + ((lane >> 3) & 1);
        const float bg_l = F.b_gate[gidx];
        f32x4 v[2][4]; float s[2] = {0.f, 0.f};
#pragma unroll
        for (int rr = 0; rr < 2; ++rr) { const int row = row0 + rr; const float* xrow = row < MP ? F.xp + (size_t)row * DM : F.xs + (size_t)(row - MP) * DM; const GAS f32x4* xr = (const GAS f32x4*)xrow + lane;
#pragma unroll
            for (int j = 0; j < 4; ++j) v[rr][j] = __builtin_nontemporal_load(xr + 64 * j); }
#pragma unroll
        for (int rr = 0; rr < 2; ++rr) {
            const int row = row0 + rr;
#pragma unroll
            for (int j = 0; j < 4; ++j) s[rr] += (v[rr][j].x * v[rr][j].x + v[rr][j].y * v[rr][j].y) + (v[rr][j].z * v[rr][j].z + v[rr][j].w * v[rr][j].w);
            const float ssq = wave_sum(s[rr]), r = rsqrtf(ssq * (1.f / 1024.f) + EPS);
            {
                const __amdgpu_buffer_rsrc_t xrs = __builtin_amdgcn_make_buffer_rsrc((void*)XB, 0, (int)((size_t)MT * DM * 2), 0x00020000);
                const bool odd = lane & 1;
#pragma unroll
                for (int jp = 0; jp < 2; ++jp) {
                    const unsigned a0 = pk2(v[rr][2 * jp].x, v[rr][2 * jp].y), a1 = pk2(v[rr][2 * jp].z, v[rr][2 * jp].w), b0 = pk2(v[rr][2 * jp + 1].x, v[rr][2 * jp + 1].y), b1 = pk2(v[rr][2 * jp + 1].z, v[rr][2 * jp + 1].w);
                    const unsigned s0 = odd ? a0 : b0, s1 = odd ? a1 : b1;
                    const unsigned r0 = (unsigned)__shfl_xor((int)s0, 1), r1 = (unsigned)__shfl_xor((int)s1, 1);
                    v4u o; if (odd) { o.x = r0; o.y = r1; o.z = b0; o.w = b1; } else { o.x = a0; o.y = a1; o.z = r0; o.w = r1; }
                    __builtin_amdgcn_raw_buffer_store_b128(o, xrs, (int)(((unsigned)row * DM + 256 * (2 * jp + (odd ? 1 : 0)) + 4 * (lane & ~1)) * 2u), 0, 16);
                } }
            if (lane < 16) SSQ0[(size_t)row * 16 + lane] = lane == 0 ? ssq : 0.f;
            f32x4 ga = (f32x4){0.f, 0.f, 0.f, 0.f}, gb = ga;
#pragma unroll
            for (int j = 0; j < 4; ++j)
#pragma unroll
                for (int e = 0; e < 4; ++e) { const LAS float* wp = WG + ((j * 4 + e) * 64 + lane) * 8; const f32x4 w0 = *(const LAS f32x4*)wp, w1 = *(const LAS f32x4*)(wp + 4); ga += w0 * v[rr][j][e]; gb += w1 * v[rr][j][e]; }
            float t4[4], t2[2], t1;
#pragma unroll
            for (int i = 0; i < 4; ++i) { const float snd = (lane & 32) ? ga[i] : gb[i], kp = (lane & 32) ? gb[i] : ga[i]; t4[i] = kp + __shfl_xor(snd, 32); }
#pragma unroll
            for (int i = 0; i < 2; ++i) { const float snd = (lane & 16) ? t4[i] : t4[2 + i], kp = (lane & 16) ? t4[2 + i] : t4[i]; t2[i] = kp + __shfl_xor(snd, 16); }
            { const float snd = (lane & 8) ? t2[0] : t2[1], kp = (lane & 8) ? t2[1] : t2[0]; t1 = kp + __shfl_xor(snd, 8); }
            t1 += __shfl_xor(t1, 1); t1 += __shfl_xor(t1, 2); t1 += __shfl_xor(t1, 4);
            const float gate = t1 * r + bg_l;
            if ((lane & 7) == 0) GATES[(size_t)row * 8 + gidx] = gidx < 4 ? gate : logsigmoidf_(gate);
        }
    }
    P0STAMP(25); BLKSTAMP(2);
}

__device__ __forceinline__ void scan_oracle(Frame& F, const bool do_p, const bool do_s, const bool wr_p) {
    const bf16* QKVO = WSP(bf16, WS_QKVO); const float* GATES = WSP(float, WS_GATES); float* HBUF = WSP(float, WS_HBUF);
    constexpr int NU_P = NB_P * NH * 32, NU_S = NB_S * NH * 32;
    for (int un = F.vcu + (do_p ? 0 : NU_P); un < (do_s ? NU_P + NU_S : NU_P); un += F.G) {
        const bool smp = un >= NU_P; const int uu = smp ? un - NU_P : un; const int vg = uu & 31, h = (uu >> 5) & 3, b = uu >> 7;
        const int S = smp ? S_S : S_P, rowbase = smp ? MP + b * S_S : b * S_P;
        const int v = 8 * vg + F.wave, d0 = 4 * F.lane;
        f32x4 C = (f32x4){0.f, 0.f, 0.f, 0.f}, n = C; float m = 0.f;
        if (smp) { C = *(const f32x4*)(F.stC + ((size_t)(b * NH + h) * DV + v) * DK + d0); n = *(const f32x4*)(F.stN + (size_t)(b * NH + h) * DK + d0); m = F.stM[b * NH + h]; }
        for (int t0 = 0; t0 < S; t0 += 8) {
            v2u qw[8], kw[8]; unsigned short vw[8]; float li[8], lf[8];
#pragma unroll
            for (int i = 0; i < 8; ++i) { const size_t row = (size_t)(rowbase + t0 + i); const bf16* bp = QKVO + row * NIN + 256 * h;
                qw[i] = *(const v2u*)(bp + d0); kw[i] = *(const v2u*)(bp + 1024 + d0); vw[i] = bp[2048 + v]; li[i] = GATES[row * 8 + h]; lf[i] = GATES[row * 8 + 4 + h]; }
#pragma unroll
            for (int i = 0; i < 8; ++i) {
                const float mn = fmaxf(lf[i] + m, li[i]), a = expf(lf[i] + m - mn), wi = expf(li[i] - mn), vf = bf2f(vw[i]) * wi;
                const f32x4 kf = (f32x4){bflo(kw[i].x), bfhi(kw[i].x), bflo(kw[i].y), bfhi(kw[i].y)}, qf = (f32x4){bflo(qw[i].x), bfhi(qw[i].x), bflo(qw[i].y), bfhi(qw[i].y)};
                C = C * a + kf * vf; n = n * a + kf * wi;
                float num = (C.x * qf.x + C.y * qf.y) + (C.z * qf.z + C.w * qf.w), den = (n.x * qf.x + n.y * qf.y) + (n.z * qf.z + n.w * qf.w);
                num = wave_sum(num); den = wave_sum(den);
                const float hv = num / fmaxf(fabsf(den), expf(-mn));
                if (F.lane == 0) HBUF[(size_t)(rowbase + t0 + i) * DM + 256 * h + v] = hv;
                m = mn;
            }
        }
        if (!smp && !wr_p) continue;
        float* Co = F.out + (smp ? O_CS : O_CP) + ((size_t)(b * NH + h) * DV + v) * DK + d0; *(f32x4*)Co = C;
        if (vg == 0 && F.wave == 0) { *(f32x4*)(F.out + (smp ? O_NS : O_NP) + (size_t)(b * NH + h) * DK + d0) = n; if (F.lane == 0) F.out[(smp ? O_MS : O_MP) + b * NH + h] = m; }
    }
}
__device__ __forceinline__ void gate_pass(Frame& F, const int row_lo, const int row_hi) {
    const bf16* QKVO = WSP(bf16, WS_QKVO); const float* HBUF = WSP(float, WS_HBUF); bf16* A2 = WSP(bf16, WS_A2);
    const int gw = F.vcu * NWAVES + F.wave, NGW = F.G * NWAVES;
    for (int row = row_lo + gw; row < row_hi; row += NGW) {
        const f32x4* hr = (const f32x4*)(HBUF + (size_t)row * DM) + F.lane; const v2u* orow = (const v2u*)(QKVO + (size_t)row * NIN + 3072) + F.lane; const f32x4* gr = (const f32x4*)F.head_norm + F.lane;
        v2u* o8 = (v2u*)(A2 + (size_t)row * DM) + F.lane;
#pragma unroll
        for (int j = 0; j < 4; ++j) { const f32x4 hv = hr[64 * j], g = gr[64 * j]; const v2u ow = orow[64 * j];
            const float ss = wave_sum((hv.x * hv.x + hv.y * hv.y) + (hv.z * hv.z + hv.w * hv.w)), rn = rsqrtf(ss * (1.f / 256.f) + EPS);
            v2u w; w.x = pk2(hv.x * rn * g.x * sigmoidf_(bflo(ow.x)), hv.y * rn * g.y * sigmoidf_(bfhi(ow.x))); w.y = pk2(hv.z * rn * g.z * sigmoidf_(bflo(ow.y)), hv.w * rn * g.w * sigmoidf_(bfhi(ow.y)));
            o8[64 * j] = w; }
    }
}
__device__ __forceinline__ void unpack8(const v4u w, float (&f)[8]) { f[0] = bflo(w.x); f[1] = bfhi(w.x); f[2] = bflo(w.y); f[3] = bfhi(w.y); f[4] = bflo(w.z); f[5] = bfhi(w.z); f[6] = bflo(w.w); f[7] = bfhi(w.w); }
__device__ __forceinline__ void conv_pass_generic(Frame& F) {
    const bf16* __restrict__ BG = WSP(bf16, WS_BG); const bf16* __restrict__ U = WSP(bf16, WS_U); bf16* __restrict__ A2 = WSP(bf16, WS_A2);
    const int gw = F.vcu * NWAVES + F.wave, NGW = F.G * NWAVES;
    float tw[3][2][8];
#pragma unroll
    for (int k = 0; k < 3; ++k)
#pragma unroll
        for (int j = 0; j < 2; ++j) { const f32x4 a = *(const f32x4*)(F.w_taps + k * DM + 8 * F.lane + 512 * j), c = *(const f32x4*)(F.w_taps + k * DM + 8 * F.lane + 512 * j + 4);
            tw[k][j][0] = a.x; tw[k][j][1] = a.y; tw[k][j][2] = a.z; tw[k][j][3] = a.w; tw[k][j][4] = c.x; tw[k][j][5] = c.y; tw[k][j][6] = c.z; tw[k][j][7] = c.w; }
    for (int blk = gw; blk < MT / 4; blk += NGW) {
        const int r0 = 4 * blk; const bool smp = r0 >= MP; const int t0 = smp ? (r0 - MP) & (S_S - 1) : r0 & (S_P - 1), bq = smp ? (r0 - MP) >> 3 : r0 >> 11;
        float p2[2][8], p1[2][8];
#pragma unroll
        for (int j = 0; j < 2; ++j) {
            if (t0 >= 2) { unpack8(*(const v4u*)(U + (size_t)(r0 - 2) * DM + 8 * F.lane + 512 * j), p2[j]); unpack8(*(const v4u*)(U + (size_t)(r0 - 1) * DM + 8 * F.lane + 512 * j), p1[j]); }
            else if (smp) { const float* sb = F.stConv + (size_t)bq * 2 * DM + 8 * F.lane + 512 * j; const f32x4 a0 = *(const f32x4*)sb, a1 = *(const f32x4*)(sb + 4), c0 = *(const f32x4*)(sb + DM), c1 = *(const f32x4*)(sb + DM + 4);
                p2[j][0] = a0.x; p2[j][1] = a0.y; p2[j][2] = a0.z; p2[j][3] = a0.w; p2[j][4] = a1.x; p2[j][5] = a1.y; p2[j][6] = a1.z; p2[j][7] = a1.w;
                p1[j][0] = c0.x; p1[j][1] = c0.y; p1[j][2] = c0.z; p1[j][3] = c0.w; p1[j][4] = c1.x; p1[j][5] = c1.y; p1[j][6] = c1.z; p1[j][7] = c1.w; }
            else {
#pragma unroll
                for (int e = 0; e < 8; ++e) { p2[j][e] = 0.f; p1[j][e] = 0.f; } }
        }
#pragma unroll
        for (int ih = 0; ih < 2; ++ih) {
            v4u uc[2][2], bgw[2][2];
#pragma unroll
            for (int i = 0; i < 2; ++i)
#pragma unroll
                for (int j = 0; j < 2; ++j) { uc[i][j] = __builtin_nontemporal_load((const v4u*)(U + (size_t)(r0 + 2 * ih + i) * DM + 8 * F.lane + 512 * j)); bgw[i][j] = __builtin_nontemporal_load((const v4u*)(BG + (size_t)(r0 + 2 * ih + i) * DM + 8 * F.lane + 512 * j)); }
#pragma unroll
            for (int i = 0; i < 2; ++i)
#pragma unroll
                for (int j = 0; j < 2; ++j) { float cur[8], bg[8], y[8]; unpack8(uc[i][j], cur); unpack8(bgw[i][j], bg);
#pragma unroll
                    for (int e = 0; e < 8; ++e) { y[e] = bg[e] * (tw[0][j][e] * p2[j][e] + tw[1][j][e] * p1[j][e] + tw[2][j][e] * cur[e]); p2[j][e] = p1[j][e]; p1[j][e] = cur[e]; }
                    v4u o; o.x = pk2(y[0], y[1]); o.y = pk2(y[2], y[3]); o.z = pk2(y[4], y[5]); o.w = pk2(y[6], y[7]);
                    *(v4u*)(A2 + (size_t)(r0 + 2 * ih + i) * DM + 8 * F.lane + 512 * j) = o; }
        }
    }
}

__device__ __forceinline__ void conv_pass(Frame& F) {
    if (F.G * 17 != MT / 4) { conv_pass_generic(F); return; }
    const bf16* __restrict__ BG = WSP(bf16, WS_BG); const bf16* __restrict__ U = WSP(bf16, WS_U); bf16* __restrict__ A2 = WSP(bf16, WS_A2);
    const __amdgpu_buffer_rsrc_t a2rs = __builtin_amdgcn_make_buffer_rsrc((void*)A2, 0, (int)((size_t)MT * DM * 2), 0x00020000);
    int lane = F.lane; asm volatile("" : "+v"(lane));
    const int j = F.wave & 1, q = F.wave >> 1, ch0 = 512 * j + 8 * lane;
    float tw[3][8];
#pragma unroll
    for (int k = 0; k < 3; ++k) { const f32x4 a = *(const f32x4*)(F.w_taps + k * DM + ch0), c = *(const f32x4*)(F.w_taps + k * DM + ch0 + 4);
        tw[k][0] = a.x; tw[k][1] = a.y; tw[k][2] = a.z; tw[k][3] = a.w; tw[k][4] = c.x; tw[k][5] = c.y; tw[k][6] = c.z; tw[k][7] = c.w; }
    v4u cu[4], cb[4], ch2 = (v4u){0u, 0u, 0u, 0u}, ch1 = ch2, nu[4], nb[4], nh2 = ch2, nh1 = ch2;
#define CV_T0(r0_) ((r0_) >= MP ? (((r0_) - MP) & (S_S - 1)) : ((r0_) & (S_P - 1)))
#define CV_LOAD(U_, B_, H2_, H1_, blk_) do { const int r0_ = 4 * (blk_); \
        _Pragma("unroll") for (int i = 0; i < 4; ++i) { U_[i] = __builtin_nontemporal_load((const v4u*)(U + (size_t)(r0_ + i) * DM + ch0)); B_[i] = __builtin_nontemporal_load((const v4u*)(BG + (size_t)(r0_ + i) * DM + ch0)); } \
        if (CV_T0(r0_) >= 2) { H2_ = *(const v4u*)(U + (size_t)(r0_ - 2) * DM + ch0); H1_ = *(const v4u*)(U + (size_t)(r0_ - 1) * DM + ch0); } } while (0)
    CV_LOAD(cu, cb, ch2, ch1, 17 * F.vcu + q);
    for (int u = 0; u < 4; ++u) {
        const int blk = 17 * F.vcu + 4 * u + q, r0 = 4 * blk; const bool smp = r0 >= MP; const int t0 = CV_T0(r0), bq = smp ? (r0 - MP) >> 3 : r0 >> 11;
        if (u + 1 < 4) CV_LOAD(nu, nb, nh2, nh1, blk + 4);
        float p2[8], p1[8];
        if (t0 >= 2) { unpack8(ch2, p2); unpack8(ch1, p1); }
        else if (smp) { const float* sb = F.stConv + (size_t)bq * 2 * DM + ch0; const f32x4 a0 = *(const f32x4*)sb, a1 = *(const f32x4*)(sb + 4), c0 = *(const f32x4*)(sb + DM), c1 = *(const f32x4*)(sb + DM + 4);
            p2[0] = a0.x; p2[1] = a0.y; p2[2] = a0.z; p2[3] = a0.w; p2[4] = a1.x; p2[5] = a1.y; p2[6] = a1.z; p2[7] = a1.w;
            p1[0] = c0.x; p1[1] = c0.y; p1[2] = c0.z; p1[3] = c0.w; p1[4] = c1.x; p1[5] = c1.y; p1[6] = c1.z; p1[7] = c1.w; }
        else {
#pragma unroll
            for (int e = 0; e < 8; ++e) { p2[e] = 0.f; p1[e] = 0.f; } }
#pragma unroll
        for (int i = 0; i < 4; ++i) { float cur[8], bg[8], y[8]; unpack8(cu[i], cur); unpack8(cb[i], bg);
#pragma unroll
            for (int e = 0; e < 8; ++e) { y[e] = bg[e] * (tw[0][e] * p2[e] + tw[1][e] * p1[e] + tw[2][e] * cur[e]); p2[e] = p1[e]; p1[e] = cur[e]; }
            v4u o; o.x = pk2(y[0], y[1]); o.y = pk2(y[2], y[3]); o.z = pk2(y[4], y[5]); o.w = pk2(y[6], y[7]);
            __builtin_amdgcn_raw_buffer_store_b128(o, a2rs, (int)(((unsigned)(r0 + i) * DM + ch0) * 2u), 0, 16); }
#pragma unroll
        for (int i = 0; i < 4; ++i) { cu[i] = nu[i]; cb[i] = nb[i]; }
        ch2 = nh2; ch1 = nh1;
    }
#undef CV_LOAD
    {
        const int blk = 17 * F.vcu + 16, r0 = 4 * blk, c = 512 * j + 128 * q + 2 * lane; const bool smp = r0 >= MP; const int t0 = CV_T0(r0), bq = smp ? (r0 - MP) >> 3 : r0 >> 11;
        unsigned ucw[4], bgq[4];
#pragma unroll
        for (int i = 0; i < 4; ++i) { ucw[i] = __builtin_nontemporal_load((const unsigned*)(U + (size_t)(r0 + i) * DM + c)); bgq[i] = __builtin_nontemporal_load((const unsigned*)(BG + (size_t)(r0 + i) * DM + c)); }
        float tq[3][2], q2[2], q1[2];
#pragma unroll
        for (int k = 0; k < 3; ++k) { tq[k][0] = F.w_taps[k * DM + c]; tq[k][1] = F.w_taps[k * DM + c + 1]; }
        if (t0 >= 2) { const unsigned h2 = *(const unsigned*)(U + (size_t)(r0 - 2) * DM + c), h1 = *(const unsigned*)(U + (size_t)(r0 - 1) * DM + c); q2[0] = bflo(h2); q2[1] = bfhi(h2); q1[0] = bflo(h1); q1[1] = bfhi(h1); }
        else if (smp) { const float* sb = F.stConv + (size_t)bq * 2 * DM + c; q2[0] = sb[0]; q2[1] = sb[1]; q1[0] = sb[DM]; q1[1] = sb[DM + 1]; }
        else { q2[0] = q2[1] = q1[0] = q1[1] = 0.f; }
#pragma unroll
        for (int i = 0; i < 4; ++i) { const float cw[2] = {bflo(ucw[i]), bfhi(ucw[i])}, bg[2] = {bflo(bgq[i]), bfhi(bgq[i])}; float y[2];
#pragma unroll
            for (int e = 0; e < 2; ++e) { y[e] = bg[e] * (tq[0][e] * q2[e] + tq[1][e] * q1[e] + tq[2][e] * cw[e]); q2[e] = q1[e]; q1[e] = cw[e]; }
            *(unsigned*)(A2 + (size_t)(r0 + i) * DM + c) = pk2(y[0], y[1]); }
    }
#undef CV_T0
}

__device__ __forceinline__ void final_norm(Frame& F) {
    const bf16* __restrict__ XB = WSP(bf16, WS_XB);
    const int gw = F.vcu * NWAVES + F.wave, NGW = F.G * NWAVES;
    int lane = F.lane; asm volatile("" : "+v"(lane));
    f32x4 gr[4];
#pragma unroll
    for (int j = 0; j < 4; ++j) gr[j] = *((const f32x4*)F.norm_final + lane + 64 * j);
    v2u cur[4][4], nxt[4][4];
#define FN_LOAD(buf, r0) do { _Pragma("unroll") for (int rr = 0; rr < 4; ++rr) { const int row = (r0) + rr * NGW; if (row < MT) { _Pragma("unroll") for (int j = 0; j < 4; ++j) buf[rr][j] = __builtin_nontemporal_load((const v2u*)(XB + (size_t)row * DM) + lane + 64 * j); } } } while (0)
    FN_LOAD(cur, gw);
    for (int row0 = gw; row0 < MT; row0 += 4 * NGW) {
        if (row0 + 4 * NGW < MT) FN_LOAD(nxt, row0 + 4 * NGW);
#pragma unroll
        for (int rr = 0; rr < 4; ++rr) { const int row = row0 + rr * NGW; if (row >= MT) continue;
            f32x4 v[4]; float s = 0.f;
#pragma unroll
            for (int j = 0; j < 4; ++j) { v[j] = (f32x4){bflo(cur[rr][j].x), bfhi(cur[rr][j].x), bflo(cur[rr][j].y), bfhi(cur[rr][j].y)}; s += (v[j].x * v[j].x + v[j].y * v[j].y) + (v[j].z * v[j].z + v[j].w * v[j].w); }
            const float r = rsqrtf(wave_sum(s) * (1.f / 1024.f) + EPS);
#pragma unroll
            for (int j = 0; j < 4; ++j) __builtin_nontemporal_store(v[j] * r * gr[j], (f32x4*)(F.out + O_Y + (size_t)row * DM) + lane + 64 * j); }
#pragma unroll
        for (int rr = 0; rr < 4; ++rr)
#pragma unroll
            for (int j = 0; j < 4; ++j) cur[rr][j] = nxt[rr][j];
    }
#undef FN_LOAD
}

typedef float f32x4v __attribute__((ext_vector_type(4)));
#define MFMA16(a, b, c) __builtin_amdgcn_mfma_f32_16x16x32_bf16((a), (b), (c), 0, 0, 0)
__device__ __forceinline__ float scan_sum(float v, int lane) {
#pragma unroll
    for (int o = 1; o < 64; o <<= 1) { const float t = __shfl_up(v, o); if (lane >= o) v += t; }
    return v;
}
__device__ __forceinline__ float scan_max(float v, int lane) {
#pragma unroll
    for (int o = 1; o < 64; o <<= 1) { const float t = __shfl_up(v, o); if (lane >= o) v = fmaxf(v, t); }
    return v;
}
__device__ __forceinline__ float wave_max(float v) {
#pragma unroll
    for (int o = 1; o < 64; o <<= 1) v = fmaxf(v, __shfl_xor(v, o));
    return v;
}
__device__ __forceinline__ unsigned img_off(unsigned row, unsigned ch) { return row * 512u + ((ch ^ (row & 15u)) << 4); }
__device__ __forceinline__ void dma_tile128(LAS unsigned char* buf, const bf16* gsrc, size_t ld, int wave, int lane) {
#pragma unroll
    for (int i = 0; i < 8; ++i) { const int p = wave * 8 + i, row = 2 * p + (lane >> 5), ch = (lane & 31) ^ (row & 15);
        __builtin_amdgcn_global_load_lds((const unsigned*)(gsrc + (size_t)row * ld + ch * 8), (LAS unsigned*)(buf + p * 1024), 16, 0, 0); }
}
__device__ __forceinline__ bf16x8 tr_frag(unsigned a0, unsigned a1) {
    v2u lo, hi;
    asm volatile("ds_read_b64_tr_b16 %0, %2\n\tds_read_b64_tr_b16 %1, %3\n\ts_waitcnt lgkmcnt(0)" : "=&v"(lo), "=&v"(hi) : "v"(a0), "v"(a1) : "memory");
    v4u r; r.x = lo.x; r.y = lo.y; r.z = hi.x; r.w = hi.y; return __builtin_bit_cast(bf16x8, r);
}
__device__ __forceinline__ bf16x8 pack_f8(const f32x4 a, const f32x4 b) { v4u r; r.x = pk2(a.x, a.y); r.y = pk2(a.z, a.w); r.z = pk2(b.x, b.y); r.w = pk2(b.z, b.w); return __builtin_bit_cast(bf16x8, r); }
__device__ __forceinline__ f32x4 bf4_to_f(const v2u w) { return (f32x4){bflo(w.x), bfhi(w.x), bflo(w.y), bfhi(w.y)}; }

__device__ __forceinline__ void s1_state_pass(Frame& F) {
    const bf16* QKVO = WSP(bf16, WS_QKVO); const float* GATES = WSP(float, WS_GATES);
    bf16* CST = WSP(bf16, WS_CST); float* NST = WSP(float, WS_NST); float* MST = WSP(float, WS_MST);
    LAS unsigned char* VP = F.lds + SCR_OFF;
    LAS float* WGS = (LAS float*)(F.lds + SCR_OFF + 8192);
    LAS float* SC = (LAS float*)(F.lds + SCR_OFF + 8192 + 1024);
    const int lane = F.lane, wave = F.wave, g = lane >> 4, q = (lane & 15) >> 2, p = lane & 3;
    const unsigned ldsK = (unsigned)(size_t)F.lds, ldsV = (unsigned)(size_t)VP;
    for (int un = F.vcu; un < NB_P * NH * 8; un += F.G) {
        const int vs = un & 7, h = (un >> 3) & 3, b = un >> 5, bh = b * NH + h;
        f32x4 acc[2][2], nacc[2];
#pragma unroll
        for (int i = 0; i < 2; ++i) { nacc[i] = (f32x4){0.f, 0.f, 0.f, 0.f};
#pragma unroll
            for (int j = 0; j < 2; ++j) acc[i][j] = (f32x4){0.f, 0.f, 0.f, 0.f}; }
        float m_run = 0.f;
        __syncthreads();
        dma_tile128(F.lds, QKVO + (size_t)(b * S_P) * NIN + 1024 + 256 * h, NIN, wave, lane);
        for (int c = 0; c < 16; ++c) {
            const int r0 = b * S_P + 128 * c, par = c & 1;
            if (wave == 0) {
                const float li0 = GATES[(size_t)(r0 + lane) * 8 + h], li1 = GATES[(size_t)(r0 + 64 + lane) * 8 + h], lf0 = GATES[(size_t)(r0 + lane) * 8 + 4 + h], lf1 = GATES[(size_t)(r0 + 64 + lane) * 8 + 4 + h];
                const float b0 = scan_sum(lf0, lane), b1 = scan_sum(lf1, lane) + __shfl(b0, 63), bL = __shfl(b1, 63);
                const float g0 = bL - b0 + li0, g1 = bL - b1 + li1, mx = wave_max(fmaxf(g0, g1));
                const float m_new = fmaxf(bL + m_run, mx), a = expf(bL + m_run - m_new);
                WGS[par * 128 + lane] = expf(g0 - m_new); WGS[par * 128 + 64 + lane] = expf(g1 - m_new);
                if (lane == 0) { SC[par * 4] = a; SC[par * 4 + 1] = m_new; if (vs == 0) MST[bh * 16 + c] = m_run; }
                m_run = m_new;
            }
            const int vl = F.tid >> 2, vp = F.tid & 3;
            const v4u vraw = *(const v4u*)(QKVO + (size_t)(r0 + vl) * NIN + 2048 + 256 * h + 32 * vs + 8 * vp);
            VM_WAIT(); __syncthreads();
            { const float wg = WGS[par * 128 + vl];
              v4u o; o.x = pk2(bflo(vraw.x) * wg, bfhi(vraw.x) * wg); o.y = pk2(bflo(vraw.y) * wg, bfhi(vraw.y) * wg); o.z = pk2(bflo(vraw.z) * wg, bfhi(vraw.z) * wg); o.w = pk2(bflo(vraw.w) * wg, bfhi(vraw.w) * wg);
              *(LAS v4u*)(VP + vl * 64 + vp * 16) = o; }
            if (c >= 1) {
                bf16* cp = CST + ((size_t)(bh * 16 + c) * DV + 32 * vs + (lane & 15)) * DK + 32 * wave + 4 * g;
#pragma unroll
                for (int dt = 0; dt < 2; ++dt)
#pragma unroll
                    for (int vt = 0; vt < 2; ++vt) { v2u w; w.x = pk2(acc[dt][vt].x, acc[dt][vt].y); w.y = pk2(acc[dt][vt].z, acc[dt][vt].w); *(v2u*)(cp + (size_t)(16 * vt) * DK + 16 * dt) = w; }
                if (vs == 0 && (lane & 15) == 0) {
#pragma unroll
                    for (int dt = 0; dt < 2; ++dt) *(f32x4*)(NST + (size_t)(bh * 16 + c) * DK + 32 * wave + 16 * dt + 4 * g) = nacc[dt]; }
            }
            __syncthreads();
            if (c + 1 < 16) dma_tile128(F.lds + ((c + 1) & 1) * 65536, QKVO + (size_t)(r0 + 128) * NIN + 1024 + 256 * h, NIN, wave, lane);
            const float a = SC[par * 4];
#pragma unroll
            for (int i = 0; i < 2; ++i) { nacc[i] = nacc[i] * a;
#pragma unroll
                for (int j = 0; j < 2; ++j) acc[i][j] = acc[i][j] * a; }
            const unsigned kb = ldsK + par * 65536;
#pragma unroll
            for (int kl = 0; kl < 4; ++kl) {
                const unsigned ra = 32 * kl + 8 * g + q, rb = ra + 4;
                bf16x8 Af[2], Bf[2];
#pragma unroll
                for (int dt = 0; dt < 2; ++dt) Af[dt] = tr_frag(kb + img_off(ra, 4 * wave + 2 * dt + (p >> 1)) + 8 * (p & 1), kb + img_off(rb, 4 * wave + 2 * dt + (p >> 1)) + 8 * (p & 1));
#pragma unroll
                for (int vt = 0; vt < 2; ++vt) Bf[vt] = tr_frag(ldsV + ra * 64 + (16 * vt + 4 * p) * 2, ldsV + rb * 64 + (16 * vt + 4 * p) * 2);
#pragma unroll
                for (int dt = 0; dt < 2; ++dt)
#pragma unroll
                    for (int vt = 0; vt < 2; ++vt) acc[dt][vt] = MFMA16(Af[dt], Bf[vt], acc[dt][vt]);
                if (vs == 0) {
                    const f32x4 w0 = *(const LAS f32x4*)(WGS + par * 128 + 32 * kl + 8 * g), w1 = *(const LAS f32x4*)(WGS + par * 128 + 32 * kl + 8 * g + 4);
                    bf16x8 b2 = pack_f8(w0, w1); if ((lane & 15) != 0) b2 = (bf16x8){0, 0, 0, 0, 0, 0, 0, 0};
#pragma unroll
                    for (int dt = 0; dt < 2; ++dt) nacc[dt] = MFMA16(Af[dt], b2, nacc[dt]);
                }
            }
        }
        float* co = F.out + O_CP + ((size_t)bh * DV + 32 * vs + (lane & 15)) * DK + 32 * wave + 4 * g;
#pragma unroll
        for (int dt = 0; dt < 2; ++dt)
#pragma unroll
            for (int vt = 0; vt < 2; ++vt) *(f32x4*)(co + (size_t)(16 * vt) * DK + 16 * dt) = acc[dt][vt];
        if (vs == 0) {
            if ((lane & 15) == 0) {
#pragma unroll
                for (int dt = 0; dt < 2; ++dt) *(f32x4*)(F.out + O_NP + (size_t)bh * DK + 32 * wave + 16 * dt + 4 * g) = nacc[dt]; }
            if (wave == 0 && lane == 0) F.out[O_MP + bh] = m_run;
        }
    }
}

template <int VT>
__device__ __forceinline__ void s2_h_step(f32x4& acc, const unsigned base, const bf16x8 (&Sf)[4]) {
    constexpr int HI = (VT >> 3) * 256;
    v2u r0, r1, r2, r3, r4, r5, r6, r7;
    asm volatile("ds_read_b64_tr_b16 %0, %8 offset:%9\n\tds_read_b64_tr_b16 %1, %8 offset:%10\n\tds_read_b64_tr_b16 %2, %8 offset:%11\n\tds_read_b64_tr_b16 %3, %8 offset:%12\n\t"
                 "ds_read_b64_tr_b16 %4, %8 offset:%13\n\tds_read_b64_tr_b16 %5, %8 offset:%14\n\tds_read_b64_tr_b16 %6, %8 offset:%15\n\tds_read_b64_tr_b16 %7, %8 offset:%16\n\ts_waitcnt lgkmcnt(0)"
                 : "=&v"(r0), "=&v"(r1), "=&v"(r2), "=&v"(r3), "=&v"(r4), "=&v"(r5), "=&v"(r6), "=&v"(r7)
                 : "v"(base), "i"(HI), "i"(HI + 8192), "i"(HI + 16384), "i"(HI + 24576), "i"(HI + 32768), "i"(HI + 40960), "i"(HI + 49152), "i"(HI + 57344) : "memory");
    v4u f;
    f.x = r0.x; f.y = r0.y; f.z = r1.x; f.w = r1.y; acc = MFMA16(__builtin_bit_cast(bf16x8, f), Sf[0], acc);
    f.x = r2.x; f.y = r2.y; f.z = r3.x; f.w = r3.y; acc = MFMA16(__builtin_bit_cast(bf16x8, f), Sf[1], acc);
    f.x = r4.x; f.y = r4.y; f.z = r5.x; f.w = r5.y; acc = MFMA16(__builtin_bit_cast(bf16x8, f), Sf[2], acc);
    f.x = r6.x; f.y = r6.y; f.z = r7.x; f.w = r7.y; acc = MFMA16(__builtin_bit_cast(bf16x8, f), Sf[3], acc);
}

#if TS_PROBE >= 0
#define S2STAMP(i) do { if (blockIdx.x == 8 && F.tid == 0 && un == F.vcu) ((unsigned long long*)(F.ctl + 2048))[(i)] = __builtin_amdgcn_s_memrealtime(); } while (0)
#else
#define S2STAMP(i) do { } while (0)
#endif
#define QPL(t, hh) (QKVO + (size_t)((t) * 4 + (hh)) * MT * 256)
__device__ __forceinline__ void s2_output_pass(Frame& F) {
    const bf16* QKVO = WSP(bf16, WS_QKVO); const float* GATES = WSP(float, WS_GATES);
    const bf16* CST = WSP(bf16, WS_CST); const float* NST = WSP(float, WS_NST); const float* MST = WSP(float, WS_MST); bf16* A2 = WSP(bf16, WS_A2);
    LAS float* ZS = (LAS float*)(F.lds + SCR_OFF); LAS float* LM = ZS + 128; LAS float* LW = ZS + 256; LAS float* LE = ZS + 384; LAS float* NS = ZS + 512; LAS float* HN = ZS + 768;
    LAS unsigned char* bufA = F.lds; LAS unsigned char* bufB = F.lds + 65536;
    const int wave = F.wave;
    const unsigned ldsB = (unsigned)(size_t)bufB;
    bool pre = false;
    for (int un = F.vcu; un < NB_P * NH * 16; un += F.G) {
        int lane = F.lane; asm volatile("" : "+v"(lane));
        const int g = lane >> 4, q = (lane & 15) >> 2, p = lane & 3, li_ = lane & 15;
        const int c = un & 15, h = (un >> 4) & 3, b = un >> 6, bh = b * NH + h, r0 = b * S_P + 128 * c;
        const bf16* Kg = QPL(1, h) + (size_t)r0 * 256; const bf16* Vg = QPL(2, h) + (size_t)r0 * 256;
        __syncthreads();
        S2STAMP(29);
        if (!pre) {
        if (c) { const bf16* Cg = CST + (size_t)(bh * 16 + c) * DV * DK; dma_tile128(bufA, Cg, DK, wave, lane); dma_tile128(bufB, Cg + (size_t)128 * DK, DK, wave, lane); }
        else { dma_tile128(bufA, Kg, 256, wave, lane); dma_tile128(bufB, Vg, 256, wave, lane); } }
        pre = false;
        if (F.tid < 128) { const f32x4 gv = WSP(f32x4, WS_GV)[(size_t)(r0 + F.tid) * 4 + h]; ZS[F.tid] = gv.x; LM[F.tid] = gv.y; LW[F.tid] = gv.z; LE[F.tid] = gv.w; }
        if (F.tid >= 128 && F.tid < 192) *(LAS f32x4*)(HN + 4 * (F.tid - 128)) = *(const f32x4*)(F.head_norm + 256 * h + 4 * (F.tid - 128));
        if (F.tid < 64) *(LAS f32x4*)(NS + 4 * F.tid) = c ? *(const f32x4*)(NST + (size_t)(bh * 16 + c) * DK + 4 * F.tid) : (f32x4){0.f, 0.f, 0.f, 0.f};
        int lrow = 16 * wave + li_; asm volatile("" : "+v"(lrow));
        const size_t row = (size_t)(r0 + lrow);
        bf16x8 Qf[8];
#pragma unroll
        for (int kd = 0; kd < 8; ++kd) Qf[kd] = *(const bf16x8*)(QPL(0, h) + row * 256 + 32 * kd + 8 * g);
        f32x4 acc[16];
#pragma unroll
        for (int vt = 0; vt < 16; ++vt) acc[vt] = (f32x4){0.f, 0.f, 0.f, 0.f};
        VM_WAIT(); __syncthreads();
        S2STAMP(30);
        if (c) {
#pragma unroll
            for (int vt = 0; vt < 8; ++vt) {
#pragma unroll
                for (int kd = 0; kd < 8; ++kd) acc[vt] = MFMA16(*(const LAS bf16x8*)(bufA + img_off(16 * vt + li_, 4 * kd + g)), Qf[kd], acc[vt]);
                __builtin_amdgcn_sched_barrier(0); }
#pragma unroll
            for (int vt = 0; vt < 8; ++vt) {
#pragma unroll
                for (int kd = 0; kd < 8; ++kd) acc[8 + vt] = MFMA16(*(const LAS bf16x8*)(bufB + img_off(16 * vt + li_, 4 * kd + g)), Qf[kd], acc[8 + vt]);
                __builtin_amdgcn_sched_barrier(0); }
            __syncthreads();
            S2STAMP(31);
            dma_tile128(bufA, Kg, 256, wave, lane); dma_tile128(bufB, Vg, 256, wave, lane);
            const float wl = LW[lrow];
#pragma unroll
            for (int vt = 0; vt < 16; ++vt) acc[vt] = acc[vt] * wl;
            VM_WAIT(); __syncthreads();
            S2STAMP(32);
        }
        float gn = 0.f;
#pragma unroll
        for (int kd = 0; kd < 8; ++kd) { const v4u qw = __builtin_bit_cast(v4u, Qf[kd]); const f32x4 n0 = *(const LAS f32x4*)(NS + 32 * kd + 8 * g), n1 = *(const LAS f32x4*)(NS + 32 * kd + 8 * g + 4);
            gn += (bflo(qw.x) * n0.x + bfhi(qw.x) * n0.y) + (bflo(qw.y) * n0.z + bfhi(qw.y) * n0.w) + (bflo(qw.z) * n1.x + bfhi(qw.z) * n1.y) + (bflo(qw.w) * n1.z + bfhi(qw.w) * n1.w); }
        gn += __shfl_xor(gn, 16); gn += __shfl_xor(gn, 32);
        v2u ovr[16];
        { const bf16* ob = QPL(3, h) + row * 256 + 4 * g;
#pragma unroll
          for (int vt = 0; vt < 16; ++vt) ovr[vt] = *(const v2u*)(ob + 16 * vt); }
        const float Ml = LM[lrow]; float dsum = 0.f;
        bf16x8 Sf[4];
#pragma unroll
        for (int ks = 0; ks < 4; ++ks) {
            f32x4 sa = (f32x4){0.f, 0.f, 0.f, 0.f}, sb = sa;
#pragma unroll
            for (int kd = 0; kd < 8; ++kd) { sa = MFMA16(*(const LAS bf16x8*)(bufA + img_off(32 * ks + li_, 4 * kd + g)), Qf[kd], sa); sb = MFMA16(*(const LAS bf16x8*)(bufA + img_off(32 * ks + 16 + li_, 4 * kd + g)), Qf[kd], sb);
                if (kd & 1) __builtin_amdgcn_sched_barrier(0); }
            const f32x4 za = *(const LAS f32x4*)(ZS + 32 * ks + 4 * g), zb = *(const LAS f32x4*)(ZS + 32 * ks + 16 + 4 * g);
#pragma unroll
            for (int r = 0; r < 4; ++r) { const int da = lrow - (32 * ks + 4 * g + r);
                sa[r] = __builtin_bit_cast(float, __builtin_bit_cast(unsigned, sa[r] * __expf(za[r] - Ml)) & ~(unsigned)(da >> 31));
                sb[r] = __builtin_bit_cast(float, __builtin_bit_cast(unsigned, sb[r] * __expf(zb[r] - Ml)) & ~(unsigned)((da - 16) >> 31)); dsum += sa[r] + sb[r]; }
            Sf[ks] = pack_f8(sa, sb);
            __builtin_amdgcn_sched_barrier(0);
        }
        dsum += __shfl_xor(dsum, 16); dsum += __shfl_xor(dsum, 32);
        {
            unsigned hb[8];
#pragma unroll
            for (int j = 0; j < 8; ++j) hb[j] = ldsB + img_off(4 * g + q, 2 * j + (p >> 1)) + 8 * (p & 1);
            s2_h_step<0>(acc[0], hb[0], Sf); s2_h_step<1>(acc[1], hb[1], Sf); s2_h_step<2>(acc[2], hb[2], Sf); s2_h_step<3>(acc[3], hb[3], Sf);
            s2_h_step<4>(acc[4], hb[4], Sf); s2_h_step<5>(acc[5], hb[5], Sf); s2_h_step<6>(acc[6], hb[6], Sf); s2_h_step<7>(acc[7], hb[7], Sf);
            s2_h_step<8>(acc[8], hb[0], Sf); s2_h_step<9>(acc[9], hb[1], Sf); s2_h_step<10>(acc[10], hb[2], Sf); s2_h_step<11>(acc[11], hb[3], Sf);
            s2_h_step<12>(acc[12], hb[4], Sf); s2_h_step<13>(acc[13], hb[5], Sf); s2_h_step<14>(acc[14], hb[6], Sf); s2_h_step<15>(acc[15], hb[7], Sf);
        }
        S2STAMP(33);
        { const int un2 = un + F.G;
          if (un2 < NB_P * NH * 16) { __syncthreads();
              const int c2 = un2 & 15, h2 = (un2 >> 4) & 3, b2 = un2 >> 6, bh2 = b2 * NH + h2, r02 = b2 * S_P + 128 * c2;
              if (c2) { const bf16* Cg = CST + (size_t)(bh2 * 16 + c2) * DV * DK; dma_tile128(bufA, Cg, DK, wave, lane); dma_tile128(bufB, Cg + (size_t)128 * DK, DK, wave, lane); }
              else { dma_tile128(bufA, QPL(1, h2) + (size_t)r02 * 256, 256, wave, lane); dma_tile128(bufB, QPL(2, h2) + (size_t)r02 * 256, 256, wave, lane); }
              pre = true; } }
        __builtin_amdgcn_sched_barrier(0);
        const float den = LW[lrow] * gn + dsum, inv = __builtin_amdgcn_rcpf(fmaxf(fabsf(den), LE[lrow]));
        float ssq = 0.f;
#pragma unroll
        for (int vt = 0; vt < 16; ++vt) { acc[vt] = acc[vt] * inv; ssq += (acc[vt].x * acc[vt].x + acc[vt].y * acc[vt].y) + (acc[vt].z * acc[vt].z + acc[vt].w * acc[vt].w); }
        ssq += __shfl_xor(ssq, 16); ssq += __shfl_xor(ssq, 32);
        const float rn = rsqrtf(ssq * (1.f / 256.f) + EPS);
        {
          const __amdgpu_buffer_rsrc_t ars = __builtin_amdgcn_make_buffer_rsrc((void*)A2, 0, (int)((size_t)MT * DM * 2), 0x00020000);
          const bool oddg = g & 1;
          const unsigned abase = (unsigned)((row * DM + 256 * h + 4 * (g & ~1)) * 2);
#pragma unroll
        for (int vj = 0; vj < 8; ++vj) {
            v2u w[2];
#pragma unroll
            for (int e = 0; e < 2; ++e) { const int vt = 2 * vj + e;
                const f32x4 ov = bf4_to_f(ovr[vt]), gh = *(const LAS f32x4*)(HN + 16 * vt + 4 * g) * rn;
                const f32x4 sg = (f32x4){__builtin_amdgcn_rcpf(1.f + __expf(-ov.x)), __builtin_amdgcn_rcpf(1.f + __expf(-ov.y)), __builtin_amdgcn_rcpf(1.f + __expf(-ov.z)), __builtin_amdgcn_rcpf(1.f + __expf(-ov.w))};
                const f32x4 o = acc[vt] * gh * sg;
                w[e].x = pk2(o.x, o.y); w[e].y = pk2(o.z, o.w); }
            const unsigned sx = oddg ? w[0].x : w[1].x, sy = oddg ? w[0].y : w[1].y;
            const unsigned rx = (unsigned)__shfl_xor((int)sx, 16), ry = (unsigned)__shfl_xor((int)sy, 16);
            v4u o4; if (oddg) { o4.x = rx; o4.y = ry; o4.z = w[1].x; o4.w = w[1].y; } else { o4.x = w[0].x; o4.y = w[0].y; o4.z = rx; o4.w = ry; }
            __builtin_amdgcn_raw_buffer_store_b128(o4, ars, (int)(abase + (unsigned)(16 * (2 * vj + (oddg ? 1 : 0)) * 2)), 0, 16);
            if (vj & 1) __builtin_amdgcn_sched_barrier(0); } }
        S2STAMP(34);
    }
}

__device__ __forceinline__ void s3_sample_pass(Frame& F, const int u_first, const int u_step) {
    const bf16* QKVO = WSP(bf16, WS_QKVO); const float* GATES = WSP(float, WS_GATES); bf16* A2 = WSP(bf16, WS_A2);
    LAS float* GP = (LAS float*)F.lds;
    LAS float* VW = (LAS float*)(F.lds + 65536);
    LAS float* SCS = (LAS float*)(F.lds + SCR_OFF);
    const int lane = F.lane, wave = F.wave, g = lane >> 4, li_ = lane & 15;
    for (int un = u_first; un < NB_S * NH; un += u_step) {
        const int h = un & 3, b = un >> 2, bh = b * NH + h, r0 = MP + S_S * b;
        __syncthreads();
        if (wave == 0) {
            const bool ok = lane < S_S; const int rr = r0 + (lane & 7);
            const float li = GATES[(size_t)rr * 8 + h], lf = ok ? GATES[(size_t)rr * 8 + 4 + h] : 0.f, m0 = F.stM[bh];
            const float bc = scan_sum(lf, lane), z = ok ? li - bc : -INFINITY, pm = scan_max(z, lane), M = fmaxf(m0, pm), bL = __shfl(bc, S_S - 1);
            const float gq = ok ? bL - bc + li : -INFINITY, mx = wave_max(gq), m_new = fmaxf(bL + m0, mx), a = expf(bL + m0 - m_new);
            if (ok) { SCS[lane] = z; SCS[8 + lane] = M; SCS[16 + lane] = expf(m0 - M); SCS[24 + lane] = expf(-(bc + M)); SCS[32 + lane] = expf(gq - m_new); }
            if (lane == 0) { SCS[40] = a; SCS[41] = m_new; F.out[O_MS + bh] = m_new; }
        }
        __syncthreads();
        { const int l = F.tid >> 6, v0 = 4 * (F.tid & 63); const float wg = SCS[32 + l];
          const f32x4 vv = bf4_to_f(*(const v2u*)(QKVO + (size_t)(r0 + l) * NIN + 2048 + 256 * h + v0)); *(LAS f32x4*)(VW + l * 256 + v0) = vv * wg; }
        float kk[8][8];
#pragma unroll
        for (int l = 0; l < 8; ++l) { const v4u w = *(const v4u*)(QKVO + (size_t)(r0 + l) * NIN + 1024 + 256 * h + 32 * wave + 8 * g);
            kk[l][0] = bflo(w.x); kk[l][1] = bfhi(w.x); kk[l][2] = bflo(w.y); kk[l][3] = bfhi(w.y); kk[l][4] = bflo(w.z); kk[l][5] = bfhi(w.z); kk[l][6] = bflo(w.w); kk[l][7] = bfhi(w.w); }
        bf16x8 Qa = (bf16x8){0, 0, 0, 0, 0, 0, 0, 0};
        if (li_ < 8) Qa = *(const bf16x8*)(QKVO + (size_t)(r0 + li_) * NIN + 256 * h + 32 * wave + 8 * g);
        __syncthreads();
        const float a = SCS[40];
        const float* cin = F.stC + ((size_t)bh * DV + li_) * DK + 32 * wave + 8 * g; float* cout = F.out + O_CS + ((size_t)bh * DV + li_) * DK + 32 * wave + 8 * g;
#pragma unroll 8
        for (int vb = 0; vb < 16; ++vb) {
            const f32x4 c0 = *(const f32x4*)(cin + (size_t)(16 * vb) * DK), c1 = *(const f32x4*)(cin + (size_t)(16 * vb) * DK + 4);
            const f32x4 gp = MFMA16(Qa, pack_f8(c0, c1), ((f32x4){0.f, 0.f, 0.f, 0.f}));
            if (g < 2) {
#pragma unroll
                for (int r = 0; r < 4; ++r) GP[(wave * 8 + 4 * g + r) * 256 + 16 * vb + li_] = gp[r]; }
            f32x4 n0 = c0 * a, n1 = c1 * a;
#pragma unroll
            for (int l = 0; l < 8; ++l) { const float vw = VW[l * 256 + 16 * vb + li_];
                n0.x += vw * kk[l][0]; n0.y += vw * kk[l][1]; n0.z += vw * kk[l][2]; n0.w += vw * kk[l][3]; n1.x += vw * kk[l][4]; n1.y += vw * kk[l][5]; n1.z += vw * kk[l][6]; n1.w += vw * kk[l][7]; }
            *(f32x4*)(cout + (size_t)(16 * vb) * DK) = n0; *(f32x4*)(cout + (size_t)(16 * vb) * DK + 4) = n1;
        }
        __syncthreads();
        {
            const int l = wave; const size_t row = (size_t)(r0 + l);
            f32x4 G = (f32x4){0.f, 0.f, 0.f, 0.f};
#pragma unroll
            for (int w2 = 0; w2 < 8; ++w2) G += *(const LAS f32x4*)(GP + (w2 * 8 + l) * 256 + 4 * lane);
            const f32x4 qv = bf4_to_f(*(const v2u*)(QKVO + row * NIN + 256 * h + 4 * lane));
            const f32x4 n0v = *(const f32x4*)(F.stN + (size_t)bh * DK + 4 * lane);
            const float gn = wave_sum((n0v.x * qv.x + n0v.y * qv.y) + (n0v.z * qv.z + n0v.w * qv.w));
            const float Ml = SCS[8 + l], wl = SCS[16 + l], el = SCS[24 + l];
            f32x4 num = G * wl; float dsum = 0.f;
#pragma unroll
            for (int s = 0; s < 8; ++s) { const f32x4 kv = bf4_to_f(*(const v2u*)(QKVO + (size_t)(r0 + s) * NIN + 1024 + 256 * h + 4 * lane));
                const float qk = wave_sum((kv.x * qv.x + kv.y * qv.y) + (kv.z * qv.z + kv.w * qv.w));
                const float sd = (s <= l) ? qk * __expf(SCS[s] - Ml) : 0.f;
                const f32x4 vv = bf4_to_f(*(const v2u*)(QKVO + (size_t)(r0 + s) * NIN + 2048 + 256 * h + 4 * lane));
                num += vv * sd; dsum += sd; }
            const float den = wl * gn + dsum, inv = 1.f / fmaxf(fabsf(den), el);
            const f32x4 hv = num * inv;
            const float rn = rsqrtf(wave_sum((hv.x * hv.x + hv.y * hv.y) + (hv.z * hv.z + hv.w * hv.w)) * (1.f / 256.f) + EPS);
            const int v0 = 256 * h + 4 * lane;
            const f32x4 ov = bf4_to_f(*(const v2u*)(QKVO + row * NIN + 3072 + v0)), gh = *(const f32x4*)(F.head_norm + v0);
            v2u w; w.x = pk2(hv.x * rn * gh.x * sigmoidf_(ov.x), hv.y * rn * gh.y * sigmoidf_(ov.y)); w.y = pk2(hv.z * rn * gh.z * sigmoidf_(ov.z), hv.w * rn * gh.w * sigmoidf_(ov.w));
            *(v2u*)(A2 + row * DM + v0) = w;
            if (wave == 0) {
                f32x4 nn = n0v * a;
#pragma unroll
                for (int s = 0; s < 8; ++s) { const f32x4 kv = bf4_to_f(*(const v2u*)(QKVO + (size_t)(r0 + s) * NIN + 1024 + 256 * h + 4 * lane)); nn += kv * SCS[32 + s]; }
                *(f32x4*)(F.out + O_NS + (size_t)bh * DK + 4 * lane) = nn;
            }
        }
    }
}
template <int KL>
__device__ __forceinline__ void s1b_kstep(f32x4 (&acc)[2][4], f32x4 (&nacc)[2], const unsigned k00, const unsigned k01, const unsigned k10, const unsigned k11, const unsigned vb, const bf16x8 b2, const bool do_n) {
    v2u a00, a01, a10, a11;
    asm volatile("ds_read_b64_tr_b16 %0, %4 offset:%8\n\tds_read_b64_tr_b16 %1, %5 offset:%8\n\tds_read_b64_tr_b16 %2, %6 offset:%8\n\tds_read_b64_tr_b16 %3, %7 offset:%8\n\ts_waitcnt lgkmcnt(0)"
                 : "=&v"(a00), "=&v"(a01), "=&v"(a10), "=&v"(a11) : "v"(k00), "v"(k01), "v"(k10), "v"(k11), "i"(KL * 16384) : "memory");
    v2u b0l, b0h, b1l, b1h, b2l, b2h, b3l, b3h;
    asm volatile("ds_read_b64_tr_b16 %0, %8 offset:%9\n\tds_read_b64_tr_b16 %1, %8 offset:%10\n\tds_read_b64_tr_b16 %2, %8 offset:%11\n\tds_read_b64_tr_b16 %3, %8 offset:%12\n\t"
                 "ds_read_b64_tr_b16 %4, %8 offset:%13\n\tds_read_b64_tr_b16 %5, %8 offset:%14\n\tds_read_b64_tr_b16 %6, %8 offset:%15\n\tds_read_b64_tr_b16 %7, %8 offset:%16\n\ts_waitcnt lgkmcnt(0)"
                 : "=&v"(b0l), "=&v"(b0h), "=&v"(b1l), "=&v"(b1h), "=&v"(b2l), "=&v"(b2h), "=&v"(b3l), "=&v"(b3h)
                 : "v"(vb), "i"(KL * 4096), "i"(KL * 4096 + 512), "i"(KL * 4096 + 32), "i"(KL * 4096 + 32 + 512), "i"(KL * 4096 + 64), "i"(KL * 4096 + 64 + 512), "i"(KL * 4096 + 96), "i"(KL * 4096 + 96 + 512) : "memory");
    v4u t;
    t.x = a00.x; t.y = a00.y; t.z = a10.x; t.w = a10.y; const bf16x8 A0 = __builtin_bit_cast(bf16x8, t);
    t.x = a01.x; t.y = a01.y; t.z = a11.x; t.w = a11.y; const bf16x8 A1 = __builtin_bit_cast(bf16x8, t);
    t.x = b0l.x; t.y = b0l.y; t.z = b0h.x; t.w = b0h.y; const bf16x8 B0 = __builtin_bit_cast(bf16x8, t);
    t.x = b1l.x; t.y = b1l.y; t.z = b1h.x; t.w = b1h.y; const bf16x8 B1 = __builtin_bit_cast(bf16x8, t);
    t.x = b2l.x; t.y = b2l.y; t.z = b2h.x; t.w = b2h.y; const bf16x8 B2 = __builtin_bit_cast(bf16x8, t);
    t.x = b3l.x; t.y = b3l.y; t.z = b3h.x; t.w = b3h.y; const bf16x8 B3 = __builtin_bit_cast(bf16x8, t);
    acc[0][0] = MFMA16(A0, B0, acc[0][0]); acc[0][1] = MFMA16(A0, B1, acc[0][1]); acc[0][2] = MFMA16(A0, B2, acc[0][2]); acc[0][3] = MFMA16(A0, B3, acc[0][3]);
    acc[1][0] = MFMA16(A1, B0, acc[1][0]); acc[1][1] = MFMA16(A1, B1, acc[1][1]); acc[1][2] = MFMA16(A1, B2, acc[1][2]); acc[1][3] = MFMA16(A1, B3, acc[1][3]);
    if (do_n) { nacc[0] = MFMA16(A0, b2, nacc[0]); nacc[1] = MFMA16(A1, b2, nacc[1]); }
}
__device__ __forceinline__ void s1b_state_pass(Frame& F, const int u_first, const int u_step) {
    const bf16* QKVO = WSP(bf16, WS_QKVO); const float* GATES = WSP(float, WS_GATES);
    bf16* CST = WSP(bf16, WS_CST); float* NST = WSP(float, WS_NST); f32x4* GV = WSP(f32x4, WS_GV);
    LAS unsigned char* VP = F.lds + SCR_OFF;
    LAS float* WGA = (LAS float*)(F.lds + SCR_OFF + 16384);
    LAS float* ACH = (LAS float*)(F.lds + SCR_OFF + 16384 + 8192);
    const int wave = F.wave;
    const unsigned ldsK = (unsigned)(size_t)F.lds, ldsV = (unsigned)(size_t)VP;
    for (int un = u_first; un < NB_P * NH * 4; un += u_step) {
        int lane = F.lane; asm volatile("" : "+v"(lane));
        const int g = lane >> 4, q = (lane & 15) >> 2, p = lane & 3;
        const int vq = un & 3, h = (un >> 2) & 3, b = un >> 4, bh = b * NH + h;
        __syncthreads();
        dma_tile128(F.lds, QKVO + (size_t)(b * S_P) * NIN + 1024 + 256 * h, NIN, wave, lane);
        if (wave == 0) {
            float li[16][2], lf[16][2];
#pragma unroll
            for (int c = 0; c < 16; ++c)
#pragma unroll
                for (int k = 0; k < 2; ++k) { const size_t row = (size_t)(b * S_P + 128 * c + 64 * k + lane); li[c][k] = GATES[row * 8 + h]; lf[c][k] = GATES[row * 8 + 4 + h]; }
            float m_run = 0.f;
#pragma unroll
            for (int c = 0; c < 16; ++c) {
                const float b0 = scan_sum(lf[c][0], lane), b1 = scan_sum(lf[c][1], lane) + __shfl(b0, 63), bL = __shfl(b1, 63);
                const float g0 = bL - b0 + li[c][0], g1 = bL - b1 + li[c][1], mx = wave_max(fmaxf(g0, g1));
                const float m_new = fmaxf(bL + m_run, mx);
                WGA[128 * c + lane] = expf(g0 - m_new); WGA[128 * c + 64 + lane] = expf(g1 - m_new);
                if (lane == 0) ACH[c] = expf(bL + m_run - m_new);
                if (vq == 0) {
                    const float z0 = li[c][0] - b0, z1 = li[c][1] - b1, p0 = scan_max(z0, lane), p1 = fmaxf(scan_max(z1, lane), __shfl(p0, 63));
                    const float M0 = fmaxf(m_run, p0), M1 = fmaxf(m_run, p1);
                    const size_t row = (size_t)(b * S_P + 128 * c + lane);
                    GV[row * 4 + h] = (f32x4){z0, M0, expf(m_run - M0), expf(-(b0 + M0))}; GV[(row + 64) * 4 + h] = (f32x4){z1, M1, expf(m_run - M1), expf(-(b1 + M1))};
                }
                m_run = m_new;
            }
            if (vq == 0 && lane == 0) F.out[O_MP + bh] = m_run;
        }
        const int vl = F.tid >> 2, vp = F.tid & 3;
        const bf16* vsrc = QKVO + (size_t)(b * S_P + vl) * NIN + 2048 + 256 * h + 64 * vq + 16 * vp;
        v4u v0 = *(const v4u*)vsrc, v1 = *(const v4u*)(vsrc + 8);
        f32x4 acc[2][4], nacc[2];
#pragma unroll
        for (int i = 0; i < 2; ++i) { nacc[i] = (f32x4){0.f, 0.f, 0.f, 0.f};
#pragma unroll
            for (int j = 0; j < 4; ++j) acc[i][j] = (f32x4){0.f, 0.f, 0.f, 0.f}; }
        for (int c = 0; c < 16; ++c) {
            const int par = c & 1;
            VM_WAIT(); __syncthreads();
            { const float wg = WGA[128 * c + vl];
              v4u o; o.x = pk2(bflo(v0.x) * wg, bfhi(v0.x) * wg); o.y = pk2(bflo(v0.y) * wg, bfhi(v0.y) * wg); o.z = pk2(bflo(v0.z) * wg, bfhi(v0.z) * wg); o.w = pk2(bflo(v0.w) * wg, bfhi(v0.w) * wg);
              *(LAS v4u*)(VP + vl * 128 + vp * 32) = o;
              o.x = pk2(bflo(v1.x) * wg, bfhi(v1.x) * wg); o.y = pk2(bflo(v1.y) * wg, bfhi(v1.y) * wg); o.z = pk2(bflo(v1.z) * wg, bfhi(v1.z) * wg); o.w = pk2(bflo(v1.w) * wg, bfhi(v1.w) * wg);
              *(LAS v4u*)(VP + vl * 128 + vp * 32 + 16) = o; }
            if (c >= 1) {
                bf16* cp = CST + ((size_t)(bh * 16 + c) * DV + 64 * vq + (lane & 15)) * DK + 32 * wave + 4 * g;
#pragma unroll
                for (int dt = 0; dt < 2; ++dt)
#pragma unroll
                    for (int vt = 0; vt < 4; ++vt) { v2u w; w.x = pk2(acc[dt][vt].x, acc[dt][vt].y); w.y = pk2(acc[dt][vt].z, acc[dt][vt].w); *(v2u*)(cp + (size_t)(16 * vt) * DK + 16 * dt) = w; }
                if (vq == 0 && (lane & 15) == 0) {
#pragma unroll
                    for (int dt = 0; dt < 2; ++dt) *(f32x4*)(NST + (size_t)(bh * 16 + c) * DK + 32 * wave + 16 * dt + 4 * g) = nacc[dt]; }
            }
            __syncthreads();
            if (c + 1 < 16) { dma_tile128(F.lds + ((c + 1) & 1) * 65536, QKVO + (size_t)(b * S_P + 128 * (c + 1)) * NIN + 1024 + 256 * h, NIN, wave, lane);
                              v0 = *(const v4u*)(vsrc + (size_t)(128 * (c + 1)) * NIN); v1 = *(const v4u*)(vsrc + (size_t)(128 * (c + 1)) * NIN + 8); }
            const float a = ACH[c];
#pragma unroll
            for (int i = 0; i < 2; ++i) { nacc[i] = nacc[i] * a;
#pragma unroll
                for (int j = 0; j < 4; ++j) acc[i][j] = acc[i][j] * a; }
            const unsigned kb = ldsK + par * 65536;
            const unsigned k00 = kb + img_off(8 * g + q, 4 * wave + (p >> 1)) + 8 * (p & 1), k01 = kb + img_off(8 * g + q, 4 * wave + 2 + (p >> 1)) + 8 * (p & 1);
            const unsigned k10 = kb + img_off(8 * g + q + 4, 4 * wave + (p >> 1)) + 8 * (p & 1), k11 = kb + img_off(8 * g + q + 4, 4 * wave + 2 + (p >> 1)) + 8 * (p & 1);
            const unsigned vb = ldsV + (8 * g + q) * 128 + 8 * p;
            const bool do_n = (vq == 0);
            bf16x8 b2[4];
#pragma unroll
            for (int kl = 0; kl < 4; ++kl) { b2[kl] = (bf16x8){0, 0, 0, 0, 0, 0, 0, 0};
                if (do_n && (lane & 15) == 0) b2[kl] = pack_f8(*(const LAS f32x4*)(WGA + 128 * c + 32 * kl + 8 * g), *(const LAS f32x4*)(WGA + 128 * c + 32 * kl + 8 * g + 4)); }
            s1b_kstep<0>(acc, nacc, k00, k01, k10, k11, vb, b2[0], do_n); s1b_kstep<1>(acc, nacc, k00, k01, k10, k11, vb, b2[1], do_n);
            s1b_kstep<2>(acc, nacc, k00, k01, k10, k11, vb, b2[2], do_n); s1b_kstep<3>(acc, nacc, k00, k01, k10, k11, vb, b2[3], do_n);
        }
        float* co = F.out + O_CP + ((size_t)bh * DV + 64 * vq + (lane & 15)) * DK + 32 * wave + 4 * g;
#pragma unroll
        for (int dt = 0; dt < 2; ++dt)
#pragma unroll
            for (int vt = 0; vt < 4; ++vt) *(f32x4*)(co + (size_t)(16 * vt) * DK + 16 * dt) = acc[dt][vt];
        if (vq == 0 && (lane & 15) == 0) {
#pragma unroll
            for (int dt = 0; dt < 2; ++dt) *(f32x4*)(F.out + O_NP + (size_t)bh * DK + 32 * wave + 16 * dt + 4 * g) = nacc[dt]; }
    }
}
#if TS_PROBE >= 0
#define S3STAMP(i) do { if (blockIdx.x == 128 && F.tid == 0 && un == u_first) ((unsigned long long*)(F.ctl + 2048))[(i)] = __builtin_amdgcn_s_memrealtime(); } while (0)
#else
#define S3STAMP(i) do { } while (0)
#endif
__device__ __forceinline__ void s3b_sample_pass(Frame& F, const int u_first, const int u_step) {
    const bf16* QKVO = WSP(bf16, WS_QKVO); const float* GATES = WSP(float, WS_GATES); bf16* A2 = WSP(bf16, WS_A2);
    LAS float* GP = (LAS float*)F.lds;
    LAS unsigned char* VWB = F.lds + 65536;
    LAS float* SCS = (LAS float*)(F.lds + SCR_OFF);
    const int wave = F.wave;
    for (int un = u_first; un < NB_S * NH; un += u_step) {
        int lane = F.lane; asm volatile("" : "+v"(lane));
        const int g = lane >> 4, li_ = lane & 15;
        const int h = un & 3, b = un >> 2, bh = b * NH + h, r0 = MP + S_S * b;
        S3STAMP(40);
        const float* __restrict__ cin = F.stC + ((size_t)bh * DV + li_) * DK + 32 * wave + 4 * g; float* __restrict__ cout = F.out + O_CS + ((size_t)bh * DV + li_) * DK + 32 * wave + 4 * g;
        f32x4 cr[16][2];
#pragma unroll
        for (int vb = 0; vb < 16; ++vb) { cr[vb][0] = __builtin_nontemporal_load((const f32x4*)(cin + (size_t)(16 * vb) * DK)); cr[vb][1] = __builtin_nontemporal_load((const f32x4*)(cin + (size_t)(16 * vb) * DK + 16)); }
        const bool ok = lane < S_S; const int rr = r0 + (lane & 7);
        float gli = 0.f, glf = 0.f, gm0 = 0.f;
        if (wave == 0) { gli = GATES[(size_t)rr * 8 + h]; glf = ok ? GATES[(size_t)rr * 8 + 4 + h] : 0.f; gm0 = F.stM[bh]; }
        bf16x8 Qa = (bf16x8){0, 0, 0, 0, 0, 0, 0, 0};
        if (li_ < 8) { const bf16* qp = QPL(0, h) + (size_t)(r0 + li_) * 256 + 32 * wave + 4 * g; const v2u q0 = *(const v2u*)qp, q1 = *(const v2u*)(qp + 16); v4u t; t.x = q0.x; t.y = q0.y; t.z = q1.x; t.w = q1.y; Qa = __builtin_bit_cast(bf16x8, t); }
        bf16x8 Ak[2];
#pragma unroll
        for (int dt = 0; dt < 2; ++dt) { Ak[dt] = (bf16x8){0, 0, 0, 0, 0, 0, 0, 0};
            if (g == 0) { const bf16* kp = QPL(1, h) + (size_t)r0 * 256 + 32 * wave + 16 * dt + li_;
#pragma unroll
                for (int l = 0; l < 8; ++l) Ak[dt][l] = (short)kp[(size_t)l * 256]; } }
        const int vwv = F.tid >> 1, vwh = F.tid & 1; const bf16* vwp = QPL(2, h) + (size_t)(r0 + 4 * vwh) * 256 + vwv;
        const unsigned short vw0 = vwp[0], vw1 = vwp[256], vw2 = vwp[512], vw3 = vwp[768];
        const size_t frow = (size_t)(r0 + wave);
        const v2u fq = *(const v2u*)(QPL(0, h) + frow * 256 + 4 * lane), fo = *(const v2u*)(QPL(3, h) + frow * 256 + 4 * lane);
        const f32x4 n0v = *(const f32x4*)(F.stN + (size_t)bh * DK + 4 * lane);
        v2u fk[8], fv[8];
#pragma unroll
        for (int s2 = 0; s2 < 8; ++s2) { fk[s2] = *(const v2u*)(QPL(1, h) + (size_t)(r0 + s2) * 256 + 4 * lane); fv[s2] = *(const v2u*)(QPL(2, h) + (size_t)(r0 + s2) * 256 + 4 * lane); }
        asm volatile("s_waitcnt lgkmcnt(0)" ::: "memory"); __builtin_amdgcn_s_barrier(); asm volatile("" ::: "memory");
        S3STAMP(41);
        if (wave == 0) {
            const float li = gli, lf = glf, m0 = gm0;
            const float bc = scan_sum(lf, lane), z = ok ? li - bc : -INFINITY, pm = scan_max(z, lane), M = fmaxf(m0, pm), bL = __shfl(bc, S_S - 1);
            const float gq = ok ? bL - bc + li : -INFINITY, mx = wave_max(gq), m_new = fmaxf(bL + m0, mx), a = expf(bL + m0 - m_new);
            if (ok) { SCS[lane] = z; SCS[8 + lane] = M; SCS[16 + lane] = expf(m0 - M); SCS[24 + lane] = expf(-(bc + M)); SCS[32 + lane] = expf(gq - m_new); }
            if (lane == 0) { SCS[40] = a; SCS[41] = m_new; F.out[O_MS + bh] = m_new; }
        }
        asm volatile("s_waitcnt lgkmcnt(0)" ::: "memory"); __builtin_amdgcn_s_barrier(); asm volatile("" ::: "memory");
        { v2u w; w.x = pk2(bf2f(vw0) * SCS[32 + 4 * vwh], bf2f(vw1) * SCS[33 + 4 * vwh]); w.y = pk2(bf2f(vw2) * SCS[34 + 4 * vwh], bf2f(vw3) * SCS[35 + 4 * vwh]);
          *(LAS v2u*)(VWB + vwv * 16 + vwh * 8) = w; }
        asm volatile("s_waitcnt lgkmcnt(0)" ::: "memory"); __builtin_amdgcn_s_barrier(); asm volatile("" ::: "memory");
        S3STAMP(42);
        const float a = SCS[40];
#pragma unroll
        for (int vb = 0; vb < 16; ++vb) {
            const f32x4 gp = MFMA16(Qa, pack_f8(cr[vb][0], cr[vb][1]), ((f32x4){0.f, 0.f, 0.f, 0.f}));
            if (g < 2) {
#pragma unroll
                for (int r = 0; r < 4; ++r) GP[(wave * 8 + 4 * g + r) * 256 + 16 * vb + li_] = gp[r]; }
            bf16x8 bvw = (bf16x8){0, 0, 0, 0, 0, 0, 0, 0};
            if (g == 0) bvw = *(const LAS bf16x8*)(VWB + (16 * vb + li_) * 16);
            const f32x4 n0 = MFMA16(Ak[0], bvw, cr[vb][0] * a), n1 = MFMA16(Ak[1], bvw, cr[vb][1] * a);
            __builtin_nontemporal_store(n0, (f32x4*)(cout + (size_t)(16 * vb) * DK)); __builtin_nontemporal_store(n1, (f32x4*)(cout + (size_t)(16 * vb) * DK + 16));
        }
        asm volatile("s_waitcnt lgkmcnt(0)" ::: "memory"); __builtin_amdgcn_s_barrier(); asm volatile("" ::: "memory");
        S3STAMP(43);
        {
            const int l = wave; const size_t row = (size_t)(r0 + l);
            f32x4 G = (f32x4){0.f, 0.f, 0.f, 0.f};
#pragma unroll
            for (int w2 = 0; w2 < 8; ++w2) G += *(const LAS f32x4*)(GP + (w2 * 8 + l) * 256 + 4 * lane);
            const f32x4 qv = bf4_to_f(fq);
            f32x4 kv[8], vv[8];
#pragma unroll
            for (int s2 = 0; s2 < 8; ++s2) { kv[s2] = bf4_to_f(fk[s2]); vv[s2] = bf4_to_f(fv[s2]); }
            const float gn = wave_sum((n0v.x * qv.x + n0v.y * qv.y) + (n0v.z * qv.z + n0v.w * qv.w));
            const float Ml = SCS[8 + l], wl = SCS[16 + l], el = SCS[24 + l];
            f32x4 num = G * wl; float dsum = 0.f;
#pragma unroll
            for (int s = 0; s < 8; ++s) { const float qk = wave_sum((kv[s].x * qv.x + kv[s].y * qv.y) + (kv[s].z * qv.z + kv[s].w * qv.w));
                const float sd = (s <= l) ? qk * __expf(SCS[s] - Ml) : 0.f; num += vv[s] * sd; dsum += sd; }
            const float den = wl * gn + dsum, inv = 1.f / fmaxf(fabsf(den), el);
            const f32x4 hv = num * inv;
            const float rn = rsqrtf(wave_sum((hv.x * hv.x + hv.y * hv.y) + (hv.z * hv.z + hv.w * hv.w)) * (1.f / 256.f) + EPS);
            const int v0 = 256 * h + 4 * lane;
            const f32x4 ov = bf4_to_f(fo), gh = *(const f32x4*)(F.head_norm + v0);
            v2u w; w.x = pk2(hv.x * rn * gh.x * sigmoidf_(ov.x), hv.y * rn * gh.y * sigmoidf_(ov.y)); w.y = pk2(hv.z * rn * gh.z * sigmoidf_(ov.z), hv.w * rn * gh.w * sigmoidf_(ov.w));
            *(v2u*)(A2 + row * DM + v0) = w;
            if (wave == 0) {
                f32x4 nn = n0v * a;
#pragma unroll
                for (int s = 0; s < 8; ++s) nn += kv[s] * SCS[32 + s];
                *(f32x4*)(F.out + O_NS + (size_t)bh * DK + 4 * lane) = nn;
            }
        }
        S3STAMP(44);
    }
}
__device__ __forceinline__ bf16x8 scale_frag(const v2u lo, const v2u hi, const f32x4 w0, const f32x4 w1) {
    v4u r; r.x = pk2(bflo(lo.x) * w0.x, bfhi(lo.x) * w0.y); r.y = pk2(bflo(lo.y) * w0.z, bfhi(lo.y) * w0.w); r.z = pk2(bflo(hi.x) * w1.x, bfhi(hi.x) * w1.y); r.w = pk2(bflo(hi.y) * w1.z, bfhi(hi.y) * w1.w);
    return __builtin_bit_cast(bf16x8, r);
}
template <int KL>
__device__ __forceinline__ void s1c_kstep(f32x4 (&acc)[2][4], f32x4 (&nacc)[2], const unsigned k00, const unsigned k01, const unsigned k10, const unsigned k11, const unsigned vb, const LAS float* wgp, const bf16x8 ones, const bool do_n) {
    v2u a00, a01, a10, a11;
    asm volatile("ds_read_b64_tr_b16 %0, %4 offset:%8\n\tds_read_b64_tr_b16 %1, %5 offset:%8\n\tds_read_b64_tr_b16 %2, %6 offset:%8\n\tds_read_b64_tr_b16 %3, %7 offset:%8\n\ts_waitcnt lgkmcnt(0)"
                 : "=&v"(a00), "=&v"(a01), "=&v"(a10), "=&v"(a11) : "v"(k00), "v"(k01), "v"(k10), "v"(k11), "i"(KL * 16384) : "memory");
    v2u b0l, b0h, b1l, b1h, b2l, b2h, b3l, b3h;
    asm volatile("ds_read_b64_tr_b16 %0, %8 offset:%9\n\tds_read_b64_tr_b16 %1, %8 offset:%10\n\tds_read_b64_tr_b16 %2, %8 offset:%11\n\tds_read_b64_tr_b16 %3, %8 offset:%12\n\t"
                 "ds_read_b64_tr_b16 %4, %8 offset:%13\n\tds_read_b64_tr_b16 %5, %8 offset:%14\n\tds_read_b64_tr_b16 %6, %8 offset:%15\n\tds_read_b64_tr_b16 %7, %8 offset:%16\n\ts_waitcnt lgkmcnt(0)"
                 : "=&v"(b0l), "=&v"(b0h), "=&v"(b1l), "=&v"(b1h), "=&v"(b2l), "=&v"(b2h), "=&v"(b3l), "=&v"(b3h)
                 : "v"(vb), "i"(KL * 4096), "i"(KL * 4096 + 512), "i"(KL * 4096 + 32), "i"(KL * 4096 + 32 + 512), "i"(KL * 4096 + 64), "i"(KL * 4096 + 64 + 512), "i"(KL * 4096 + 96), "i"(KL * 4096 + 96 + 512) : "memory");
    const f32x4 w0 = *(const LAS f32x4*)(wgp + 32 * KL), w1 = *(const LAS f32x4*)(wgp + 32 * KL + 4);
    const bf16x8 A0 = scale_frag(a00, a10, w0, w1), A1 = scale_frag(a01, a11, w0, w1);
    v4u t;
    t.x = b0l.x; t.y = b0l.y; t.z = b0h.x; t.w = b0h.y; const bf16x8 B0 = __builtin_bit_cast(bf16x8, t);
    t.x = b1l.x; t.y = b1l.y; t.z = b1h.x; t.w = b1h.y; const bf16x8 B1 = __builtin_bit_cast(bf16x8, t);
    t.x = b2l.x; t.y = b2l.y; t.z = b2h.x; t.w = b2h.y; const bf16x8 B2 = __builtin_bit_cast(bf16x8, t);
    t.x = b3l.x; t.y = b3l.y; t.z = b3h.x; t.w = b3h.y; const bf16x8 B3 = __builtin_bit_cast(bf16x8, t);
    acc[0][0] = MFMA16(A0, B0, acc[0][0]); acc[0][1] = MFMA16(A0, B1, acc[0][1]); acc[0][2] = MFMA16(A0, B2, acc[0][2]); acc[0][3] = MFMA16(A0, B3, acc[0][3]);
    acc[1][0] = MFMA16(A1, B0, acc[1][0]); acc[1][1] = MFMA16(A1, B1, acc[1][1]); acc[1][2] = MFMA16(A1, B2, acc[1][2]); acc[1][3] = MFMA16(A1, B3, acc[1][3]);
    if (do_n) { nacc[0] = MFMA16(A0, ones, nacc[0]); nacc[1] = MFMA16(A1, ones, nacc[1]); }
}
constexpr int S1C_SLOT = 40960;
__device__ __forceinline__ void s1c_stage(LAS unsigned char* slot, const bf16* kg, const bf16* vg, int wave, int lane) {
#pragma unroll
    for (int i = 0; i < 4; ++i) { const int p = wave + 8 * i, row = 2 * p + (lane >> 5), ch = (lane & 31) ^ (row & 15);
        __builtin_amdgcn_global_load_lds((const unsigned*)(kg + (size_t)row * 256 + ch * 8), (LAS unsigned*)(slot + p * 1024), 16, 0, 0); }
    { const int row = 8 * wave + (lane >> 3); __builtin_amdgcn_global_load_lds((const unsigned*)(vg + (size_t)row * 256 + 8 * (lane & 7)), (LAS unsigned*)(slot + 32768 + wave * 1024), 16, 0, 0); }
}
__device__ __forceinline__ void s1c_state_pass(Frame& F, const int u_first, const int u_step) {
    const bf16* QKVO = WSP(bf16, WS_QKVO); const float* GATES = WSP(float, WS_GATES);
    bf16* CST = WSP(bf16, WS_CST); float* NST = WSP(float, WS_NST); f32x4* GV = WSP(f32x4, WS_GV);
    LAS float* WGA = (LAS float*)(F.lds + 3 * S1C_SLOT);
    LAS float* ACH = (LAS float*)(F.lds + SCR_OFF);
    const int wave = F.wave;
    const unsigned ldsK = (unsigned)(size_t)F.lds;
    for (int un = u_first; un < NB_P * NH * 4; un += u_step) {
        int lane = F.lane; asm volatile("" : "+v"(lane));
        const int g = lane >> 4, q = (lane & 15) >> 2, p = lane & 3;
        const int vq = un & 3, h = (un >> 2) & 3, b = un >> 4, bh = b * NH + h;
        const bf16* kg0 = QPL(1, h) + (size_t)(b * S_P) * 256; const bf16* vg0 = QPL(2, h) + (size_t)(b * S_P) * 256 + 64 * vq;
        asm volatile("s_waitcnt vmcnt(0)" ::: "memory"); __syncthreads();
        s1c_stage(F.lds, kg0, vg0, wave, lane); s1c_stage(F.lds + S1C_SLOT, kg0 + (size_t)64 * 256, vg0 + (size_t)64 * 256, wave, lane);
        {
            LAS float* BLS = ACH + 16; LAS float* MXS = ACH + 32; LAS float* MSS = ACH + 48; LAS float* MNS = ACH + 64;
            float gq[2][2], zq[2][2], pq[2][2], bq[2][2];
#pragma unroll
            for (int cc = 0; cc < 2; ++cc) { const int c = 2 * wave + cc; const size_t row = (size_t)(b * S_P + 128 * c + lane);
                const float li0 = GATES[row * 8 + h], li1 = GATES[(row + 64) * 8 + h], lf0 = GATES[row * 8 + 4 + h], lf1 = GATES[(row + 64) * 8 + 4 + h];
                const float b0 = scan_sum(lf0, lane), b1 = scan_sum(lf1, lane) + __shfl(b0, 63), bL = __shfl(b1, 63);
                gq[cc][0] = bL - b0 + li0; gq[cc][1] = bL - b1 + li1; const float mx = wave_max(fmaxf(gq[cc][0], gq[cc][1]));
                if (lane == 0) { BLS[c] = bL; MXS[c] = mx; }
                zq[cc][0] = li0 - b0; zq[cc][1] = li1 - b1; bq[cc][0] = b0; bq[cc][1] = b1;
                pq[cc][0] = scan_max(zq[cc][0], lane); pq[cc][1] = fmaxf(scan_max(zq[cc][1], lane), __shfl(pq[cc][0], 63)); }
            asm volatile("s_waitcnt vmcnt(0)" ::: "memory");
            __syncthreads();
            if (wave == 0 && lane == 0) { float m_run = 0.f;
                for (int c = 0; c < 16; ++c) { const float m_new = fmaxf(BLS[c] + m_run, MXS[c]); MSS[c] = m_run; MNS[c] = m_new; ACH[c] = expf(BLS[c] + m_run - m_new); m_run = m_new; }
                if (vq == 0) F.out[O_MP + bh] = m_run; }
            __syncthreads();
#pragma unroll
            for (int cc = 0; cc < 2; ++cc) { const int c = 2 * wave + cc; const float m_new = MNS[c], m_st = MSS[c];
                WGA[128 * c + lane] = expf(gq[cc][0] - m_new); WGA[128 * c + 64 + lane] = expf(gq[cc][1] - m_new);
                if (vq == 0) { const float M0 = fmaxf(m_st, pq[cc][0]), M1 = fmaxf(m_st, pq[cc][1]); const size_t row = (size_t)(b * S_P + 128 * c + lane);
                    GV[row * 4 + h] = (f32x4){zq[cc][0], M0, expf(m_st - M0), expf(-(bq[cc][0] + M0))}; GV[(row + 64) * 4 + h] = (f32x4){zq[cc][1], M1, expf(m_st - M1), expf(-(bq[cc][1] + M1))}; } }
            P0STAMP(23);
        }
        f32x4 acc[2][4], nacc[2];
#pragma unroll
        for (int i = 0; i < 2; ++i) { nacc[i] = (f32x4){0.f, 0.f, 0.f, 0.f};
#pragma unroll
            for (int j = 0; j < 4; ++j) acc[i][j] = (f32x4){0.f, 0.f, 0.f, 0.f}; }
        v4u ot; ot.x = ot.y = ot.z = ot.w = ((lane & 15) == 0) ? 0x3F803F80u : 0u; const bf16x8 ones = __builtin_bit_cast(bf16x8, ot);
        const bool do_n = (vq == 0);
        for (int sc = 0; sc < 32; ++sc) {
            const int c = sc >> 1;
            if (sc + 1 < 32) asm volatile("s_waitcnt vmcnt(5)" ::: "memory"); else asm volatile("s_waitcnt vmcnt(0)" ::: "memory");
            __builtin_amdgcn_s_barrier(); asm volatile("" ::: "memory");
            if ((sc & 1) == 0) {
                if (c >= 1) {
                    bf16* cp = CST + ((size_t)(bh * 16 + c) * DV + 64 * vq + (lane & 15)) * DK + 32 * wave + 4 * g;
#pragma unroll
                    for (int dt = 0; dt < 2; ++dt)
#pragma unroll
                        for (int vt = 0; vt < 4; ++vt) { v2u w; w.x = pk2(acc[dt][vt].x, acc[dt][vt].y); w.y = pk2(acc[dt][vt].z, acc[dt][vt].w); *(v2u*)(cp + (size_t)(16 * vt) * DK + 16 * dt) = w; }
                    if (do_n && (lane & 15) == 0) {
#pragma unroll
                        for (int dt = 0; dt < 2; ++dt) *(f32x4*)(NST + (size_t)(bh * 16 + c) * DK + 32 * wave + 16 * dt + 4 * g) = nacc[dt]; }
                }
            }
            if (sc + 2 < 32) s1c_stage(F.lds + ((sc + 2) % 3) * S1C_SLOT, kg0 + (size_t)(64 * (sc + 2)) * 256, vg0 + (size_t)(64 * (sc + 2)) * 256, wave, lane);
            if ((sc & 1) == 0) { const float a = ACH[c];
#pragma unroll
                for (int i = 0; i < 2; ++i) { nacc[i] = nacc[i] * a;
#pragma unroll
                    for (int j = 0; j < 4; ++j) acc[i][j] = acc[i][j] * a; } }
            const unsigned kb = ldsK + (sc % 3) * S1C_SLOT;
            const unsigned k00 = kb + img_off(8 * g + q, 4 * wave + (p >> 1)) + 8 * (p & 1), k01 = kb + img_off(8 * g + q, 4 * wave + 2 + (p >> 1)) + 8 * (p & 1);
            const unsigned k10 = kb + img_off(8 * g + q + 4, 4 * wave + (p >> 1)) + 8 * (p & 1), k11 = kb + img_off(8 * g + q + 4, 4 * wave + 2 + (p >> 1)) + 8 * (p & 1);
            const unsigned vb = kb + 32768 + (8 * g + q) * 128 + 8 * p;
            const LAS float* wgp = WGA + 64 * sc + 8 * g;
            s1c_kstep<0>(acc, nacc, k00, k01, k10, k11, vb, wgp, ones, do_n); s1c_kstep<1>(acc, nacc, k00, k01, k10, k11, vb, wgp, ones, do_n);
            asm volatile("" ::: "memory");
        }
        float* co = F.out + O_CP + ((size_t)bh * DV + 64 * vq + (lane & 15)) * DK + 32 * wave + 4 * g;
#pragma unroll
        for (int dt = 0; dt < 2; ++dt)
#pragma unroll
            for (int vt = 0; vt < 4; ++vt) *(f32x4*)(co + (size_t)(16 * vt) * DK + 16 * dt) = acc[dt][vt];
        if (do_n && (lane & 15) == 0) {
#pragma unroll
            for (int dt = 0; dt < 2; ++dt) *(f32x4*)(F.out + O_NP + (size_t)bh * DK + 32 * wave + 16 * dt + 4 * g) = nacc[dt]; }
    }
}
constexpr int S2R_SLOT = 32768;
__device__ __forceinline__ void s2r_stage(LAS unsigned char* slot, const bf16* src, size_t pitch, int wave, int lane) {
#pragma unroll
    for (int i = 0; i < 4; ++i) { const int p = wave + 8 * i, row = 2 * p + (lane >> 5), ch = (lane & 31) ^ (row & 15);
        __builtin_amdgcn_global_load_lds((const unsigned*)(src + (size_t)row * pitch + ch * 8), (LAS unsigned*)(slot + p * 1024), 16, 0, 0); }
}
__device__ __forceinline__ void s2r_stage_sub(Frame& F, LAS unsigned char* slot, int un, int ss, int wave, int lane) {
    const int c = un & 15, h = (un >> 4) & 3, b = un >> 6, bh = b * NH + h, r0 = b * S_P + 128 * c, k = c ? ss : ss + 4;
    const bf16* QKVO = WSP(bf16, WS_QKVO);
    if (k < 4) s2r_stage(slot, WSP(bf16, WS_CST) + ((size_t)(bh * 16 + c) * DV + 64 * k) * DK, DK, wave, lane);
    else if (k < 6) s2r_stage(slot, QKVO + (size_t)(r0 + 64 * (k - 4)) * NIN + 1024 + 256 * h, NIN, wave, lane);
    else s2r_stage(slot, QKVO + (size_t)(r0 + 64 * (k - 6)) * NIN + 2048 + 256 * h, NIN, wave, lane);
}
template <int J> __device__ __forceinline__ void s2r_gq(f32x4 (&acc)[16], const LAS unsigned char* sl, const bf16x8 (&Qf)[8], int lane) {
    asm volatile("" : "+v"(lane)); const int li_ = lane & 15, g = lane >> 4;
#pragma unroll
    for (int t = 0; t < 4; ++t) {
#pragma unroll
        for (int kd = 0; kd < 8; ++kd) { acc[4 * J + t] = MFMA16(*(const LAS bf16x8*)(sl + img_off(16 * t + li_, 4 * kd + g)), Qf[kd], acc[4 * J + t]); if ((kd & 3) == 3) __builtin_amdgcn_sched_barrier(0); } }
}
template <int I> __device__ __forceinline__ void s2r_sh(bf16x8 (&Sf)[4], float& dsum, const LAS unsigned char* sl, const bf16x8 (&Qf)[8], const LAS float* ZS, float Ml, int wave, int lane) {
    asm volatile("" : "+v"(lane)); const int li_ = lane & 15, g = lane >> 4, lrow = 16 * wave + li_;
#pragma unroll
    for (int kk = 0; kk < 2; ++kk) { const int ks = 2 * I + kk;
        f32x4 sa = (f32x4){0.f, 0.f, 0.f, 0.f}, sb = sa;
#pragma unroll
        for (int kd = 0; kd < 8; ++kd) { sa = MFMA16(*(const LAS bf16x8*)(sl + img_off(32 * kk + li_, 4 * kd + g)), Qf[kd], sa); sb = MFMA16(*(const LAS bf16x8*)(sl + img_off(32 * kk + 16 + li_, 4 * kd + g)), Qf[kd], sb);
            if (kd & 1) __builtin_amdgcn_sched_barrier(0); }
        const f32x4 za = *(const LAS f32x4*)(ZS + 32 * ks + 4 * g), zb = *(const LAS f32x4*)(ZS + 32 * ks + 16 + 4 * g);
#pragma unroll
        for (int r = 0; r < 4; ++r) { const int da = lrow - (32 * ks + 4 * g + r);
            sa[r] = __builtin_bit_cast(float, __builtin_bit_cast(unsigned, sa[r] * __expf(za[r] - Ml)) & ~(unsigned)(da >> 31));
            sb[r] = __builtin_bit_cast(float, __builtin_bit_cast(unsigned, sb[r] * __expf(zb[r] - Ml)) & ~(unsigned)((da - 16) >> 31)); dsum += sa[r] + sb[r]; }
        Sf[ks] = pack_f8(sa, sb);
        __builtin_amdgcn_sched_barrier(0); }
}
template <int VT> __device__ __forceinline__ void s2r_hv(f32x4& acc, const unsigned base, const bf16x8 S0, const bf16x8 S1) {
    constexpr int HI = (VT >> 3) * 256;
    v2u r0, r1, r2, r3;
    asm volatile("ds_read_b64_tr_b16 %0, %4 offset:%5\n\tds_read_b64_tr_b16 %1, %4 offset:%6\n\tds_read_b64_tr_b16 %2, %4 offset:%7\n\tds_read_b64_tr_b16 %3, %4 offset:%8\n\ts_waitcnt lgkmcnt(0)"
                 : "=&v"(r0), "=&v"(r1), "=&v"(r2), "=&v"(r3) : "v"(base), "i"(HI), "i"(HI + 8192), "i"(HI + 16384), "i"(HI + 24576) : "memory");
    v4u f;
    f.x = r0.x; f.y = r0.y; f.z = r1.x; f.w = r1.y; acc = MFMA16(__builtin_bit_cast(bf16x8, f), S0, acc);
    f.x = r2.x; f.y = r2.y; f.z = r3.x; f.w = r3.y; acc = MFMA16(__builtin_bit_cast(bf16x8, f), S1, acc);
}
__device__ __forceinline__ void s2r_hh(f32x4 (&acc)[16], const unsigned slb, const bf16x8 S0, const bf16x8 S1, int lane) {
    asm volatile("" : "+v"(lane)); const int g = lane >> 4, q = (lane & 15) >> 2, p = lane & 3;
    unsigned hb[8];
#pragma unroll
    for (int j = 0; j < 8; ++j) hb[j] = slb + img_off(4 * g + q, 2 * j + (p >> 1)) + 8 * (p & 1);
    s2r_hv<0>(acc[0], hb[0], S0, S1); s2r_hv<1>(acc[1], hb[1], S0, S1); s2r_hv<2>(acc[2], hb[2], S0, S1); s2r_hv<3>(acc[3], hb[3], S0, S1);
    s2r_hv<4>(acc[4], hb[4], S0, S1); s2r_hv<5>(acc[5], hb[5], S0, S1); s2r_hv<6>(acc[6], hb[6], S0, S1); s2r_hv<7>(acc[7], hb[7], S0, S1);
    s2r_hv<8>(acc[8], hb[0], S0, S1); s2r_hv<9>(acc[9], hb[1], S0, S1); s2r_hv<10>(acc[10], hb[2], S0, S1); s2r_hv<11>(acc[11], hb[3], S0, S1);
    s2r_hv<12>(acc[12], hb[4], S0, S1); s2r_hv<13>(acc[13], hb[5], S0, S1); s2r_hv<14>(acc[14], hb[6], S0, S1); s2r_hv<15>(acc[15], hb[7], S0, S1);
}
__device__ __forceinline__ void s2r_output_pass(Frame& F) {
    const bf16* QKVO = WSP(bf16, WS_QKVO); const float* NST = WSP(float, WS_NST); bf16* A2 = WSP(bf16, WS_A2);
    const int wave = F.wave;
    const unsigned ldsR = (unsigned)(size_t)F.lds;
    int nun = 0, total = 0;
    for (int un = F.vcu; un < NB_P * NH * 16; un += F.G) { ++nun; total += (un & 15) ? 8 : 4; }
    if (total == 0) return;
    asm volatile("s_waitcnt vmcnt(0)" ::: "memory"); __syncthreads();
    int sj = 0, ss = 0;
#pragma unroll
    for (int s = 0; s < 3; ++s) if (s < total) { const int un = F.vcu + sj * F.G; s2r_stage_sub(F, F.lds + s * S2R_SLOT, un, ss, wave, F.lane); if (++ss == ((un & 15) ? 8 : 4)) { ss = 0; ++sj; } }
    int cj = 0, cs = 0;
    f32x4 acc[16]; bf16x8 Qf[8], Sf[4]; v2u ovr[16]; float dsum = 0.f, gn = 0.f;
    for (int gs = 0; gs < total; ++gs) {
        int lane = F.lane; asm volatile("" : "+v"(lane));
        const int g = lane >> 4, q = (lane & 15) >> 2, p = lane & 3, li_ = lane & 15, lrow = 16 * wave + li_;
        const int un = F.vcu + cj * F.G, c = un & 15, h = (un >> 4) & 3, b = un >> 6, bh = b * NH + h, r0 = b * S_P + 128 * c, k = c ? cs : cs + 4, par = cj & 1;
        LAS float* ZS = (LAS float*)(F.lds + SCR_OFF) + par * 1024; LAS float* LM = ZS + 128; LAS float* LW = ZS + 256; LAS float* LE = ZS + 384; LAS float* NS = ZS + 512; LAS float* HN = ZS + 768;
        const size_t row = (size_t)(r0 + lrow);
        if (cs == 0) {
            if (F.tid < 128) { const f32x4 gv = WSP(f32x4, WS_GV)[(size_t)(r0 + F.tid) * 4 + h]; ZS[F.tid] = gv.x; LM[F.tid] = gv.y; LW[F.tid] = gv.z; LE[F.tid] = gv.w; }
            if (F.tid >= 128 && F.tid < 192) *(LAS f32x4*)(HN + 4 * (F.tid - 128)) = *(const f32x4*)(F.head_norm + 256 * h + 4 * (F.tid - 128));
            if (F.tid < 64) *(LAS f32x4*)(NS + 4 * F.tid) = c ? *(const f32x4*)(NST + (size_t)(bh * 16 + c) * DK + 4 * F.tid) : (f32x4){0.f, 0.f, 0.f, 0.f};
#pragma unroll
            for (int kd = 0; kd < 8; ++kd) Qf[kd] = *(const bf16x8*)(QKVO + row * NIN + 256 * h + 32 * kd + 8 * g);
#pragma unroll
            for (int vt = 0; vt < 16; ++vt) acc[vt] = (f32x4){0.f, 0.f, 0.f, 0.f};
            dsum = 0.f;
        }
        const int rem = total - 1 - gs;
        if (rem >= 2) asm volatile("s_waitcnt vmcnt(8)" ::: "memory"); else if (rem == 1) asm volatile("s_waitcnt vmcnt(4)" ::: "memory"); else asm volatile("s_waitcnt vmcnt(0)" ::: "memory");
        __builtin_amdgcn_s_barrier(); asm volatile("" ::: "memory");
        if (gs + 3 < total) { const int sun = F.vcu + sj * F.G; s2r_stage_sub(F, F.lds + ((gs + 3) & 3) * S2R_SLOT, sun, ss, wave, lane); if (++ss == ((sun & 15) ? 8 : 4)) { ss = 0; ++sj; } }
        const LAS unsigned char* sl = F.lds + (gs & 3) * S2R_SLOT; const unsigned slb = ldsR + (gs & 3) * S2R_SLOT;
        if (k == 0) s2r_gq<0>(acc, sl, Qf, lane);
        else if (k == 1) s2r_gq<1>(acc, sl, Qf, lane);
        else if (k == 2) s2r_gq<2>(acc, sl, Qf, lane);
        else if (k == 3) { s2r_gq<3>(acc, sl, Qf, lane); const float wl = LW[lrow];
#pragma unroll
            for (int vt = 0; vt < 16; ++vt) acc[vt] = acc[vt] * wl; }
        else if (k == 4) s2r_sh<0>(Sf, dsum, sl, Qf, ZS, LM[lrow], wave, lane);
        else if (k == 5) { s2r_sh<1>(Sf, dsum, sl, Qf, ZS, LM[lrow], wave, lane);
            gn = 0.f;
#pragma unroll
            for (int kd = 0; kd < 8; ++kd) { const v4u qw = __builtin_bit_cast(v4u, Qf[kd]); const f32x4 n0 = *(const LAS f32x4*)(NS + 32 * kd + 8 * g), n1 = *(const LAS f32x4*)(NS + 32 * kd + 8 * g + 4);
                gn += (bflo(qw.x) * n0.x + bfhi(qw.x) * n0.y) + (bflo(qw.y) * n0.z + bfhi(qw.y) * n0.w) + (bflo(qw.z) * n1.x + bfhi(qw.z) * n1.y) + (bflo(qw.w) * n1.z + bfhi(qw.w) * n1.w); }
            gn += __shfl_xor(gn, 16); gn += __shfl_xor(gn, 32); }
        else if (k == 6) {
            { const bf16* ob = QKVO + row * NIN + 3072 + 256 * h + 4 * g;
#pragma unroll
              for (int vt = 0; vt < 16; ++vt) ovr[vt] = *(const v2u*)(ob + 16 * vt); }
            s2r_hh(acc, slb, Sf[0], Sf[1], lane); }
        else {
            s2r_hh(acc, slb, Sf[2], Sf[3], lane);
            float ds = dsum; ds += __shfl_xor(ds, 16); ds += __shfl_xor(ds, 32);
            __builtin_amdgcn_sched_barrier(0);
            const float den = LW[lrow] * gn + ds, inv = __builtin_amdgcn_rcpf(fmaxf(fabsf(den), LE[lrow]));
            float ssq = 0.f;
#pragma unroll
            for (int vt = 0; vt < 16; ++vt) { acc[vt] = acc[vt] * inv; ssq += (acc[vt].x * acc[vt].x + acc[vt].y * acc[vt].y) + (acc[vt].z * acc[vt].z + acc[vt].w * acc[vt].w); }
            ssq += __shfl_xor(ssq, 16); ssq += __shfl_xor(ssq, 32);
            const float rn = rsqrtf(ssq * (1.f / 256.f) + EPS);
            { bf16* ab = A2 + row * DM + 256 * h + 4 * g;
#pragma unroll
            for (int vt = 0; vt < 16; ++vt) {
                const f32x4 ov = bf4_to_f(ovr[vt]), gh = *(const LAS f32x4*)(HN + 16 * vt + 4 * g) * rn;
                const f32x4 sg = (f32x4){__builtin_amdgcn_rcpf(1.f + __expf(-ov.x)), __builtin_amdgcn_rcpf(1.f + __expf(-ov.y)), __builtin_amdgcn_rcpf(1.f + __expf(-ov.z)), __builtin_amdgcn_rcpf(1.f + __expf(-ov.w))};
                const f32x4 o = acc[vt] * gh * sg;
                v2u w; w.x = pk2(o.x, o.y); w.y = pk2(o.z, o.w);
                *(v2u*)(ab + 16 * vt) = w;
                if ((vt & 3) == 3) __builtin_amdgcn_sched_barrier(0); } }
        }
        asm volatile("" ::: "memory");
        if (++cs == (c ? 8 : 4)) { cs = 0; ++cj; }
    }
    asm volatile("s_waitcnt vmcnt(0)" ::: "memory"); __syncthreads();
}
namespace epf {
using pg8::Unit; using pg8::bf16_t; using pg8::BM; using pg8::HALF; using pg8::u32x4;
typedef __amdgpu_buffer_rsrc_t rsrc_t;
__device__ __forceinline__ rsrc_t mk(const void* p, size_t bytes) { return __builtin_amdgcn_make_buffer_rsrc((void*)p, 0, (int)bytes, 0x00020000); }
__device__ __forceinline__ void st16(rsrc_t r, unsigned off, u32x4 v) { __builtin_amdgcn_raw_buffer_store_b128(v, r, (int)off, 0, 16); }
__device__ __forceinline__ void st16f(rsrc_t r, unsigned off, f32x4 v) { __builtin_amdgcn_raw_buffer_store_b128(__builtin_bit_cast(u32x4, v), r, (int)off, 0, 16); }
__device__ __forceinline__ void st8(rsrc_t r, unsigned off, v2u v) { __builtin_amdgcn_raw_buffer_store_b64(v, r, (int)off, 0, 16); }
__device__ __forceinline__ void st4f(rsrc_t r, unsigned off, float v) { __builtin_amdgcn_raw_buffer_store_b32(__builtin_bit_cast(unsigned, v), r, (int)off, 0, 16); }
__device__ __forceinline__ f32x4 ld16f(rsrc_t r, unsigned off) { return __builtin_bit_cast(f32x4, __builtin_amdgcn_raw_buffer_load_b128(r, (int)off, 0, 16)); }
__device__ __forceinline__ v2u ld8(rsrc_t r, unsigned off) { return __builtin_amdgcn_raw_buffer_load_b64(r, (int)off, 0, 16); }
__device__ __forceinline__ float row_rs(rsrc_t slab, int row) {
    const f32x4 a = ld16f(slab, (unsigned)row * 64u), b = ld16f(slab, (unsigned)row * 64u + 16u), c = ld16f(slab, (unsigned)row * 64u + 32u), d = ld16f(slab, (unsigned)row * 64u + 48u);
    const float s = (((a.x + a.y) + (a.z + a.w)) + ((b.x + b.y) + (b.z + b.w))) + (((c.x + c.y) + (c.z + c.w)) + ((d.x + d.y) + (d.z + d.w)));
    return rsqrtf(s * (1.f / 1024.f) + EPS);
}
using ep::pack8; using ep::silu_mul;

struct EpiSwiGLU {
    static constexpr bool PERM = true, AFTER_DRAIN = false;
    rsrc_t O; rsrc_t ssq;
    __device__ __forceinline__ void operator()(const f32x4 (&acc)[2][2][4][2], const Unit& u, int wr, int wc, int fr, int fq) const {
        const int row0 = u.pm * BM + wr * 64 + fr, col0 = u.pn * HALF + wc * 32 + 8 * fq;
#pragma unroll
        for (int ai = 0; ai < 2; ++ai)
#pragma unroll
            for (int m = 0; m < 4; ++m) { const int row = row0 + ai * HALF + m * 16; const float r = row_rs(ssq, row);
                const f32x4 g0 = acc[ai][0][m][0] * r, g1 = acc[ai][0][m][1] * r, u0 = acc[ai][1][m][0] * r, u1 = acc[ai][1][m][1] * r;
                f32x4 h0, h1;
#pragma unroll
                for (int j = 0; j < 4; ++j) { h0[j] = silu_mul(g0[j], u0[j]); h1[j] = silu_mul(g1[j], u1[j]); }
                st16(O, ((unsigned)row * DFF + col0) * 2u, pack8(h0, h1)); }
    }
};
template <bool WB, bool BASE_Y> struct EpiResid {
    static constexpr bool PERM = true, AFTER_DRAIN = false;
    const float* baseP; const float* baseS; rsrc_t Y; rsrc_t XB; rsrc_t ssq;
    __device__ __forceinline__ void operator()(const f32x4 (&acc)[2][2][4][2], const Unit& u, int wr, int wc, int fr, int fq) const {
        const int row0 = u.pm * BM + wr * 64 + fr, col0 = u.pn * BM + wc * 32 + 8 * fq;
#pragma unroll
        for (int ai = 0; ai < 2; ++ai)
#pragma unroll
            for (int m = 0; m < 4; ++m) { const int row = row0 + ai * HALF + m * 16; const unsigned eo = (unsigned)row * DM + col0;
                const float* bp = (row < MP ? baseP + (size_t)row * DM : baseS + (size_t)(row - MP) * DM) + col0;
                float ss = 0.f;
#pragma unroll
                for (int bj = 0; bj < 2; ++bj) {
                    f32x4 b0, b1;
                    if (BASE_Y) { b0 = ld16f(Y, (eo + bj * HALF) * 4u); b1 = ld16f(Y, (eo + bj * HALF + 4) * 4u); } else { b0 = *(const f32x4*)(bp + bj * HALF); b1 = *(const f32x4*)(bp + bj * HALF + 4); }
                    const f32x4 x0 = b0 + acc[ai][bj][m][0], x1 = b1 + acc[ai][bj][m][1];
                    st16f(Y, (eo + bj * HALF) * 4u, x0); st16f(Y, (eo + bj * HALF + 4) * 4u, x1);
                    if (WB) { st16(XB, (eo + bj * HALF) * 2u, pack8(x0, x1));
                        ss += ((x0[0] * x0[0] + x0[1] * x0[1]) + (x0[2] * x0[2] + x0[3] * x0[3])) + ((x1[0] * x1[0] + x1[1] * x1[1]) + (x1[2] * x1[2] + x1[3] * x1[3])); } }
                if (WB) { ss += __shfl_xor(ss, 16); ss += __shfl_xor(ss, 32); if (fq == 0) st4f(ssq, ((unsigned)row * 16 + u.pn * 4 + wc) * 4u, ss); } }
    }
};
struct EpiConvIn {
    static constexpr bool PERM = true, AFTER_DRAIN = false;
    rsrc_t BG; rsrc_t U; rsrc_t ssq; float* cvP; float* cvS;
    __device__ __forceinline__ void operator()(const f32x4 (&acc)[2][2][4][2], const Unit& u, int wr, int wc, int fr, int fq) const {
        const int row0 = u.pm * BM + wr * 64 + fr;
        if (u.pn < 4) {
            const int col0 = u.pn * BM + wc * 32 + 8 * fq;
#pragma unroll
            for (int ai = 0; ai < 2; ++ai)
#pragma unroll
                for (int m = 0; m < 4; ++m) { const int row = row0 + ai * HALF + m * 16; const float r = row_rs(ssq, row);
#pragma unroll
                    for (int bj = 0; bj < 2; ++bj) st16(BG, ((unsigned)row * DM + col0 + bj * HALF) * 2u, pack8(acc[ai][bj][m][0] * r, acc[ai][bj][m][1] * r)); }
        } else {
            const int col0 = (u.pn - 4) * HALF + wc * 32 + 8 * fq;
#pragma unroll
            for (int ai = 0; ai < 2; ++ai)
#pragma unroll
                for (int m = 0; m < 4; ++m) { const int row = row0 + ai * HALF + m * 16; const float r = row_rs(ssq, row);
                    const f32x4 p0 = (acc[ai][0][m][0] * r) * (acc[ai][1][m][0] * r), p1 = (acc[ai][0][m][1] * r) * (acc[ai][1][m][1] * r);
                    st16(U, ((unsigned)row * DM + col0) * 2u, pack8(p0, p1));
                    float* sp = nullptr;
                    if (row < MP) { const int t = row & (S_P - 1), b = row >> 11; if (t >= S_P - 2) sp = cvP + (size_t)(b * 2 + (t - (S_P - 2))) * DM + col0; }
                    else { const int rs = row - MP, t = rs & (S_S - 1), b = rs >> 3; if (t >= S_S - 2) sp = cvS + (size_t)(b * 2 + (t - (S_S - 2))) * DM + col0; }
                    if (sp) { *(f32x4*)sp = p0; *(f32x4*)(sp + 4) = p1; } }
        }
    }
};
}

constexpr int CW_CNT = 16384;
constexpr int CW_TMO = 8;
__device__ __forceinline__ void flow_poll(const unsigned* p, unsigned need, unsigned* tmo) {
    unsigned spins = 0;
    while ((unsigned)__builtin_amdgcn_readfirstlane(__hip_atomic_load(p, __ATOMIC_RELAXED, __HIP_MEMORY_SCOPE_AGENT)) < need) {
        __builtin_amdgcn_s_sleep(2);
        if (++spins > (1u << 18)) { if ((threadIdx.x & 63) == 0) __hip_atomic_store(tmo, 1u, __ATOMIC_RELAXED, __HIP_MEMORY_SCOPE_AGENT); break; }
    }
}
struct FlowOrder : pg8::StaticOrder {
    const unsigned* dep; unsigned need; unsigned* pub; unsigned* tmo; int wgm; mutable int pend;
    __device__ __forceinline__ bool next(int i, pg8::Unit& u) const {
        const long L = (long)i * G + c; if (L >= nwg) return false;
        int wgid = (int)L; { const int q = nwg / pg8::NXCD, r = nwg % pg8::NXCD, xcd = wgid % pg8::NXCD, off = wgid / pg8::NXCD; wgid = (xcd < r ? xcd * (q + 1) : r * (q + 1) + (xcd - r) * q) + off; }
        const int nig = wgm * nN, gid = wgid / nig, fm = gid * wgm, gsz = (nM - fm) < wgm ? (nM - fm) : wgm;
        u.pm = fm + ((wgid % nig) % gsz); u.pn = (wgid % nig) / gsz; return true;
    }
    __device__ __forceinline__ void a_ready(const pg8::Unit& u) const {
        if (dep) {
            if (threadIdx.x < 64) flow_poll(dep + 64 * u.pm, need, tmo);
            asm volatile("" ::: "memory"); __builtin_amdgcn_s_barrier(); asm volatile("" ::: "memory");
        }
    }
    __device__ __forceinline__ void done(const pg8::Unit& u) const { pend = u.pm; }
    __device__ __forceinline__ void pre_prologue() const {}
    __device__ __forceinline__ void mid_prologue() const {}
    __device__ __forceinline__ void flush() const {
        if (pend >= 0) { if ((threadIdx.x & 63) == 0) __hip_atomic_fetch_add(pub + 64 * pend, 1u, __ATOMIC_RELAXED, __HIP_MEMORY_SCOPE_AGENT); pend = -1; }
    }
};
template <class Epi>
__device__ __forceinline__ void flow_gemm(Frame& F, const pg8::Gemm g, const Epi& E, int rot, const unsigned* dep, unsigned need, unsigned* pub) {
    FlowOrder S; S.init(g.M, g.N, F.G, (int)((blockIdx.x + F.G - (unsigned)(rot % F.G)) % F.G)); S.dep = dep; S.need = need; S.pub = pub; S.tmo = (unsigned*)(F.ctl + CW_TMO); S.wgm = 2; S.pend = -1;
    pg8::gemm_phase<Epi, FlowOrder, true, true>(F.lds + RING_OFF, g, S, E);
}
__device__ __forceinline__ void conv_flow(Frame& F, int rot, const unsigned* dep, unsigned* pub) {
    const epf::rsrc_t BG = epf::mk(F.ws + WS_BG, (size_t)MT * DM * 2), U = epf::mk(F.ws + WS_U, (size_t)MT * DM * 2), A2 = epf::mk(F.ws + WS_A2, (size_t)MT * DM * 2);
    unsigned* tmo = (unsigned*)(F.ctl + CW_TMO);
    const int c = (int)((blockIdx.x + F.G - (unsigned)(rot % F.G)) % F.G);
    for (int pm = c; pm < MT / 256; pm += F.G) {
        if (F.tid < 64) { flow_poll(dep + 64 * pm, 96u, tmo); if (pm < MP / 256 && (pm & 7)) flow_poll(dep + 64 * (pm - 1), 96u, tmo); }
        __syncthreads();
        for (int rr = F.wave; rr < 256; rr += NWAVES) {
            const int row = pm * 256 + rr; const bool smp = row >= MP; const int t = smp ? (row - MP) & (S_S - 1) : row & (S_P - 1), b = smp ? (row - MP) >> 3 : row >> 11;
            const f32x4* sb = (const f32x4*)(F.stConv + (size_t)b * 2 * DM) + F.lane;
#pragma unroll
            for (int j = 0; j < 4; ++j) {
                const unsigned eo = ((unsigned)row * DM + 4 * F.lane + 256 * j) * 2u;
                const v2u uc = epf::ld8(U, eo), bw = epf::ld8(BG, eo);
                const f32x4 w0 = ((const f32x4*)F.w_taps + F.lane)[64 * j], w1 = ((const f32x4*)(F.w_taps + DM) + F.lane)[64 * j], w2 = ((const f32x4*)(F.w_taps + 2 * DM) + F.lane)[64 * j];
                f32x4 a = (f32x4){0.f, 0.f, 0.f, 0.f}, cc = a;
                if (t >= 2) a = bf4_to_f(epf::ld8(U, eo - 2u * DM * 2u)); else if (smp) a = sb[(t == 0 ? 0 : 256) + 64 * j];
                if (t >= 1) cc = bf4_to_f(epf::ld8(U, eo - DM * 2u)); else if (smp) cc = sb[256 + 64 * j];
                const f32x4 y = bf4_to_f(bw) * (w0 * a + w1 * cc + w2 * bf4_to_f(uc));
                v2u w; w.x = pk2(y.x, y.y); w.y = pk2(y.z, y.w); epf::st8(A2, eo, w);
            }
        }
        VM_WAIT();
        if (F.lane == 0) __hip_atomic_fetch_add(pub + 64 * pm, 1u, __ATOMIC_RELAXED, __HIP_MEMORY_SCOPE_AGENT);
    }
}
__device__ __forceinline__ void fnorm_flow(Frame& F, int rot, const unsigned* dep) {
    const epf::rsrc_t Y = epf::mk(F.out + O_Y, (size_t)MT * DM * 4);
    unsigned* tmo = (unsigned*)(F.ctl + CW_TMO);
    const int c = (int)((blockIdx.x + F.G - (unsigned)(rot % F.G)) % F.G);
    for (int it = c; it < (MT / 256) * 4; it += F.G) {
        const int pm = it >> 2, qq = it & 3;
        if (F.tid < 64) flow_poll(dep + 64 * pm, 32u, tmo);
        __syncthreads();
        for (int rr = F.wave; rr < 64; rr += NWAVES) {
            const int row = pm * 256 + qq * 64 + rr; const unsigned eo = ((unsigned)row * DM + 4 * F.lane) * 4u;
            const f32x4* gr = (const f32x4*)F.norm_final + F.lane; f32x4* xo = (f32x4*)(F.out + O_Y + (size_t)row * DM) + F.lane;
            f32x4 v[4]; float s = 0.f;
#pragma unroll
            for (int j = 0; j < 4; ++j) { v[j] = epf::ld16f(Y, eo + 1024u * j); s += (v[j].x * v[j].x + v[j].y * v[j].y) + (v[j].z * v[j].z + v[j].w * v[j].w); }
            const float r = rsqrtf(wave_sum(s) * (1.f / 1024.f) + EPS);
#pragma unroll
            for (int j = 0; j < 4; ++j) xo[64 * j] = v[j] * r * gr[64 * j];
        }
    }
}
namespace sg {
constexpr int BKS = 128, SLOTB = 32768, NSLOT = 4;
__device__ __forceinline__ unsigned soff(unsigned row, unsigned ch) { return row * 256u + ((ch ^ (row & 15u)) << 4); }
struct MapPlain { __device__ __forceinline__ int operator()(int tn, int r) const { return 64 * tn + r; } };
struct MapGU { __device__ __forceinline__ int operator()(int tn, int r) const { const int c0 = 32 * tn; return 256 * (c0 >> 7) + (c0 & 127) + 128 * ((r >> 4) & 1) + 16 * (r >> 5) + (r & 15); } };
struct MapCin { __device__ __forceinline__ int operator()(int tn, int r) const { if (tn < 16) return 64 * tn + r; const int c0 = 32 * (tn - 16); return DM + 256 * (c0 >> 7) + (c0 & 127) + 128 * ((r >> 4) & 1) + 16 * (r >> 5) + (r & 15); } };

template <class Map>
__device__ __forceinline__ void stage(LAS unsigned char* slot, const bf16* A, const bf16* Bt, int K, int ks, int tn, const Map& map, int wave, int lane) {
    const int rr = lane >> 4, cs = lane & 15;
#pragma unroll
    for (int i = 0; i < 4; ++i) { const int pr = (wave + 8 * i) & 15, row = 4 * pr + rr, ch = cs ^ (row & 15);
        const bf16* src = (i < 2) ? A + (size_t)row * K + ks * BKS + ch * 8 : Bt + (size_t)map(tn, row) * K + ks * BKS + ch * 8;
        __builtin_amdgcn_global_load_lds((const unsigned*)src, (LAS unsigned*)(slot + (i < 2 ? 0 : 16384) + pr * 1024), 16, 0, 0); }
}
template <class Epi, class Map>
__device__ __forceinline__ void run(LAS unsigned char* lds, const bf16* Abase  , const bf16* Bt, int K, const Map& map, const Epi& E, int t_first, int t_step, int t_end) {
    const int tid = threadIdx.x, wave = __builtin_amdgcn_readfirstlane(tid >> 6), wr = wave >> 1, wc = wave & 1;
    const int nK = K / BKS, ntile = t_first < t_end ? (t_end - t_first + t_step - 1) / t_step : 0, total = ntile * nK;
    if (total == 0) return;
    int lane = tid & 63; asm volatile("" : "+v"(lane));
    const int lr = lane & 15, g = lane >> 4;
    asm volatile("" ::: "memory"); __builtin_amdgcn_s_barrier(); asm volatile("" ::: "memory");
    int sj = 0, sk = 0;
#pragma unroll
    for (int s = 0; s < 3; ++s) if (s < total) { const int ti = t_first + sj * t_step; stage(lds + s * SLOTB, Abase + (size_t)(64 * (ti & 15)) * K, Bt, K, sk, ti >> 4, map, wave, lane); if (++sk == nK) { sk = 0; ++sj; } }
    f32x4 acc[2] = {(f32x4){0.f, 0.f, 0.f, 0.f}, (f32x4){0.f, 0.f, 0.f, 0.f}};
    int cj = 0, ck = 0;
    for (int gs = 0; gs < total; ++gs) {
        const int rem = total - 1 - gs;
        if (rem >= 2) asm volatile("s_waitcnt vmcnt(8)" ::: "memory"); else if (rem == 1) asm volatile("s_waitcnt vmcnt(4)" ::: "memory"); else asm volatile("s_waitcnt vmcnt(0)" ::: "memory");
        __builtin_amdgcn_s_barrier(); asm volatile("" ::: "memory");
        if (gs + 3 < total) { const int ti = t_first + sj * t_step; stage(lds + ((gs + 3) & 3) * SLOTB, Abase + (size_t)(64 * (ti & 15)) * K, Bt, K, sk, ti >> 4, map, wave, lane); if (++sk == nK) { sk = 0; ++sj; } }
        const LAS unsigned char* sl = lds + (gs & 3) * SLOTB;
#pragma unroll
        for (int kk = 0; kk < 4; ++kk) {
            const bf16x8 a = *(const LAS bf16x8*)(sl + soff(16 * wr + lr, 4 * kk + g));
            const bf16x8 b0 = *(const LAS bf16x8*)(sl + 16384 + soff(32 * wc + lr, 4 * kk + g)), b1 = *(const LAS bf16x8*)(sl + 16384 + soff(32 * wc + 16 + lr, 4 * kk + g));
            acc[0] = __builtin_amdgcn_mfma_f32_16x16x32_bf16(b0, a, acc[0], 0, 0, 0); acc[1] = __builtin_amdgcn_mfma_f32_16x16x32_bf16(b1, a, acc[1], 0, 0, 0);
        }
        asm volatile("" ::: "memory");
        if (++ck == nK) { const int ti = t_first + cj * t_step; E(acc, ti & 15, ti >> 4, wr, wc, lr, g); acc[0] = (f32x4){0.f, 0.f, 0.f, 0.f}; acc[1] = acc[0]; ck = 0; ++cj; }
    }
    asm volatile("s_waitcnt vmcnt(0)" ::: "memory"); __builtin_amdgcn_s_barrier(); asm volatile("" ::: "memory");
}

__device__ __forceinline__ unsigned soff128(unsigned row, unsigned ch) { return row * 128u + ((ch ^ (row & 7u)) << 4); }
template <class Map>
__device__ __forceinline__ void stage128(LAS unsigned char* slot, const bf16* A, const bf16* Bt, int K, int ks, int TN, const Map& map, int wave, int lane) {
    const int rr = lane >> 3, cs = lane & 7;
#pragma unroll
    for (int i = 0; i < 4; ++i) { const int pr = (wave + 8 * i) & 15, row = 8 * pr + rr, ch = cs ^ (row & 7);
        const bf16* src = (i < 2) ? A + (size_t)row * K + ks * 64 + ch * 8 : Bt + (size_t)map(2 * TN + (row >> 6), row & 63) * K + ks * 64 + ch * 8;
        __builtin_amdgcn_global_load_lds((const unsigned*)src, (LAS unsigned*)(slot + (i < 2 ? 0 : 16384) + pr * 1024), 16, 0, 0); }
}
template <class Epi, class Map>
__device__ __forceinline__ void run128(LAS unsigned char* lds, const bf16* Abase, const bf16* Bt, int K, const Map& map, const Epi& E, int t_first, int t_step, int t_end) {
    const int tid = threadIdx.x, wave = __builtin_amdgcn_readfirstlane(tid >> 6), wr = wave >> 1, wc = wave & 1;
    const int nK = K / 64, ntile = t_first < t_end ? (t_end - t_first + t_step - 1) / t_step : 0, total = ntile * nK;
    if (total == 0) return;
    int lane = tid & 63; asm volatile("" : "+v"(lane));
    const int lr = lane & 15, g = lane >> 4;
    asm volatile("" ::: "memory"); __builtin_amdgcn_s_barrier(); asm volatile("" ::: "memory");
    int sj = 0, sk = 0;
#pragma unroll
    for (int s = 0; s < 3; ++s) if (s < total) { const int ti = t_first + sj * t_step; stage128(lds + s * SLOTB, Abase + (size_t)(128 * (ti & 7)) * K, Bt, K, sk, ti >> 3, map, wave, lane); if (++sk == nK) { sk = 0; ++sj; } }
    f32x4 acc[2][4];
#pragma unroll
    for (int i = 0; i < 2; ++i)
#pragma unroll
        for (int n = 0; n < 4; ++n) acc[i][n] = (f32x4){0.f, 0.f, 0.f, 0.f};
    int cj = 0, ck = 0;
    for (int gs = 0; gs < total; ++gs) {
        const int rem = total - 1 - gs;
        if (rem >= 2) asm volatile("s_waitcnt vmcnt(8)" ::: "memory"); else if (rem == 1) asm volatile("s_waitcnt vmcnt(4)" ::: "memory"); else asm volatile("s_waitcnt vmcnt(0)" ::: "memory");
        __builtin_amdgcn_s_barrier(); asm volatile("" ::: "memory");
        if (gs + 3 < total) { const int ti = t_first + sj * t_step; stage128(lds + ((gs + 3) & 3) * SLOTB, Abase + (size_t)(128 * (ti & 7)) * K, Bt, K, sk, ti >> 3, map, wave, lane); if (++sk == nK) { sk = 0; ++sj; } }
        const LAS unsigned char* sl = lds + (gs & 3) * SLOTB;
#pragma unroll
        for (int kk = 0; kk < 2; ++kk) {
            bf16x8 a[2], bb[4];
#pragma unroll
            for (int i = 0; i < 2; ++i) a[i] = *(const LAS bf16x8*)(sl + soff128(32 * wr + 16 * i + lr, 4 * kk + g));
#pragma unroll
            for (int n = 0; n < 4; ++n) bb[n] = *(const LAS bf16x8*)(sl + 16384 + soff128(64 * wc + 16 * n + lr, 4 * kk + g));
#pragma unroll
            for (int i = 0; i < 2; ++i)
#pragma unroll
                for (int n = 0; n < 4; ++n) acc[i][n] = __builtin_amdgcn_mfma_f32_16x16x32_bf16(bb[n], a[i], acc[i][n], 0, 0, 0);
        }
        asm volatile("" ::: "memory");
        if (++ck == nK) { const int ti = t_first + cj * t_step, TM = ti & 7, TN = ti >> 3;
#pragma unroll
            for (int i = 0; i < 2; ++i)
#pragma unroll
                for (int p = 0; p < 2; ++p) { const f32x4 t2[2] = {acc[i][2 * p], acc[i][2 * p + 1]}; E(t2, 2 * TM + (wr >> 1), 2 * TN + wc, 2 * (wr & 1) + i, p, lr, g); acc[i][2 * p] = (f32x4){0.f, 0.f, 0.f, 0.f}; acc[i][2 * p + 1] = acc[i][2 * p]; }
            ck = 0; ++cj; }
    }
    asm volatile("s_waitcnt vmcnt(0)" ::: "memory"); __builtin_amdgcn_s_barrier(); asm volatile("" ::: "memory");
}

__device__ __forceinline__ v2u pack4(const f32x4 v) { v2u w; w.x = pg8::cvt_pk_bf16(v[0], v[1]); w.y = pg8::cvt_pk_bf16(v[2], v[3]); return w; }
struct EpiScale {
    bf16* O; int ldc; const LAS float* SRS;
    __device__ __forceinline__ void operator()(const f32x4 (&acc)[2], int tm, int tn, int wr, int wc, int lr, int g) const {
        const int row = MP + 64 * tm + 16 * wr + lr; const float r = SRS[row - MP]; bf16* p = O + ((size_t)(tn >> 2) * MT + row) * 256 + 64 * (tn & 3) + 32 * wc + 4 * g;
        *(v2u*)p = pack4(acc[0] * r); *(v2u*)(p + 16) = pack4(acc[1] * r);
    }
};
struct EpiSwiGLU {
    bf16* O; const LAS float* SRS;
    __device__ __forceinline__ void operator()(const f32x4 (&acc)[2], int tm, int tn, int wr, int wc, int lr, int g) const {
        const int row = MP + 64 * tm + 16 * wr + lr; const float r = SRS[row - MP];
        const f32x4 gg = acc[0] * r, uu = acc[1] * r; f32x4 h;
#pragma unroll
        for (int j = 0; j < 4; ++j) h[j] = ep::silu_mul(gg[j], uu[j]);
        *(v2u*)(O + (size_t)row * DFF + 32 * tn + 16 * wc + 4 * g) = pack4(h);
    }
};
template <bool WB> struct EpiResid {
    bf16* XB; float* ssq;
    __device__ __forceinline__ void operator()(const f32x4 (&acc)[2], int tm, int tn, int wr, int wc, int lr, int g) const {
        const int row = MP + 64 * tm + 16 * wr + lr, col = 64 * tn + 32 * wc + 4 * g; bf16* xp = XB + (size_t)row * DM + col;
        const v2u w0 = pack4(bf4_to_f(*(const v2u*)xp) + acc[0]), w1 = pack4(bf4_to_f(*(const v2u*)(xp + 16)) + acc[1]);
        *(v2u*)xp = w0; *(v2u*)(xp + 16) = w1;
        if (WB) { const f32x4 r0 = bf4_to_f(w0), r1 = bf4_to_f(w1);
            float ss = ((r0[0] * r0[0] + r0[1] * r0[1]) + (r0[2] * r0[2] + r0[3] * r0[3])) + ((r1[0] * r1[0] + r1[1] * r1[1]) + (r1[2] * r1[2] + r1[3] * r1[3]));
            ss += __shfl_xor(ss, 16); ss += __shfl_xor(ss, 32); if (g == 0) atomicAdd(ssq + (size_t)row * 16 + tn, ss); }
    }
};
struct EpiConvIn {
    bf16* BG; bf16* U; const LAS float* SRS; float* cvS;
    __device__ __forceinline__ void operator()(const f32x4 (&acc)[2], int tm, int tn, int wr, int wc, int lr, int g) const {
        const int row = MP + 64 * tm + 16 * wr + lr; const float r = SRS[row - MP];
        if (tn < 16) { bf16* p = BG + (size_t)row * DM + 64 * tn + 32 * wc + 4 * g; *(v2u*)p = pack4(acc[0] * r); *(v2u*)(p + 16) = pack4(acc[1] * r); }
        else { const int ch = 32 * (tn - 16) + 16 * wc + 4 * g; const f32x4 pv = (acc[0] * r) * (acc[1] * r);
            *(v2u*)(U + (size_t)row * DM + ch) = pack4(pv);
            const int rs = row - MP, t = rs & (S_S - 1), b = rs >> 3; if (t >= S_S - 2) *(f32x4*)(cvS + (size_t)(b * 2 + (t - (S_S - 2))) * DM + ch) = pv; }
    }
};
__device__ __forceinline__ const LAS float* fill_srs(LAS unsigned char* lds, const float* slab) {
    LAS float* SRS = (LAS float*)(lds + SCR_OFF + 8192);
    for (int i = threadIdx.x; i < MS; i += NWAVES * 64) SRS[i] = ep::row_rs(slab, MP + i);
    __syncthreads();
    return SRS;
}
}
#ifndef SELF_INIT_BAR
#define SELF_INIT_BAR 1
#endif
#ifndef TS_PROBE
#define TS_PROBE -1
#endif
#ifndef TS_A
#define TS_A ((TS_PROBE >= N_PHASES) ? 0 : TS_PROBE)
#define TS_B ((TS_PROBE >= N_PHASES) ? N_PHASES : TS_PROBE + 1)
#endif
#ifndef PROBE_LAUNCH
#define PROBE_LAUNCH -1
#define PROBE_LAUNCH_N 1
#endif
#ifndef PROBE_ID
#define PROBE_ID -1
#define PROBE_N 1
#endif
#ifndef SCAN_MODE
#define SCAN_MODE 3
#endif
#ifndef MK_N_LAUNCHES
#define MK_N_LAUNCHES 1
#endif
constexpr int N_PHASES = (FLOW == 1) ? 5 : 13;
struct Args { const float* in[18]; float* out; unsigned char* ws; int ph_lo, ph_hi, rep_id, rep_n, dry, pad; };
__global__ void __launch_bounds__(NWAVES * 64, 2) fwd_kernel(Args args) {
    extern __shared__ __attribute__((aligned(16))) unsigned char lds[];
    Frame F;
    F.lds = (LAS unsigned char*)lds; F.MISC = (volatile LAS unsigned*)(F.lds + MISC_OFF);
    F.tid = threadIdx.x; F.lane = F.tid & 63; F.wave = __builtin_amdgcn_readfirstlane(F.tid >> 6);
    F.G = gridDim.x; { const int bx = blockIdx.x; F.vcu = (F.G % 8 == 0) ? (bx % 8) * (F.G / 8) + bx / 8 : bx; }
    F.ws = args.ws; F.out = args.out; F.ctl = (gu32*)(args.ws + WS_CTL);
    F.xp = args.in[0]; F.xs = args.in[1]; F.stC = args.in[2]; F.stN = args.in[3]; F.stM = args.in[4]; F.stConv = args.in[5]; F.norm_mix = args.in[6]; F.norm_ffn = args.in[7]; F.norm_final = args.in[8];
    F.w_in = args.in[9]; F.b_gate = args.in[10]; F.head_norm = args.in[11]; F.w_out = args.in[12]; F.w_cin = args.in[13]; F.w_taps = args.in[14]; F.w_cout = args.in[15]; F.w_gu = args.in[16]; F.w_dn = args.in[17];
    for (int u = F.tid; u < (LDS_BYTES - LDSCTL_OFF) / 4; u += NWAVES * 64) ((LAS unsigned*)(F.lds + LDSCTL_OFF))[u] = 0u;
    __syncthreads();
    XcdBarrier bar; bar.bar = (unsigned*)(F.ctl + CW_BAR); bar.x = 0; bar.st = nullptr;
    const int lo = args.ph_lo, hi = args.ph_hi;
#if SELF_INIT_BAR
    constexpr unsigned BAR_MAGIC = 0x600DF00Du; gu32* READY = F.ctl + 16;
    bool posted = false;
    if (hi - lo > 1 && blockIdx.x == 0) {
        for (int i = F.tid; i < XCD_BAR_WORDS; i += NWAVES * 64) ((unsigned*)(F.ctl + CW_BAR))[i] = 0u;
        if (F.tid < 16) ((unsigned*)F.ctl)[F.tid] = 0u;
        if (F.tid < NWAVES) ((unsigned*)F.ctl)[1024 + 64 * F.tid] = 0u;
        asm volatile("s_waitcnt vmcnt(0)" ::: "memory"); __syncthreads();
        if (F.tid == 0) { __builtin_amdgcn_fence(__ATOMIC_RELEASE, "agent"); asm volatile("s_waitcnt vmcnt(0)" ::: "memory"); __hip_atomic_store(READY, BAR_MAGIC, RLX_AGENT); }
    }
#define ENSURE_POST() do { if (!posted) { if (F.tid == 0) { unsigned sp = 0; while (__hip_atomic_load(READY, RLX_AGENT) != BAR_MAGIC) { __builtin_amdgcn_s_sleep(2); if (++sp > (1u << 22)) break; } } \
        __syncthreads(); bar = xcd_barrier_post((unsigned*)(F.ctl + CW_BAR), F.MISC + 8); posted = true; } } while (0)
#else
    if (hi - lo > 1) bar = xcd_barrier_post((unsigned*)(F.ctl + CW_BAR), F.MISC + 8);
#define ENSURE_POST() do { } while (0)
#endif
#define IN(k) (lo <= (k) && (k) < hi)
#define REP(id) (args.rep_id == (id) ? args.rep_n : 1)
#define SEAM(k) do { if (IN(k) && IN((k) + 1)) { ENSURE_POST(); xcd_barrier(bar); } STAMP((k) + 1); } while (0)
#if TS_PROBE >= 0
#define STAMP(i) do { if (blockIdx.x == 0 && F.tid == 0) ((unsigned long long*)(F.ctl + 2048))[(i)] = __builtin_amdgcn_s_memrealtime(); } while (0)
#else
#define STAMP(i) do { } while (0)
#endif
    bf16* XB = WSP(bf16, WS_XB); bf16* A2 = WSP(bf16, WS_A2); float* Y = F.out + O_Y;
    float* SSQ0 = WSP(float, WS_SSQ); float* SSQ1 = SSQ0 + (size_t)MT * 16; float* SSQ2 = SSQ1 + (size_t)MT * 16; float* SSQ3 = SSQ2 + (size_t)MT * 16;

    STAMP(0); BLKSTAMP(0);
    if (IN(0)) { p0_prologue(F, READY, BAR_MAGIC); }
#if TS_PROBE >= 0
    asm volatile("s_waitcnt vmcnt(0)" ::: "memory"); __syncthreads(); BLKSTAMP(3);
#endif
    SEAM(0);
#define SG_UP(WOFF) do { if (F.G == 256) { if (blockIdx.x < 128) sg::run(F.lds, XBs, WSP(bf16, WOFF), DM, sg::MapGU(), Es, (int)blockIdx.x, 128, 384); else sg::run(F.lds, XBs, WSP(bf16, WOFF), DM, sg::MapGU(), Es, 384 + (int)blockIdx.x - 128, 128, 16 * (DFF / 32)); } \
        else sg::run(F.lds, XBs, WSP(bf16, WOFF), DM, sg::MapGU(), Es, F.vcu, F.G, 16 * (DFF / 32)); } while (0)
    const bf16* XBs = XB + (size_t)MP * DM; const bf16* A2s = A2 + (size_t)MP * DM; const bf16* HFs = WSP(bf16, WS_HFF) + (size_t)MP * DFF;
    if (IN(1)) { pg8::Gemm g{XB, WSP(bf16, WS_W_IN), MP, NIN, DM}; ep::EpiScale E{WSP(bf16, WS_QKVO), NIN, SSQ0, nullptr, 0}; run_gemm_rs<ep::EpiScale, true, true>(F, g, E);
        sg::EpiScale Es{WSP(bf16, WS_QKVO), NIN, sg::fill_srs(F.lds, SSQ0)}; sg::run128(F.lds, XBs, WSP(bf16, WS_W_IN), DM, sg::MapPlain(), Es, F.vcu, F.G, 8 * (NIN / 128)); } SEAM(1);
#if SCAN_MODE == 0
    if (IN(2)) { scan_oracle(F, true, true, true); } SEAM(2);
    if (IN(3)) { gate_pass(F, 0, MT); } SEAM(3);
#elif SCAN_MODE == 1
    if (IN(2)) { s1_state_pass(F); scan_oracle(F, true, true, false); } SEAM(2);
    if (IN(3)) { gate_pass(F, 0, MT); } SEAM(3);
#elif SCAN_MODE == 2
    if (IN(2)) { s1_state_pass(F); scan_oracle(F, false, true, false); } SEAM(2);
    if (IN(3)) { s2_output_pass(F); gate_pass(F, MP, MT); } SEAM(3);
#else
    if (IN(2)) {
        const bool split = (F.G % 32) == 0; const int slot = F.vcu & 31, grp = F.vcu >> 5, ngrp = F.G >> 5;
        if (!split) { s3b_sample_pass(F, F.vcu, F.G); s1c_state_pass(F, F.vcu, F.G); }
        else if (slot < 16) { s1c_state_pass(F, grp * 16 + slot, ngrp * 16); P0STAMP(22); }
        else { s3b_sample_pass(F, grp * 16 + slot - 16, ngrp * 16);
#if TS_PROBE >= 0
            if (blockIdx.x == 128 && F.tid == 0) ((unsigned long long*)(F.ctl + 2048))[24] = __builtin_amdgcn_s_memrealtime();
#endif
        }
    } SEAM(2);
    if (IN(3)) { s2_output_pass(F); } SEAM(3);
#endif
#if FLOW == 1
    if (IN(4)) {
        unsigned* CNT = (unsigned*)(F.ctl + CW_CNT);
#define CNTS(s) (CNT + (s) * 68 * 64)
        const epf::rsrc_t rY = epf::mk(Y, (size_t)MT * DM * 4), rXB = epf::mk(XB, (size_t)MT * DM * 2), rHFF = epf::mk(F.ws + WS_HFF, (size_t)MT * DFF * 2);
        const epf::rsrc_t rS1 = epf::mk(SSQ1, SSQ_BYTES), rS2 = epf::mk(SSQ2, SSQ_BYTES), rS3 = epf::mk(SSQ3, SSQ_BYTES);
        const epf::rsrc_t rBG = epf::mk(F.ws + WS_BG, (size_t)MT * DM * 2), rU = epf::mk(F.ws + WS_U, (size_t)MT * DM * 2);
        int rot = 0;
        { pg8::Gemm g{A2, WSP(bf16, WS_W_OUT), MT, DM, DM}; epf::EpiResid<true, false> E{F.xp, F.xs, rY, rXB, rS1}; flow_gemm(F, g, E, rot, nullptr, 0u, CNTS(0)); rot += 272; }
        { pg8::Gemm g{XB, WSP(bf16, WS_W_GU0), MT, NGU, DM}; epf::EpiSwiGLU E{rHFF, rS1}; flow_gemm(F, g, E, rot, CNTS(0), 32u, CNTS(1)); rot += 1496; }
        { pg8::Gemm g{WSP(bf16, WS_HFF), WSP(bf16, WS_W_DN0), MT, DM, DFF}; epf::EpiResid<true, true> E{nullptr, nullptr, rY, rXB, rS2}; flow_gemm(F, g, E, rot, CNTS(1), 176u, CNTS(2)); rot += 272; }
        { pg8::Gemm g{XB, WSP(bf16, WS_W_CIN), MT, NCIN, DM}; epf::EpiConvIn E{rBG, rU, rS2, F.out + O_CVP, F.out + O_CVS}; flow_gemm(F, g, E, rot, CNTS(2), 32u, CNTS(3)); rot += 816; }
        conv_flow(F, rot, CNTS(3), CNTS(4)); rot += 72;
        { pg8::Gemm g{A2, WSP(bf16, WS_W_COUT), MT, DM, DM}; epf::EpiResid<true, true> E{nullptr, nullptr, rY, rXB, rS3}; flow_gemm(F, g, E, rot, CNTS(4), 8u, CNTS(5)); rot += 272; }
        { pg8::Gemm g{XB, WSP(bf16, WS_W_GU1), MT, NGU, DM}; epf::EpiSwiGLU E{rHFF, rS3}; flow_gemm(F, g, E, rot, CNTS(5), 32u, CNTS(6)); rot += 1496; }
        { pg8::Gemm g{WSP(bf16, WS_HFF), WSP(bf16, WS_W_DN1), MT, DM, DFF}; epf::EpiResid<false, true> E{nullptr, nullptr, rY, rXB, rS3}; flow_gemm(F, g, E, rot, CNTS(6), 176u, CNTS(7)); rot += 272; }
        fnorm_flow(F, rot, CNTS(7));
#undef CNTS
    }
#elif FLOW == 2
    {
        const epf::rsrc_t rY = epf::mk(Y, (size_t)MT * DM * 4), rXB = epf::mk(XB, (size_t)MT * DM * 2), rHFF = epf::mk(F.ws + WS_HFF, (size_t)MT * DFF * 2);
        const epf::rsrc_t rS1 = epf::mk(SSQ1, SSQ_BYTES), rS2 = epf::mk(SSQ2, SSQ_BYTES), rS3 = epf::mk(SSQ3, SSQ_BYTES);
        const epf::rsrc_t rBG = epf::mk(F.ws + WS_BG, (size_t)MT * DM * 2), rU = epf::mk(F.ws + WS_U, (size_t)MT * DM * 2);
    if (IN(4)) { pg8::Gemm g{A2, WSP(bf16, WS_W_OUT), MT, DM, DM}; epf::EpiResid<true, false> E{F.xp, F.xs, rY, rXB, rS1}; run_gemm<epf::EpiResid<true, false>, true, true>(F, g, E); } SEAM(4);
    if (IN(5)) { pg8::Gemm g{XB, WSP(bf16, WS_W_GU0), MT, NGU, DM}; epf::EpiSwiGLU E{rHFF, rS1}; run_gemm<epf::EpiSwiGLU, true, true>(F, g, E); } SEAM(5);
    if (IN(6)) { pg8::Gemm g{WSP(bf16, WS_HFF), WSP(bf16, WS_W_DN0), MT, DM, DFF}; epf::EpiResid<true, true> E{nullptr, nullptr, rY, rXB, rS2}; run_gemm<epf::EpiResid<true, true>, true, true>(F, g, E); } SEAM(6);
    if (IN(7)) { pg8::Gemm g{XB, WSP(bf16, WS_W_CIN), MT, NCIN, DM}; epf::EpiConvIn E{rBG, rU, rS2, F.out + O_CVP, F.out + O_CVS}; run_gemm<epf::EpiConvIn, true, true>(F, g, E); } SEAM(7);
    if (IN(8)) { conv_pass(F); } SEAM(8);
    if (IN(9)) { pg8::Gemm g{A2, WSP(bf16, WS_W_COUT), MT, DM, DM}; epf::EpiResid<true, true> E{nullptr, nullptr, rY, rXB, rS3}; run_gemm<epf::EpiResid<true, true>, true, true>(F, g, E); } SEAM(9);
    if (IN(10)) { pg8::Gemm g{XB, WSP(bf16, WS_W_GU1), MT, NGU, DM}; epf::EpiSwiGLU E{rHFF, rS3}; run_gemm<epf::EpiSwiGLU, true, true>(F, g, E); } SEAM(10);
    if (IN(11)) { pg8::Gemm g{WSP(bf16, WS_HFF), WSP(bf16, WS_W_DN1), MT, DM, DFF}; epf::EpiResid<false, true> E{nullptr, nullptr, rY, rXB, rS3}; run_gemm<epf::EpiResid<false, true>, true, true>(F, g, E); } SEAM(11);
    if (IN(12)) { final_norm(F); }
    }
#else
    if (IN(4)) { pg8::Gemm g{A2, WSP(bf16, WS_W_OUT), MP, DM, DM}; ep::EpiResid<true> E{XB, SSQ1}; run_gemm<ep::EpiResid<true>, true, true>(F, g, E);
        sg::EpiResid<true> Es{XB, SSQ1}; sg::run(F.lds, A2s, WSP(bf16, WS_W_OUT), DM, sg::MapPlain(), Es, F.vcu, F.G, 16 * (DM / 64)); } SEAM(4);
    if (IN(5)) { pg8::Gemm g{XB, WSP(bf16, WS_W_GU0), MT, NGU, DM}; ep::EpiSwiGLU E{WSP(bf16, WS_HFF), SSQ1, nullptr, 0}; run_gemm_rs<ep::EpiSwiGLU, true, true>(F, g, E); } SEAM(5);
    if (IN(6)) { pg8::Gemm g{WSP(bf16, WS_HFF), WSP(bf16, WS_W_DN0), MP, DM, DFF}; ep::EpiResid<true> E{XB, SSQ2}; run_gemm<ep::EpiResid<true>, true, true>(F, g, E);
        sg::EpiResid<true> Es{XB, SSQ2}; sg::run(F.lds, HFs, WSP(bf16, WS_W_DN0), DFF, sg::MapPlain(), Es, F.vcu, F.G, 16 * (DM / 64)); } SEAM(6);
    if (IN(7)) { pg8::Gemm g{XB, WSP(bf16, WS_W_CIN), MP, NCIN, DM}; ep::EpiConvIn E{WSP(bf16, WS_BG), WSP(bf16, WS_U), SSQ2, F.out + O_CVP, F.out + O_CVS, nullptr, 0}; run_gemm_rs<ep::EpiConvIn, true, true>(F, g, E);
        sg::EpiConvIn Es{WSP(bf16, WS_BG), WSP(bf16, WS_U), sg::fill_srs(F.lds, SSQ2), F.out + O_CVS}; sg::run128(F.lds, XBs, WSP(bf16, WS_W_CIN), DM, sg::MapCin(), Es, F.vcu, F.G, 8 * (NCIN / 128)); } SEAM(7);
    if (IN(8)) { conv_pass(F); } SEAM(8);
    if (IN(9)) { pg8::Gemm g{A2, WSP(bf16, WS_W_COUT), MP, DM, DM}; ep::EpiResid<true> E{XB, SSQ3}; run_gemm<ep::EpiResid<true>, true, true>(F, g, E);
        sg::EpiResid<true> Es{XB, SSQ3}; sg::run(F.lds, A2s, WSP(bf16, WS_W_COUT), DM, sg::MapPlain(), Es, F.vcu, F.G, 16 * (DM / 64)); } SEAM(9);
    if (IN(10)) { pg8::Gemm g{XB, WSP(bf16, WS_W_GU1), MT, NGU, DM}; ep::EpiSwiGLU E{WSP(bf16, WS_HFF), SSQ3, nullptr, 0}; run_gemm_rs<ep::EpiSwiGLU, true, true>(F, g, E); } SEAM(10);
    if (IN(11)) { pg8::Gemm g{WSP(bf16, WS_HFF), WSP(bf16, WS_W_DN1), MP, DM, DFF}; ep::EpiResid<false> E{XB, nullptr}; run_gemm<ep::EpiResid<false>, true, true>(F, g, E);
        sg::EpiResid<false> Es{XB, nullptr}; sg::run(F.lds, HFs, WSP(bf16, WS_W_DN1), DFF, sg::MapPlain(), Es, F.vcu, F.G, 16 * (DM / 64)); } SEAM(11);
    if (IN(12)) { final_norm(F); }
#endif
#if TS_PROBE >= 0
    {
        xcd_barrier(bar); STAMP(N_PHASES);
        if (blockIdx.x == 0 && F.tid == 0) {
            const unsigned long long* ts = (const unsigned long long*)(F.ctl + 2048);
            const unsigned long long t0 = ts[TS_A], t1 = ts[TS_B];
            int T = (int)((t1 - t0 + 50) / 100);
#ifdef TS_MODE
#ifndef TS_REF
#define TS_REF 0
#endif
            { const unsigned long long* bs = (const unsigned long long*)(F.ctl + 8192) + TS_SLOT * 256; unsigned long long mx = 0, mn = ~0ull; int am = 0, cnt = 0;
              for (int i = 0; i < 256; ++i) { const unsigned long long v = __hip_atomic_load(bs + i, RLX_AGENT); if (v > mx) { mx = v; am = i; } if (v < mn) mn = v; if (v - ts[TS_REF] > (unsigned long long)TS_THR * 100) ++cnt; }
              T = TS_MODE == 1 ? (int)((mx - ts[TS_REF] + 50) / 100) : TS_MODE == 2 ? am : TS_MODE == 3 ? (int)((mn - ts[TS_REF] + 50) / 100) : cnt;
              if (TS_MODE >= 5) { unsigned long long sx[8] = {0,0,0,0,0,0,0,0}, tot = 0;
                for (int i = 0; i < 256; ++i) { const unsigned long long v = __hip_atomic_load(bs + i, RLX_AGENT) - ts[TS_REF]; tot += v;
#pragma unroll
                    for (int x = 0; x < 8; ++x) if ((i & 7) == x) sx[x] += v; }
                unsigned long long hi8 = 0, lo8 = ~0ull; int ax = 0;
#pragma unroll
                for (int x = 0; x < 8; ++x) { if (sx[x] > hi8) { hi8 = sx[x]; ax = x; } if (sx[x] < lo8) lo8 = sx[x]; }
                T = TS_MODE == 5 ? ax * 100 + (int)((hi8 - lo8) / 3200) : (int)(tot / 25600); } }
#endif
            F.out[O_Y] += (float)(10 + T / 50);
            const float X = (2.5f + 0.07f * (float)(T % 50)) * 1e-4f, sc = 1.f + sqrtf(X);
            for (int i = 0; i < NB_P * NH; ++i) F.out[O_MP + i] *= sc;
        }
    }
#endif
#if SELF_INIT_BAR
    if (hi - lo > 1 && blockIdx.x == 0 && F.tid == 0) __hip_atomic_store(READY, 0u, RLX_AGENT);
#endif
#undef IN
#undef SEAM
}

extern "C" void kernel_launch(void* const* d_in, const int* in_sizes, int n_in, void* d_out, int out_size, void* d_ws, size_t ws_size, hipStream_t stream) {
    static int grid = 0;
    if (grid == 0) {
        if (n_in != 18 || in_sizes[0] != MP * DM || (size_t)out_size != O_END || ws_size < WS_END) { fprintf(stderr, "kernel_launch: unexpected shapes: n_in %d in0 %d out %d ws %zu (need out %zu ws %zu)\n", n_in, n_in > 0 ? in_sizes[0] : -1, out_size, ws_size, (size_t)O_END, (size_t)WS_END); grid = -1; return; }
        int dev = 0, cus = 0;
        if (hipGetDevice(&dev) != hipSuccess || hipDeviceGetAttribute(&cus, hipDeviceAttributeMultiprocessorCount, dev) != hipSuccess) { grid = -1; return; }
        if (hipFuncSetAttribute((const void*)fwd_kernel, hipFuncAttributeMaxDynamicSharedMemorySize, LDS_BYTES) != hipSuccess) { fprintf(stderr, "kernel_launch: hipFuncSetAttribute failed\n"); grid = -1; return; }
        int bpc = 0;
        if (hipOccupancyMaxActiveBlocksPerMultiprocessor(&bpc, (const void*)fwd_kernel, NWAVES * 64, (size_t)LDS_BYTES) != hipSuccess || bpc < 1 || cus < 1) {
            fprintf(stderr, "kernel_launch: occupancy query: %d workgroups per CU on %d CUs -- the persistent grid would not be resident, not launching\n", bpc, cus); (void)hipGetLastError(); grid = -1; return; }
        (void)hipGetLastError();
        grid = cus;
    }
    if (grid < 0) return;
#if !SELF_INIT_BAR
    (void)hipMemsetAsync((char*)d_ws + WS_CTL, 0, CTL_ZERO_BYTES, stream);
#endif
    Args a{};
    for (int i = 0; i < 18; ++i) a.in[i] = (const float*)d_in[i];
    a.out = (float*)d_out; a.ws = (unsigned char*)d_ws; a.rep_id = PROBE_ID; a.rep_n = PROBE_N;
#if MK_N_LAUNCHES == 1
    a.ph_lo = 0; a.ph_hi = N_PHASES;
    {
        void* kargs[] = {(void*)&a};
        if (hipLaunchCooperativeKernel((const void*)fwd_kernel, dim3(grid), dim3(NWAVES * 64), kargs, (unsigned)LDS_BYTES, stream) != hipSuccess) { fprintf(stderr, "kernel_launch: cooperative launch refused\n"); (void)hipGetLastError(); } }
#else
    for (int p = 0; p < N_PHASES; ++p) { a.ph_lo = p; a.ph_hi = p + 1; const int nr = (p == PROBE_LAUNCH ? PROBE_LAUNCH_N : 1); for (int r = 0; r < nr; ++r) { a.dry = (r + 1 < nr) ? 1 : 0; hipLaunchKernelGGL(fwd_kernel, dim3(grid), dim3(NWAVES * 64), LDS_BYTES, stream, a); } }
#endif
}
```
